# Optimizing an MI355X kernel written in HIP

```python
import jax, jax.numpy as jnp
from jax import lax
import numpy as np

D_MODEL = 1024
BATCH = 8
SEQ = 2048
DEPTH = 1

GRID_W = 64
CTX_LEN = 256
N_HEADS = 16
N_KV_HEADS = 4
GROUP = N_HEADS // N_KV_HEADS
HEAD_DIM = 64
ATTN_WIDTH = N_HEADS * HEAD_DIM
KV_WIDTH = N_KV_HEADS * HEAD_DIM
WINDOW = 128
BLOCK = 128
ROPE_AXIS_DIM = HEAD_DIM // 2
ROPE_BASE = 10000.0
CONV_CH = D_MODEL // 2
CONV_WIDTH = 31
N_BRANCHES = 2
Q_OFF = 0
K_OFF = Q_OFF + ATTN_WIDTH
V_OFF = K_OFF + KV_WIDTH
CONV_OFF = V_OFF + KV_WIDTH
GATE_OFF = CONV_OFF + 2 * CONV_CH
IN_WIDTH = GATE_OFF + N_BRANCHES * D_MODEL
PEER_HEADS = 8
N_KEYS = 128
N_EXPERTS = N_KEYS * N_KEYS
PEER_QDIM = 256
PEER_HALF = PEER_QDIM // 2
PEER_TOPK = 16
PEER_CHUNK = 128
NORM_EPS = 1e-6
NEG_INF = -1e30

kernel_name = "hybrid_dit_wgqa_conformer_peer"


def rmsnorm(x, g):
    xf = x.astype(jnp.float32)
    y = xf * lax.rsqrt(jnp.mean(xf * xf, axis=-1, keepdims=True) + NORM_EPS)
    return (y * g.astype(jnp.float32)).astype(x.dtype)


def layernorm(x, g, b):
    xf = x.astype(jnp.float32)
    mu = jnp.mean(xf, axis=-1, keepdims=True)
    var = jnp.mean(jnp.square(xf - mu), axis=-1, keepdims=True)
    y = (xf - mu) * lax.rsqrt(var + NORM_EPS)
    return (y * g.astype(jnp.float32) + b.astype(jnp.float32)).astype(x.dtype)


def adaln(cond, w_ada, b_ada):
    return jnp.split(jax.nn.silu(cond) @ w_ada + b_ada, 6, axis=-1)


def modulate(h, shift, scale):
    return h * (1.0 + scale) + shift


def axial_rope_tables(rows):
    t = jnp.arange(rows * GRID_W, dtype=jnp.int32)
    row = (t // GRID_W).astype(jnp.float32)
    col = (t % GRID_W).astype(jnp.float32)
    freqs = ROPE_BASE ** (-jnp.arange(0, ROPE_AXIS_DIM, 2, dtype=jnp.float32) / ROPE_AXIS_DIM)
    ang_r = row[:, None] * freqs[None, :]
    ang_c = col[:, None] * freqs[None, :]
    return (jnp.cos(ang_r), jnp.sin(ang_r), jnp.cos(ang_c), jnp.sin(ang_c))


def rope_rotate_half(x, cos, sin):
    x1, x2 = jnp.split(x, 2, axis=-1)
    cos = cos[None, :, None, :]
    sin = sin[None, :, None, :]
    return jnp.concatenate([x1 * cos - x2 * sin, x2 * cos + x1 * sin], axis=-1)


def apply_axial_rope(x, rope):
    cos_r, sin_r, cos_c, sin_c = rope
    xf = x.astype(jnp.float32)
    xr = rope_rotate_half(xf[..., :ROPE_AXIS_DIM], cos_r, sin_r)
    xc = rope_rotate_half(xf[..., ROPE_AXIS_DIM:], cos_c, sin_c)
    return jnp.concatenate([xr, xc], axis=-1).astype(x.dtype)


def window_attention(q, k, v, k_ctx, v_ctx, sink):
    B, S = q.shape[:2]
    nb = S // BLOCK
    qb = q.reshape(B, nb, BLOCK, N_KV_HEADS, GROUP, HEAD_DIM)
    pad = ((0, 0), (WINDOW, WINDOW), (0, 0), (0, 0))
    kb = jnp.pad(k, pad).reshape(B, nb + 2, BLOCK, N_KV_HEADS, HEAD_DIM)
    vb = jnp.pad(v, pad).reshape(B, nb + 2, BLOCK, N_KV_HEADS, HEAD_DIM)
    k_win = jnp.concatenate([kb[:, :-2], kb[:, 1:-1], kb[:, 2:]], axis=2)
    v_win = jnp.concatenate([vb[:, :-2], vb[:, 1:-1], vb[:, 2:]], axis=2)
    qpos = jnp.arange(nb)[:, None, None] * BLOCK + jnp.arange(BLOCK)[None, :, None]
    kpos = (jnp.arange(nb)[:, None, None] - 1) * BLOCK + jnp.arange(3 * BLOCK)[None, None, :]
    valid = (kpos >= 0) & (kpos < S) & (jnp.abs(qpos - kpos) <= WINDOW)
    s_win = jnp.einsum('bnqhgd,bnkhd->bnhgqk', qb, k_win).astype(jnp.float32)
    s_win = jnp.where(valid[None, :, None, None], s_win, NEG_INF)
    s_ctx = jnp.einsum('bnqhgd,bchd->bnhgqc', qb, k_ctx).astype(jnp.float32)
    s_sink = jnp.broadcast_to(
        sink.astype(jnp.float32).reshape(N_KV_HEADS, GROUP)[None, None, :, :, None, None],
        s_win.shape[:-1] + (1,))
    p = jax.nn.softmax(jnp.concatenate([s_win, s_ctx, s_sink], axis=-1), axis=-1)
    n_win = 3 * BLOCK
    n_ctx = k_ctx.shape[1]
    p_win = p[..., :n_win].astype(v.dtype)
    p_ctx = p[..., n_win:n_win + n_ctx].astype(v.dtype)
    o = (jnp.einsum('bnhgqk,bnkhd->bnqhgd', p_win, v_win)
         + jnp.einsum('bnhgqc,bchd->bnqhgd', p_ctx, v_ctx))
    return o.reshape(B, S, ATTN_WIDTH)


def context_attention(q, k, v, sink):
    B, L = q.shape[:2]
    qg = q.reshape(B, L, N_KV_HEADS, GROUP, HEAD_DIM)
    s = jnp.einsum('blhgd,bmhd->bhglm', qg, k).astype(jnp.float32)
    s_sink = jnp.broadcast_to(
        sink.astype(jnp.float32).reshape(N_KV_HEADS, GROUP)[None, :, :, None, None],
        s.shape[:-1] + (1,))
    p = jax.nn.softmax(jnp.concatenate([s, s_sink], axis=-1), axis=-1)[..., :L]
    o = jnp.einsum('bhglm,bmhd->blhgd', p.astype(v.dtype), v)
    return o.reshape(B, L, ATTN_WIDTH)


def conformer_conv(u_glu, conv_dw, conv_dw_b, conv_ln_g, conv_ln_b, w_o_conv):
    a, g = jnp.split(u_glu, 2, axis=-1)
    u = a * jax.nn.sigmoid(g)
    u = lax.conv_general_dilated(
        u, conv_dw[:, None, :].astype(u.dtype), window_strides=(1,),
        padding=[(CONV_WIDTH // 2, CONV_WIDTH // 2)],
        dimension_numbers=('NWC', 'WIO', 'NWC'), feature_group_count=CONV_CH) + conv_dw_b
    u = jax.nn.silu(layernorm(u, conv_ln_g, conv_ln_b))
    return u @ w_o_conv


def merge_branches(y_attn, y_conv, gate_logits, w_out):
    g_attn, g_conv = jnp.split(gate_logits, N_BRANCHES, axis=-1)
    return (jax.nn.sigmoid(g_attn) * y_attn + jax.nn.sigmoid(g_conv) * y_conv) @ w_out


def peer_ffn(h, peer_wq, peer_keys, peer_u, peer_v):
    B, S, D = h.shape
    t = B * S
    hf = h.reshape(t, D)
    q = (hf @ peer_wq).reshape(t, PEER_HEADS, 2, PEER_HALF)
    s = jnp.einsum('thpd,hpkd->thpk', q, peer_keys).astype(jnp.float32)
    s1, i1 = lax.top_k(s[:, :, 0], PEER_TOPK)
    s2, i2 = lax.top_k(s[:, :, 1], PEER_TOPK)
    cand = (s1[..., :, None] + s2[..., None, :]).reshape(t, PEER_HEADS, PEER_TOPK * PEER_TOPK)
    best, pos = lax.top_k(cand, PEER_TOPK)
    idx = (jnp.take_along_axis(i1, pos // PEER_TOPK, axis=-1) * N_KEYS
           + jnp.take_along_axis(i2, pos % PEER_TOPK, axis=-1))
    gates = jax.nn.softmax(best, axis=-1).astype(h.dtype)
    n_chunks = t // PEER_CHUNK

    def expert_block(args):
        xb, ib, gb = args
        act = jax.nn.gelu(jnp.einsum('td,thkd->thk', xb, peer_u[ib]), approximate=False)
        return jnp.einsum('thk,thkd->td', gb * act, peer_v[ib])

    out = lax.map(expert_block, (hf.reshape(n_chunks, PEER_CHUNK, D),
                                 idx.reshape(n_chunks, PEER_CHUNK, PEER_HEADS, PEER_TOPK),
                                 gates.reshape(n_chunks, PEER_CHUNK, PEER_HEADS, PEER_TOPK)))
    return out.reshape(B, S, D)


def trunk_layer(x, h_ctx, c, c_ctx, rope, update_ctx,
                w_ada, b_ada, g_pre_mix, g_post_mix, g_pre_ffn, g_post_ffn,
                w_in, attn_sink, w_o_attn, conv_dw, conv_dw_b, conv_ln_g, conv_ln_b,
                w_o_conv, w_out, peer_wq, peer_keys, peer_u, peer_v):
    B, S, _ = x.shape
    L = h_ctx.shape[1]
    sh1, sc1, gt1, sh2, sc2, gt2 = [m[:, None, :] for m in adaln(c, w_ada, b_ada)]
    csh1, csc1, cgt1, csh2, csc2, cgt2 = adaln(c_ctx, w_ada, b_ada)
    q_scale = HEAD_DIM ** -0.5

    hx = modulate(rmsnorm(x, g_pre_mix), sh1, sc1)
    hc = modulate(rmsnorm(h_ctx, g_pre_mix), csh1, csc1)
    p = hx @ w_in
    q = apply_axial_rope(p[..., Q_OFF:K_OFF].reshape(B, S, N_HEADS, HEAD_DIM), rope) * q_scale
    k = apply_axial_rope(p[..., K_OFF:V_OFF].reshape(B, S, N_KV_HEADS, HEAD_DIM), rope)
    v = p[..., V_OFF:CONV_OFF].reshape(B, S, N_KV_HEADS, HEAD_DIM)
    if update_ctx:
        pc = hc @ w_in
        kvc = pc[..., K_OFF:CONV_OFF]
    else:
        kvc = hc @ w_in[:, K_OFF:CONV_OFF]
    k_c = kvc[..., :KV_WIDTH].reshape(B, L, N_KV_HEADS, HEAD_DIM)
    v_c = kvc[..., KV_WIDTH:].reshape(B, L, N_KV_HEADS, HEAD_DIM)

    y_attn = window_attention(q, k, v, k_c, v_c, attn_sink) @ w_o_attn
    y_conv = conformer_conv(p[..., CONV_OFF:GATE_OFF], conv_dw, conv_dw_b, conv_ln_g, conv_ln_b, w_o_conv)
    mixed = merge_branches(y_attn, y_conv, p[..., GATE_OFF:], w_out)
    x = x + gt1 * rmsnorm(mixed, g_post_mix)

    if update_ctx:
        q_c = pc[..., Q_OFF:K_OFF].reshape(B, L, N_HEADS, HEAD_DIM) * q_scale
        yc_attn = context_attention(q_c, k_c, v_c, attn_sink) @ w_o_attn
        yc_conv = conformer_conv(pc[..., CONV_OFF:GATE_OFF], conv_dw, conv_dw_b, conv_ln_g, conv_ln_b, w_o_conv)
        mixed_c = merge_branches(yc_attn, yc_conv, pc[..., GATE_OFF:], w_out)
        h_ctx = h_ctx + cgt1 * rmsnorm(mixed_c, g_post_mix)

    h2 = modulate(rmsnorm(x, g_pre_ffn), sh2, sc2)
    x = x + gt2 * rmsnorm(peer_ffn(h2, peer_wq, peer_keys, peer_u, peer_v), g_post_ffn)
    if update_ctx:
        hc2 = modulate(rmsnorm(h_ctx, g_pre_ffn), csh2, csc2)
        h_ctx = h_ctx + cgt2 * rmsnorm(peer_ffn(hc2, peer_wq, peer_keys, peer_u, peer_v), g_post_ffn)
    return x, h_ctx


def setup_inputs(seed: int = 0) -> dict:
    key = jax.random.key(seed)
    ks = jax.random.split(key, 24)
    f32 = jnp.float32
    D = D_MODEL

    def nrm(k, shape, scale):
        return jax.random.normal(k, shape, f32) * scale

    def gain(k, shape):
        return 1.0 + 0.05 * jax.random.normal(k, shape, f32)

    return {
        "x": nrm(ks[0], (BATCH, SEQ, D), 1.0),
        "c": nrm(ks[1], (BATCH, D), 1.0),
        "ctx": nrm(ks[2], (BATCH, CTX_LEN, D), 1.0),
        "c_ctx": nrm(ks[3], (D,), 1.0),
        "w_ada": nrm(ks[4], (DEPTH, D, 6 * D), 0.5 * D ** -0.5),
        "b_ada": nrm(ks[5], (DEPTH, 6 * D), 0.01),
        "g_pre_mix": gain(ks[6], (DEPTH, D)),
        "g_post_mix": gain(ks[7], (DEPTH, D)),
        "g_pre_ffn": gain(ks[8], (DEPTH, D)),
        "g_post_ffn": gain(ks[9], (DEPTH, D)),
        "w_in": nrm(ks[10], (DEPTH, D, IN_WIDTH), D ** -0.5),
        "attn_sink": nrm(ks[11], (DEPTH, N_HEADS), 0.5),
        "w_o_attn": nrm(ks[12], (DEPTH, ATTN_WIDTH, D), ATTN_WIDTH ** -0.5),
        "conv_dw": nrm(ks[13], (DEPTH, CONV_WIDTH, CONV_CH), CONV_WIDTH ** -0.5),
        "conv_dw_b": nrm(ks[14], (DEPTH, CONV_CH), 0.01),
        "conv_ln_g": gain(ks[15], (DEPTH, CONV_CH)),
        "conv_ln_b": nrm(ks[16], (DEPTH, CONV_CH), 0.01),
        "w_o_conv": nrm(ks[17], (DEPTH, CONV_CH, D), CONV_CH ** -0.5),
        "w_out": nrm(ks[18], (DEPTH, D, D), D ** -0.5),
        "peer_wq": nrm(ks[19], (DEPTH, D, PEER_HEADS * PEER_QDIM), D ** -0.5),
        "peer_keys": nrm(ks[20], (DEPTH, PEER_HEADS, 2, N_KEYS, PEER_HALF), PEER_HALF ** -0.5),
        "peer_u": nrm(ks[21], (DEPTH, N_EXPERTS, D), D ** -0.5),
        "peer_v": nrm(ks[22], (DEPTH, N_EXPERTS, D), D ** -0.5),
    }


def reference(x, c, ctx, c_ctx, w_ada, b_ada, g_pre_mix, g_post_mix, g_pre_ffn, g_post_ffn,
              w_in, attn_sink, w_o_attn, conv_dw, conv_dw_b, conv_ln_g, conv_ln_b, w_o_conv,
              w_out, peer_wq, peer_keys, peer_u, peer_v):
    rows = x.shape[1] // GRID_W
    rope = axial_rope_tables(rows)
    h_ctx = ctx
    for layer in range(DEPTH):
        x, h_ctx = trunk_layer(
            x, h_ctx, c, c_ctx, rope, layer + 1 < DEPTH,
            w_ada[layer], b_ada[layer], g_pre_mix[layer], g_post_mix[layer],
            g_pre_ffn[layer], g_post_ffn[layer], w_in[layer], attn_sink[layer],
            w_o_attn[layer], conv_dw[layer], conv_dw_b[layer], conv_ln_g[layer],
            conv_ln_b[layer], w_o_conv[layer], w_out[layer], peer_wq[layer],
            peer_keys[layer], peer_u[layer], peer_v[layer])
    return x
```

```cpp
#include <hip/hip_runtime.h>
#include <cstdint>
#include <cstdio>

#ifndef GOLD
#define GOLD 0
#endif
#ifndef ONE_LAUNCH
#define ONE_LAUNCH 1
#endif

typedef unsigned short bf16_t;
typedef short bf16x8 __attribute__((ext_vector_type(8)));
typedef short s16x4 __attribute__((ext_vector_type(4)));
typedef float f32x4 __attribute__((ext_vector_type(4)));
typedef float f32x16 __attribute__((ext_vector_type(16)));
typedef unsigned u32x2 __attribute__((ext_vector_type(2)));
typedef unsigned u32x4 __attribute__((ext_vector_type(4)));

#if GOLD
typedef float act_t;
#else
typedef bf16_t act_t;
#endif
constexpr int AS = sizeof(act_t);

constexpr int DM = 1024, BATCH = 8, SEQ = 2048, CTXL = 256, NH = 16, NKV = 4, HD = 64;
constexpr int INW = 4608, PQW = 2048, NEXP = 16384;
constexpr int CONV_CH = 512, CONV_W = 31;
constexpr float EPS = 1e-6f;
constexpr float LOG2E = 1.4426950408889634f;
constexpr float QS = 0.125f * LOG2E;
#if GOLD
constexpr int CH_B = 1;
#else
constexpr int CH_B = 8;
#endif
constexpr int T_ = CH_B * SEQ;
constexpr int CT_ = CH_B * CTXL;
constexpr int NPHASE = 11;

constexpr size_t MiB = 1u << 20;
constexpr size_t WS_CTL = 0, CTL_BYTES = 1 * MiB;
constexpr size_t WS_MOD = 512 * 1024;
constexpr size_t WS_ROPE = 1 * MiB;
constexpr size_t WS_WIN = 2 * MiB;
constexpr size_t WS_WOA = 22 * MiB;
constexpr size_t WS_WOC = 26 * MiB;
constexpr size_t WS_WOUT = 28 * MiB;
constexpr size_t WS_WQ = 32 * MiB;
constexpr size_t WS_KEYS = 40 * MiB;
constexpr size_t AR = 42 * MiB;
constexpr size_t A0 = AR;
constexpr size_t O_Q = A0;
constexpr size_t O_K = O_Q + (size_t)T_ * 1024 * AS;
constexpr size_t O_VT = O_K + (size_t)T_ * 256 * AS;
constexpr size_t O_U = O_VT + (size_t)T_ * 256 * AS;
constexpr size_t O_SG = O_U + (size_t)T_ * 512 * AS;
constexpr size_t O_KC = O_SG + (size_t)T_ * 2048 * AS;
constexpr size_t O_VTC = O_KC + (size_t)CT_ * 256 * AS;
constexpr size_t A0_END = O_VTC + (size_t)CT_ * 256 * AS;
constexpr size_t O_MIXED = A0;
constexpr size_t O_PQ = A0 + (size_t)T_ * 4096;
constexpr size_t O_TOPV = A0;
constexpr size_t O_TOPI = A0 + (size_t)T_ * 1024;
constexpr size_t O_PV = A0 + 32 * MiB;
constexpr size_t A1 = A0_END;
constexpr size_t O_ATT = A1;
constexpr size_t O_CACT = O_ATT + (size_t)T_ * 1024 * AS;
constexpr size_t A1_END = O_CACT + (size_t)T_ * 512 * AS;
constexpr size_t O_HX = A1;
constexpr size_t O_HC = A1 + (size_t)T_ * 1024 * AS;
constexpr size_t O_PU = A1;
constexpr size_t O_PEI = O_CACT;
constexpr size_t O_PEG = O_CACT + (size_t)T_ * 512;
constexpr size_t A2 = A1_END;
constexpr size_t O_M = A2;
constexpr size_t O_H2 = A2;
constexpr size_t WS_END = A2 + (size_t)T_ * 1024 * AS;
static_assert(O_PQ + (size_t)T_ * 2048 * AS <= A0_END, "pq overlay");
static_assert(O_TOPI + (size_t)T_ * 1024 <= O_PQ, "topk overlay");
static_assert(GOLD || (O_PV >= O_TOPI + (size_t)T_ * 1024 && O_PV + 32 * MiB <= O_PQ), "pv overlay");
static_assert(GOLD || (O_PU + 32 * MiB <= O_PEI), "pu overlay");
static_assert(O_PEG + (size_t)T_ * 512 <= A1_END, "pe overlay");
static_assert(O_HC + (size_t)CT_ * 1024 * AS <= A1_END, "hc overlay");

constexpr int LDS_BYTES = 147456;
constexpr int LDS_MISC = LDS_BYTES - 256;

__device__ __forceinline__ float bf2f(bf16_t h) { return __uint_as_float((unsigned)h << 16); }
__device__ __forceinline__ unsigned f2bf(float f) { unsigned u = __float_as_uint(f); return (u + 0x7fffu + ((u >> 16) & 1u)) >> 16; }
__device__ __forceinline__ unsigned pk2(float lo, float hi) { return f2bf(lo) | (f2bf(hi) << 16); }
#if GOLD
__device__ __forceinline__ float ld_act(const act_t* p) { return *p; }
__device__ __forceinline__ void st_act(act_t* p, float v) { *p = v; }
__device__ __forceinline__ f32x4 ld4(const act_t* p) { return *(const f32x4*)p; }
__device__ __forceinline__ void st4(act_t* p, f32x4 v) { *(f32x4*)p = v; }
#else
__device__ __forceinline__ float ld_act(const act_t* p) { return bf2f(*p); }
__device__ __forceinline__ void st_act(act_t* p, float v) { *p = (bf16_t)f2bf(v); }
__device__ __forceinline__ f32x4 ld4(const act_t* p) { u32x2 w = *(const u32x2*)p; f32x4 r; r[0] = __uint_as_float(w[0] << 16); r[1] = __uint_as_float(w[0] & 0xffff0000u); r[2] = __uint_as_float(w[1] << 16); r[3] = __uint_as_float(w[1] & 0xffff0000u); return r; }
__device__ __forceinline__ void st4(act_t* p, f32x4 v) { u32x2 w; w[0] = pk2(v[0], v[1]); w[1] = pk2(v[2], v[3]); *(u32x2*)p = w; }
#endif
__device__ __forceinline__ float wave_sum(float v) {
#pragma unroll
    for (int o = 1; o < 64; o <<= 1) v += __shfl_xor(v, o);
    return v;
}
__device__ __forceinline__ float wave_max(float v) {
#pragma unroll
    for (int o = 1; o < 64; o <<= 1) v = fmaxf(v, __shfl_xor(v, o));
    return v;
}
__device__ __forceinline__ float sigmoidf_(float x) { return 1.0f / (1.0f + expf(-x)); }
__device__ __forceinline__ int crow(int r, int hi) { return (r & 3) + 8 * (r >> 2) + 4 * hi; }

#define LAS __attribute__((address_space(3)))
#define XB_TMO      128
#define XB_XCNT(j)  (256  + 64 * (j))
#define XB_XSUB(j)  (1280 + 64 * (j))
#define XB_XGEN(j)  (2304 + 64 * (j))
#define XB_TOP      3328
#define XB_TOPGEN   3392
#define XCD_BAR_WORDS 3456
#define XB_SPIN_CAP (1u << 18)
__device__ __forceinline__ unsigned xb_ld(unsigned* p)              { return __hip_atomic_load(p, __ATOMIC_RELAXED, __HIP_MEMORY_SCOPE_AGENT); }
__device__ __forceinline__ unsigned xb_add(unsigned* p, unsigned v) { return __hip_atomic_fetch_add(p, v, __ATOMIC_RELAXED, __HIP_MEMORY_SCOPE_AGENT); }
__device__ __forceinline__ unsigned xb_xcc_id() { return (unsigned)__builtin_amdgcn_s_getreg((3 << 11) | 20) & 0xFu; }
#define XB_SPIN(cond, bar) do { unsigned _sp = 0; while (cond) { __builtin_amdgcn_s_sleep(1); \
    if ((++_sp & 255u) == 0u) { if (xb_ld(&(bar)[XB_TMO])) break; if (_sp > XB_SPIN_CAP) { atomicAdd(&(bar)[XB_TMO], 1u); break; } } } } while (0)
struct XcdBarrier { unsigned* bar; unsigned x; volatile LAS unsigned* st; };
__device__ __forceinline__ XcdBarrier xcd_barrier_post(unsigned* bar, volatile LAS unsigned* st) {
    XcdBarrier b; b.bar = bar; b.x = xb_xcc_id(); b.st = st;
    if (threadIdx.x == 0) (void)xb_add(&bar[XB_XCNT(b.x)], 1u);
    return b;
}
__device__ __forceinline__ void xcd_barrier_complete(unsigned* bar, unsigned x, unsigned& nloc, unsigned& nx) {
    const unsigned G = gridDim.x * gridDim.y * gridDim.z;
    unsigned sum, cnt, mine, sp = 0u;
    for (;;) {
        sum = 0u; cnt = 0u; mine = 0u;
#pragma unroll
        for (unsigned j = 0; j < 16; ++j) { const unsigned c = xb_ld(&bar[XB_XCNT(j)]); sum += c; cnt += (c > 0u) ? 1u : 0u; mine = (j == x) ? c : mine; }
        if (sum == G) break;
        __builtin_amdgcn_s_sleep(1);
        if ((++sp & 255u) == 0u) { if (xb_ld(&bar[XB_TMO])) break; if (sp > XB_SPIN_CAP) { atomicAdd(&bar[XB_TMO], 1u); break; } }
    }
    nloc = mine > 0u ? mine : 1u; nx = cnt > 0u ? cnt : 1u;
}
__device__ __forceinline__ void xcd_barrier(const XcdBarrier& b) {
    asm volatile("s_waitcnt vmcnt(0)" ::: "memory");
    __syncthreads();
    if (threadIdx.x == 0) {
        unsigned* bar = b.bar;
        __builtin_amdgcn_s_waitcnt(0);
        unsigned nloc = b.st[0], nx = b.st[1];
        if (nloc == 0u) { xcd_barrier_complete(bar, b.x, nloc, nx); b.st[0] = nloc; b.st[1] = nx; }
        const unsigned old = xb_add(&bar[XB_XSUB(b.x)], 1u);
        const unsigned gen = old / nloc;
        if (old + 1u == (gen + 1u) * nloc) {
            __builtin_amdgcn_fence(__ATOMIC_RELEASE, "agent");
            asm volatile("s_waitcnt vmcnt(0)" ::: "memory");
            const unsigned og = xb_add(&bar[XB_TOP], 1u);
            const unsigned tg = og / nx;
            if (og + 1u == (tg + 1u) * nx) xb_add(&bar[XB_TOPGEN], 1u);
            else XB_SPIN(xb_ld(&bar[XB_TOPGEN]) == tg, bar);
            __builtin_amdgcn_fence(__ATOMIC_ACQUIRE, "agent");
            xb_add(&bar[XB_XGEN(b.x)], 1u);
            asm volatile("s_waitcnt vmcnt(0)" ::: "memory");
        } else {
            XB_SPIN(xb_ld(&bar[XB_XGEN(b.x)]) == gen, bar);
            __builtin_amdgcn_fence(__ATOMIC_ACQUIRE, "agent");
            asm volatile("s_waitcnt vmcnt(0)" ::: "memory");
        }
    }
    __syncthreads();
}

struct Args { const float* in[23]; float* out; unsigned char* ws; int ph_lo, ph_hi, b0, pad; };

struct Frame {
    unsigned char* lds;
    int tid, lane, wid, G, bid;
    int b0;
    const float *x, *c, *ctx, *c_ctx, *w_ada, *b_ada, *g_pre_mix, *g_post_mix, *g_pre_ffn, *g_post_ffn, *w_in, *sink, *w_o_attn,
        *conv_dw, *conv_dw_b, *conv_ln_g, *conv_ln_b, *w_o_conv, *w_out, *peer_wq, *peer_keys, *peer_u, *peer_v;
    float* out;
    float* mod; float* rope;
    act_t *win_t, *woa_t, *woc_t, *wout_t, *wq_t, *keys_t;
    act_t *q, *k, *vT, *u, *sg, *kc, *vTc, *att, *cact, *hx, *hc, *m, *h2, *pq;
    float *mixed, *topv, *peg; int *topi, *pei;
    bf16_t *pu16, *pv16;
};

constexpr int BK = 32;
#if GOLD
constexpr int LDT = 36;
#else
constexpr int LDT = 40;
#endif
constexpr int TILE_LDS = 128 * LDT * AS;
constexpr int GEMM_LDS = 2 * TILE_LDS;

__device__ __forceinline__ void acc_zero(f32x4 (&acc)[2][4]) {
#pragma unroll
    for (int i = 0; i < 2; ++i)
#pragma unroll
        for (int j = 0; j < 4; ++j) acc[i][j] = (f32x4){0.f, 0.f, 0.f, 0.f};
}

__device__ __forceinline__ void mma_tile(f32x4 (&acc)[2][4], unsigned char* lds, const act_t* __restrict__ A, int lda,
                                         const act_t* __restrict__ Bt, int ldb, int K, int m0, int n0) {
    const int tid = threadIdx.x, lane = tid & 63, wid = tid >> 6, wm = wid >> 1, wn = wid & 1, fr = lane & 15, fq = lane >> 4;
    act_t* As = (act_t*)lds; act_t* Bs = (act_t*)(lds + TILE_LDS);
    constexpr int EPC = 16 / AS, CPR = BK / EPC, NCH = 128 * CPR / 512;
    u32x4 ra[NCH], rb[NCH];
#pragma unroll
    for (int i = 0; i < NCH; ++i) { const int cidx = tid + 512 * i, row = cidx / CPR, ch = cidx % CPR;
        ra[i] = *(const u32x4*)(A + (size_t)(m0 + row) * lda + ch * EPC);
        rb[i] = *(const u32x4*)(Bt + (size_t)(n0 + row) * ldb + ch * EPC); }
    const int nk = K / BK;
    for (int kt = 0; kt < nk; ++kt) {
        __syncthreads();
#pragma unroll
        for (int i = 0; i < NCH; ++i) { const int cidx = tid + 512 * i, row = cidx / CPR, ch = cidx % CPR;
            *(u32x4*)(As + row * LDT + ch * EPC) = ra[i];
            *(u32x4*)(Bs + row * LDT + ch * EPC) = rb[i]; }
        __syncthreads();
        if (kt + 1 < nk) {
            const int k1 = (kt + 1) * BK;
#pragma unroll
            for (int i = 0; i < NCH; ++i) { const int cidx = tid + 512 * i, row = cidx / CPR, ch = cidx % CPR;
                ra[i] = *(const u32x4*)(A + (size_t)(m0 + row) * lda + k1 + ch * EPC);
                rb[i] = *(const u32x4*)(Bt + (size_t)(n0 + row) * ldb + k1 + ch * EPC); }
        }
#if GOLD
        f32x4 a4[2][2], b4[4][2];
#pragma unroll
        for (int mi = 0; mi < 2; ++mi)
#pragma unroll
            for (int g = 0; g < 2; ++g) a4[mi][g] = *(const f32x4*)(As + (wm * 32 + mi * 16 + fr) * LDT + 16 * g + 4 * fq);
#pragma unroll
        for (int ni = 0; ni < 4; ++ni)
#pragma unroll
            for (int g = 0; g < 2; ++g) b4[ni][g] = *(const f32x4*)(Bs + (wn * 64 + ni * 16 + fr) * LDT + 16 * g + 4 * fq);
#pragma unroll
        for (int mi = 0; mi < 2; ++mi)
#pragma unroll
            for (int ni = 0; ni < 4; ++ni)
#pragma unroll
                for (int g = 0; g < 2; ++g)
#pragma unroll
                    for (int j = 0; j < 4; ++j) acc[mi][ni] = __builtin_amdgcn_mfma_f32_16x16x4f32(b4[ni][g][j], a4[mi][g][j], acc[mi][ni], 0, 0, 0);
#else
        bf16x8 af[2], bfr[4];
#pragma unroll
        for (int mi = 0; mi < 2; ++mi) af[mi] = *(const bf16x8*)(As + (wm * 32 + mi * 16 + fr) * LDT + fq * 8);
#pragma unroll
        for (int ni = 0; ni < 4; ++ni) bfr[ni] = *(const bf16x8*)(Bs + (wn * 64 + ni * 16 + fr) * LDT + fq * 8);
#pragma unroll
        for (int mi = 0; mi < 2; ++mi)
#pragma unroll
            for (int ni = 0; ni < 4; ++ni) acc[mi][ni] = __builtin_amdgcn_mfma_f32_16x16x32_bf16(bfr[ni], af[mi], acc[mi][ni], 0, 0, 0);
#endif
    }
}
template <class F> __device__ __forceinline__ void epi_foreach(const f32x4 (&acc)[2][4], int m0, int n0, F f) {
    const int tid = threadIdx.x, lane = tid & 63, wid = tid >> 6, wm = wid >> 1, wn = wid & 1, fr = lane & 15, fq = lane >> 4;
#pragma unroll
    for (int mi = 0; mi < 2; ++mi)
#pragma unroll
        for (int gp = 0; gp < 2; ++gp) f(m0 + wm * 32 + mi * 16 + fr, n0 + wn * 64 + gp * 32 + 4 * fq, acc[mi][2 * gp], acc[mi][2 * gp + 1]);
}

__device__ __forceinline__ void p0_adaln_item(const Frame& F, int item) {
    float* sc = (float*)F.lds;
    float* part = sc + 9 * 1024;
    __syncthreads();
    for (int e = F.tid; e < 9 * 1024; e += 512) { const int r = e >> 10, kk = e & 1023; const float v = (r < 8) ? F.c[r * DM + kk] : F.c_ctx[kk]; sc[e] = v / (1.0f + expf(-v)); }
    __syncthreads();
    const int col = item * 64 + F.lane, kg = F.wid;
    float a[9];
#pragma unroll
    for (int r = 0; r < 9; ++r) a[r] = 0.f;
    for (int kk = kg * 128; kk < kg * 128 + 128; ++kk) {
        const float w = F.w_ada[(size_t)kk * 6144 + col];
#pragma unroll
        for (int r = 0; r < 9; ++r) a[r] += sc[r * 1024 + kk] * w;
    }
#pragma unroll
    for (int r = 0; r < 9; ++r) part[(kg * 9 + r) * 64 + F.lane] = a[r];
    __syncthreads();
    for (int e = F.tid; e < 9 * 64; e += 512) { const int r = e >> 6, cl = e & 63; float s = F.b_ada[item * 64 + cl];
#pragma unroll
        for (int g = 0; g < 8; ++g) s += part[(g * 9 + r) * 64 + cl];
        F.mod[r * 6144 + item * 64 + cl] = s; }
}
template <class CM> __device__ __forceinline__ void p0_transpose_item(const Frame& F, const float* W, int K, int Nsrc, act_t* dst, int item, int ntn, CM cmap) {
    float* tl = (float*)F.lds;
    const int kb = item / ntn, nb = item % ntn, k0 = kb * 64, n0 = nb * 64;
    __syncthreads();
    { const int j = F.tid & 63, i0 = F.tid >> 6; const int sc = cmap(n0 + j);
#pragma unroll
      for (int i = 0; i < 8; ++i) { const int kk = i0 + 8 * i; tl[kk * 65 + j] = W[(size_t)(k0 + kk) * Nsrc + sc]; } }
    __syncthreads();
    { const int kk = F.tid & 63, nn0 = F.tid >> 6;
#pragma unroll
      for (int i = 0; i < 8; ++i) { const int n = nn0 + 8 * i; st_act(dst + (size_t)(n0 + n) * K + k0 + kk, tl[kk * 65 + n]); } }
}
__device__ __forceinline__ int cmap_in(int n) {
    if (n < 1536 || n >= 2560) return n;
    const int g = (n - 1536) >> 5, e = n & 31;
    return (e < 16) ? (1536 + 16 * g + e) : (2048 + 16 * g + (e - 16));
}
__device__ __forceinline__ void p0_prep(const Frame& F) {
    for (int it = F.bid; it < 96; it += F.G) p0_adaln_item(F, it);
    constexpr int I_IN = 16 * 72, I_OA = 16 * 16, I_OC = 8 * 16, I_OUT = 16 * 16, I_WQ = 16 * 32;
    constexpr int NIT = I_IN + I_OA + I_OC + I_OUT + I_WQ;
    auto ident = [](int n) { return n; };
    for (int it = F.bid; it < NIT; it += F.G) {
        int r = it;
        if (r < I_IN) { p0_transpose_item(F, F.w_in, 1024, INW, F.win_t, r, 72, [](int n) { return cmap_in(n); }); continue; } r -= I_IN;
        if (r < I_OA) { p0_transpose_item(F, F.w_o_attn, 1024, 1024, F.woa_t, r, 16, ident); continue; } r -= I_OA;
        if (r < I_OC) { p0_transpose_item(F, F.w_o_conv, 512, 1024, F.woc_t, r, 16, ident); continue; } r -= I_OC;
        if (r < I_OUT) { p0_transpose_item(F, F.w_out, 1024, 1024, F.wout_t, r, 16, ident); continue; } r -= I_OUT;
        p0_transpose_item(F, F.peer_wq, 1024, PQW, F.wq_t, r, 32, ident);
    }
    for (int e = F.bid * 512 + F.tid; e < 16 * 128 * 128; e += F.G * 512) st_act(F.keys_t + e, F.peer_keys[e]);
    for (int e = F.bid * 512 + F.tid; e < 64 * 16; e += F.G * 512) {
        const int pos = e >> 4, f = e & 15;
        const float freq = powf(10000.0f, -(float)(2 * f) / 32.0f);
        const float ang = (float)pos * freq;
        const double TWO_PI = 6.283185307179586476925286766559;
        double r = (double)ang; r -= TWO_PI * rint(r / TWO_PI);
        const double r2 = r * r;
        double sn = 0.0, cs = 0.0;
        double ts = r, tc = 1.0;
#pragma unroll 1
        for (int n = 0; n < 14; ++n) { sn += ts; cs += tc; ts *= -r2 / (double)((2 * n + 2) * (2 * n + 3)); tc *= -r2 / (double)((2 * n + 1) * (2 * n + 2)); }
        F.rope[e * 2] = (float)cs; F.rope[e * 2 + 1] = (float)sn;
    }
}

__device__ __forceinline__ void p1_norm(const Frame& F) {
    const int gw = F.bid * 8 + F.wid, NGW = F.G * 8;
    for (int r = gw; r < T_ + CT_; r += NGW) {
        const bool isx = r < T_;
        const int rr = isx ? r : r - T_;
        const float* src = isx ? F.x + ((size_t)F.b0 * SEQ + rr) * DM : F.ctx + ((size_t)F.b0 * CTXL + rr) * DM;
        act_t* dst = isx ? F.hx + (size_t)rr * DM : F.hc + (size_t)rr * DM;
        const float* mrow = isx ? F.mod + (size_t)(F.b0 + rr / SEQ) * 6144 : F.mod + (size_t)8 * 6144;
        f32x4 v[4]; float ss = 0.f;
#pragma unroll
        for (int j = 0; j < 4; ++j) { v[j] = *(const f32x4*)(src + j * 256 + F.lane * 4); ss += v[j][0] * v[j][0] + v[j][1] * v[j][1] + v[j][2] * v[j][2] + v[j][3] * v[j][3]; }
        ss = wave_sum(ss);
        const float rstd = 1.0f / sqrtf(ss * (1.0f / DM) + EPS);
#pragma unroll
        for (int j = 0; j < 4; ++j) { const int d = j * 256 + F.lane * 4;
            const f32x4 g = *(const f32x4*)(F.g_pre_mix + d), sh = *(const f32x4*)(mrow + d), sc = *(const f32x4*)(mrow + 1024 + d);
            f32x4 o;
#pragma unroll
            for (int i = 0; i < 4; ++i) o[i] = (v[j][i] * rstd) * g[i] * (1.0f + sc[i]) + sh[i];
            st4(dst + d, o); }
    }
}

__device__ __forceinline__ void p2_inproj(const Frame& F) {
    constexpr int nM = T_ / 128, nN = INW / 128, nMc = CT_ / 128, nNc = 4;
    const int ntile = nM * nN + nMc * nNc;
    for (int t = F.bid; t < ntile; t += F.G) {
        f32x4 acc[2][4]; acc_zero(acc);
        if (t < nM * nN) {
            const int pm = t / nN, pn = t % nN;
            mma_tile(acc, F.lds, F.hx, DM, F.win_t, DM, DM, pm * 128, pn * 128);
            epi_foreach(acc, pm * 128, pn * 128, [&](int r, int c, f32x4 v0, f32x4 v1) {
                const int s = r & (SEQ - 1);
                if (c < 1280) {
                    const int axis = (c >> 5) & 1, pos = axis ? (s & 63) : (s >> 6);
                    const float* rp = F.rope + (pos * 16 + (c & 15)) * 2;
                    const f32x4 cs0 = *(const f32x4*)rp, cs1 = *(const f32x4*)(rp + 4);
                    f32x4 o1, o2;
                    o1[0] = v0[0] * cs0[0] - v1[0] * cs0[1]; o2[0] = v1[0] * cs0[0] + v0[0] * cs0[1];
                    o1[1] = v0[1] * cs0[2] - v1[1] * cs0[3]; o2[1] = v1[1] * cs0[2] + v0[1] * cs0[3];
                    o1[2] = v0[2] * cs1[0] - v1[2] * cs1[1]; o2[2] = v1[2] * cs1[0] + v0[2] * cs1[1];
                    o1[3] = v0[3] * cs1[2] - v1[3] * cs1[3]; o2[3] = v1[3] * cs1[2] + v0[3] * cs1[3];
                    if (c < 1024) { o1 *= QS; o2 *= QS; st4(F.q + (size_t)r * 1024 + c, o1); st4(F.q + (size_t)r * 1024 + c + 16, o2); }
                    else { st4(F.k + (size_t)r * 256 + (c - 1024), o1); st4(F.k + (size_t)r * 256 + (c - 1024) + 16, o2); }
                } else if (c < 1536) {
                    const int cc = c - 1280, hk = cc >> 6, d = cc & 63, bl = r / SEQ;
                    act_t* base = F.vT + ((size_t)(bl * 4 + hk) * 64 + d) * SEQ + s;
#pragma unroll
                    for (int i = 0; i < 4; ++i) { st_act(base + (size_t)i * SEQ, v0[i]); st_act(base + (size_t)(16 + i) * SEQ, v1[i]); }
                } else if (c < 2560) {
                    const int ch = ((c - 1536) >> 5) * 16 + (c & 15);
                    f32x4 o;
#pragma unroll
                    for (int i = 0; i < 4; ++i) o[i] = v0[i] * sigmoidf_(v1[i]);
                    st4(F.u + (size_t)r * 512 + ch, o);
                } else {
                    const int g = c - 2560; f32x4 o0, o1;
#pragma unroll
                    for (int i = 0; i < 4; ++i) { o0[i] = sigmoidf_(v0[i]); o1[i] = sigmoidf_(v1[i]); }
                    st4(F.sg + (size_t)r * 2048 + g, o0); st4(F.sg + (size_t)r * 2048 + g + 16, o1);
                }
            });
        } else {
            const int tt = t - nM * nN, pm = tt / nNc, pn = tt % nNc;
            mma_tile(acc, F.lds, F.hc, DM, F.win_t + (size_t)1024 * DM, DM, DM, pm * 128, pn * 128);
            epi_foreach(acc, pm * 128, pn * 128, [&](int r, int c, f32x4 v0, f32x4 v1) {
                if (c < 256) { st4(F.kc + (size_t)r * 256 + c, v0); st4(F.kc + (size_t)r * 256 + c + 16, v1); }
                else { const int cc = c - 256, hk = cc >> 6, d = cc & 63, bl = r / CTXL, sx = r % CTXL;
                    act_t* base = F.vTc + ((size_t)(bl * 4 + hk) * 64 + d) * CTXL + sx;
#pragma unroll
                    for (int i = 0; i < 4; ++i) { st_act(base + (size_t)i * CTXL, v0[i]); st_act(base + (size_t)(16 + i) * CTXL, v1[i]); } }
            });
        }
    }
}

#if GOLD
__device__ __forceinline__ void p3_attn(const Frame& F) {
    float* qs = (float*)F.lds + F.wid * 64;
    float* ps = (float*)F.lds + 512 + F.wid * 640;
    const int gw = F.bid * 8 + F.wid, NGW = F.G * 8;
    for (int it = gw; it < T_ * NH; it += NGW) {
        const int r = it / NH, head = it % NH, hk = head >> 2, bl = r / SEQ, s = r % SEQ;
        qs[F.lane] = F.q[(size_t)r * 1024 + head * 64 + F.lane];
        const int lo = (s - 128 < 0) ? 0 : s - 128, hi = (s + 128 > SEQ - 1) ? SEQ - 1 : s + 128, nwin = hi - lo + 1, ntot = nwin + CTXL;
        float mx = -1e30f;
        for (int jj = F.lane; jj < ntot; jj += 64) {
            const float* kr = (jj < nwin) ? F.k + ((size_t)(bl * SEQ + lo + jj)) * 256 + hk * 64 : F.kc + ((size_t)(bl * CTXL + jj - nwin)) * 256 + hk * 64;
            float d = 0.f;
            for (int e = 0; e < 64; e += 4) { const f32x4 kv = *(const f32x4*)(kr + e); d += qs[e] * kv[0] + qs[e + 1] * kv[1] + qs[e + 2] * kv[2] + qs[e + 3] * kv[3]; }
            ps[jj] = d; mx = fmaxf(mx, d);
        }
        mx = wave_max(mx);
        float l = 0.f;
        for (int jj = F.lane; jj < ntot; jj += 64) { const float p = exp2f(ps[jj] - mx); ps[jj] = p; l += p; }
        l = wave_sum(l) + exp2f(F.sink[head] * LOG2E - mx);
        const float* vr = F.vT + ((size_t)(bl * 4 + hk) * 64 + F.lane) * SEQ + lo;
        const float* vc = F.vTc + ((size_t)(bl * 4 + hk) * 64 + F.lane) * CTXL;
        float o = 0.f;
        for (int jj = 0; jj < nwin; ++jj) o += ps[jj] * vr[jj];
        for (int jj = 0; jj < CTXL; ++jj) o += ps[nwin + jj] * vc[jj];
        F.att[(size_t)r * 1024 + head * 64 + F.lane] = o / l;
    }
}
#else
__device__ __forceinline__ void p3_attn(const Frame& F) {
    constexpr int KLD = 72;
    bf16_t* Kt = (bf16_t*)F.lds;
    bf16_t* Vt = (bf16_t*)(F.lds + 64 * KLD * 2);
    const int lane = F.lane, l31 = lane & 31, hi = lane >> 5;
    const int g = F.wid >> 1, half = F.wid & 1;
    constexpr int NUNIT = CH_B * NKV * (SEQ / 128);
    for (int un = F.bid; un < NUNIT; un += F.G) {
        const int nb = un & 15, hk = (un >> 4) & 3, bl = un >> 6;
        const int head = hk * 4 + g;
        const int r0 = bl * SEQ + nb * 128 + half * 64;
        bf16x8 qf[2][4];
#pragma unroll
        for (int qt = 0; qt < 2; ++qt)
#pragma unroll
            for (int s = 0; s < 4; ++s) qf[qt][s] = *(const bf16x8*)(F.q + (size_t)(r0 + qt * 32 + l31) * 1024 + head * 64 + s * 16 + 8 * hi);
        float mrun[2] = {-1e30f, -1e30f}, lrun[2] = {0.f, 0.f};
        f32x16 O[2][2];
#pragma unroll
        for (int a = 0; a < 2; ++a)
#pragma unroll
            for (int b = 0; b < 2; ++b)
#pragma unroll
                for (int r = 0; r < 16; ++r) O[a][b][r] = 0.f;
        for (int tile = 0; tile < 10; ++tile) {
            const bool isctx = tile < 4;
            const int ks = isctx ? tile * 64 : nb * 128 - 128 + 64 * (tile - 4);
            if (!isctx && (ks < 0 || ks >= SEQ)) continue;
            __syncthreads();
            { const int row = F.tid >> 3, ch = F.tid & 7;
              const act_t* ksrc = isctx ? F.kc + ((size_t)(bl * CTXL + ks + row)) * 256 + hk * 64 + ch * 8
                                        : F.k + ((size_t)(bl * SEQ + ks + row)) * 256 + hk * 64 + ch * 8;
              const act_t* vsrc = isctx ? F.vTc + ((size_t)(bl * 4 + hk) * 64 + row) * CTXL + ks + ch * 8
                                        : F.vT + ((size_t)(bl * 4 + hk) * 64 + row) * SEQ + ks + ch * 8;
              *(u32x4*)(Kt + row * KLD + ch * 8) = *(const u32x4*)ksrc;
              *(u32x4*)(Vt + row * KLD + ch * 8) = *(const u32x4*)vsrc; }
            __syncthreads();
            const int j = tile - 4;
            const bool need = isctx || (half == 0 ? (j <= 4) : (j >= 1));
            if (need) {
                f32x16 st[2][2];
#pragma unroll
                for (int a = 0; a < 2; ++a)
#pragma unroll
                    for (int b = 0; b < 2; ++b)
#pragma unroll
                        for (int r = 0; r < 16; ++r) st[a][b][r] = 0.f;
#pragma unroll
                for (int s = 0; s < 4; ++s)
#pragma unroll
                    for (int kt = 0; kt < 2; ++kt) {
                        const bf16x8 a = *(const bf16x8*)(Kt + (kt * 32 + l31) * KLD + s * 16 + 8 * hi);
#pragma unroll
                        for (int qt = 0; qt < 2; ++qt) st[kt][qt] = __builtin_amdgcn_mfma_f32_32x32x16_bf16(a, qf[qt][s], st[kt][qt], 0, 0, 0);
                    }
                if (!isctx) {
#pragma unroll
                    for (int kt = 0; kt < 2; ++kt)
#pragma unroll
                        for (int qt = 0; qt < 2; ++qt) {
                            const int qp = nb * 128 + half * 64 + qt * 32 + l31;
#pragma unroll
                            for (int r = 0; r < 16; ++r) { const int kp = ks + kt * 32 + crow(r, hi); const int dd = qp - kp; if (dd > 128 || dd < -128) st[kt][qt][r] = -1e30f; }
                        }
                }
                bf16x8 pf[2][2][2];
#pragma unroll
                for (int qt = 0; qt < 2; ++qt) {
                    float mx = -1e30f;
#pragma unroll
                    for (int kt = 0; kt < 2; ++kt)
#pragma unroll
                        for (int r = 0; r < 16; ++r) mx = fmaxf(mx, st[kt][qt][r]);
                    mx = fmaxf(mx, __shfl_xor(mx, 32));
                    const float mn = fmaxf(mrun[qt], mx);
                    const float alpha = __builtin_amdgcn_exp2f(mrun[qt] - mn);
                    mrun[qt] = mn; lrun[qt] *= alpha;
#pragma unroll
                    for (int dt = 0; dt < 2; ++dt)
#pragma unroll
                        for (int r = 0; r < 16; ++r) O[dt][qt][r] *= alpha;
                    float ls = 0.f;
#pragma unroll
                    for (int kt = 0; kt < 2; ++kt) {
                        float p[16];
#pragma unroll
                        for (int r = 0; r < 16; ++r) { p[r] = __builtin_amdgcn_exp2f(st[kt][qt][r] - mn); ls += p[r]; }
#pragma unroll
                        for (int s2 = 0; s2 < 2; ++s2) {
                            u32x4 w;
                            w[0] = pk2(p[8 * s2 + 0], p[8 * s2 + 1]); w[1] = pk2(p[8 * s2 + 2], p[8 * s2 + 3]);
                            w[2] = pk2(p[8 * s2 + 4], p[8 * s2 + 5]); w[3] = pk2(p[8 * s2 + 6], p[8 * s2 + 7]);
                            pf[kt][s2][qt] = __builtin_bit_cast(bf16x8, w);
                        }
                    }
                    lrun[qt] += ls;
                }
#pragma unroll
                for (int kt = 0; kt < 2; ++kt)
#pragma unroll
                    for (int s2 = 0; s2 < 2; ++s2)
#pragma unroll
                        for (int dt = 0; dt < 2; ++dt) {
                            const bf16_t* vp = Vt + (dt * 32 + l31) * KLD + kt * 32 + s2 * 16 + 4 * hi;
                            const s16x4 lo = *(const s16x4*)vp, hh = *(const s16x4*)(vp + 8);
                            const bf16x8 a = (bf16x8){lo[0], lo[1], lo[2], lo[3], hh[0], hh[1], hh[2], hh[3]};
#pragma unroll
                            for (int qt = 0; qt < 2; ++qt) O[dt][qt] = __builtin_amdgcn_mfma_f32_32x32x16_bf16(a, pf[kt][s2][qt], O[dt][qt], 0, 0, 0);
                        }
            }
        }
        const float sk = F.sink[head] * LOG2E;
#pragma unroll
        for (int qt = 0; qt < 2; ++qt) {
            float lt = lrun[qt] + __shfl_xor(lrun[qt], 32);
            lt += __builtin_amdgcn_exp2f(sk - mrun[qt]);
            const float inv = 1.0f / lt;
            act_t* orow = F.att + (size_t)(r0 + qt * 32 + l31) * 1024 + head * 64;
#pragma unroll
            for (int dt = 0; dt < 2; ++dt)
#pragma unroll
                for (int g4 = 0; g4 < 4; ++g4) {
                    f32x4 o; o[0] = O[dt][qt][4 * g4] * inv; o[1] = O[dt][qt][4 * g4 + 1] * inv; o[2] = O[dt][qt][4 * g4 + 2] * inv; o[3] = O[dt][qt][4 * g4 + 3] * inv;
                    st4(orow + dt * 32 + 8 * g4 + 4 * hi, o);
                }
        }
    }
}
#endif

#if GOLD
constexpr int CTK = 32;
#else
constexpr int CTK = 64;
#endif
__device__ __forceinline__ void p3_conv(const Frame& F) {
    act_t* ub = (act_t*)F.lds;
    float* yb = (float*)(F.lds + (size_t)(CTK + 30) * 512 * AS);
    static_assert((CTK + 30) * 512 * AS + 8 * 512 * 4 <= LDS_MISC, "conv LDS");
    const int c = F.tid;
    float w[CONV_W];
#pragma unroll
    for (int i = 0; i < CONV_W; ++i) w[i] = F.conv_dw[i * CONV_CH + c];
    const float bias = F.conv_dw_b[c];
    constexpr int NT = T_ / CTK;
    for (int t = F.bid; t < NT; t += F.G) {
        const int r0 = t * CTK, bl = r0 / SEQ, s0 = r0 % SEQ;
        __syncthreads();
        constexpr int CPRW = 512 * AS / 16;
        for (int e = F.tid; e < (CTK + 30) * CPRW; e += 512) {
            const int rr = e / CPRW, ch = e % CPRW, sp = s0 + rr - 15;
            u32x4 v = (u32x4){0u, 0u, 0u, 0u};
            if (sp >= 0 && sp < SEQ) v = *(const u32x4*)((const unsigned char*)(F.u + (size_t)(bl * SEQ + sp) * 512) + ch * 16);
            *(u32x4*)((unsigned char*)ub + (size_t)rr * 512 * AS + ch * 16) = v;
        }
        __syncthreads();
        for (int chunk = 0; chunk < CTK / 8; ++chunk) {
#pragma unroll 1
            for (int tt = 0; tt < 8; ++tt) {
                const int tk = chunk * 8 + tt;
                float a = 0.f;
#pragma unroll
                for (int i = 0; i < CONV_W; ++i) a += ld_act(ub + (size_t)(tk + i) * 512 + c) * w[i];
                yb[tt * 512 + c] = a + bias;
            }
            __syncthreads();
            {
                const int tk = chunk * 8 + F.wid;
                float y[8];
                const f32x4 y0 = *(const f32x4*)(yb + F.wid * 512 + F.lane * 8), y1 = *(const f32x4*)(yb + F.wid * 512 + F.lane * 8 + 4);
                y[0] = y0[0]; y[1] = y0[1]; y[2] = y0[2]; y[3] = y0[3]; y[4] = y1[0]; y[5] = y1[1]; y[6] = y1[2]; y[7] = y1[3];
                float s = 0.f;
#pragma unroll
                for (int i = 0; i < 8; ++i) s += y[i];
                const float mean = wave_sum(s) * (1.0f / CONV_CH);
                float q = 0.f;
#pragma unroll
                for (int i = 0; i < 8; ++i) { y[i] -= mean; q += y[i] * y[i]; }
                const float rstd = 1.0f / sqrtf(wave_sum(q) * (1.0f / CONV_CH) + EPS);
                f32x4 o0, o1;
#pragma unroll
                for (int i = 0; i < 8; ++i) { const int ch = F.lane * 8 + i; const float z = y[i] * rstd * F.conv_ln_g[ch] + F.conv_ln_b[ch]; const float o = z * sigmoidf_(z); if (i < 4) o0[i] = o; else o1[i - 4] = o; }
                act_t* dst = F.cact + (size_t)(r0 + tk) * 512 + F.lane * 8;
                st4(dst, o0); st4(dst + 4, o1);
            }
            __syncthreads();
        }
    }
}

__device__ __forceinline__ void p4_merge(const Frame& F) {
    constexpr int nM = T_ / 128, nN = 8;
    for (int t = F.bid; t < nM * nN; t += F.G) {
        const int pm = t / nN, pn = t % nN;
        f32x4 accA[2][4], accC[2][4]; acc_zero(accA); acc_zero(accC);
        mma_tile(accA, F.lds, F.att, 1024, F.woa_t, 1024, 1024, pm * 128, pn * 128);
        mma_tile(accC, F.lds, F.cact, 512, F.woc_t, 512, 512, pm * 128, pn * 128);
        const int lane = F.lane, wm = F.wid >> 1, wn = F.wid & 1, fr = lane & 15, fq = lane >> 4;
#pragma unroll
        for (int mi = 0; mi < 2; ++mi)
#pragma unroll
            for (int ni = 0; ni < 4; ++ni) {
                const int r = pm * 128 + wm * 32 + mi * 16 + fr, c = pn * 128 + wn * 64 + ni * 16 + 4 * fq;
                const f32x4 ga = ld4(F.sg + (size_t)r * 2048 + c), gc = ld4(F.sg + (size_t)r * 2048 + 1024 + c);
                st4(F.m + (size_t)r * 1024 + c, ga * accA[mi][ni] + gc * accC[mi][ni]);
            }
    }
}
__device__ __forceinline__ void p5_out(const Frame& F) {
    constexpr int nM = T_ / 128, nN = 8;
    for (int t = F.bid; t < nM * nN; t += F.G) {
        const int pm = t / nN, pn = t % nN;
        f32x4 acc[2][4]; acc_zero(acc);
        mma_tile(acc, F.lds, F.m, 1024, F.wout_t, 1024, 1024, pm * 128, pn * 128);
        const int lane = F.lane, wm = F.wid >> 1, wn = F.wid & 1, fr = lane & 15, fq = lane >> 4;
#pragma unroll
        for (int mi = 0; mi < 2; ++mi)
#pragma unroll
            for (int ni = 0; ni < 4; ++ni) {
                const int r = pm * 128 + wm * 32 + mi * 16 + fr, c = pn * 128 + wn * 64 + ni * 16 + 4 * fq;
                *(f32x4*)(F.mixed + (size_t)r * 1024 + c) = acc[mi][ni];
            }
    }
}
__device__ __forceinline__ void p6_rows(const Frame& F) {
    const int gw = F.bid * 8 + F.wid, NGW = F.G * 8;
    for (int r = gw; r < T_; r += NGW) {
        const float* mrow = F.mod + (size_t)(F.b0 + r / SEQ) * 6144;
        const float* xr = F.x + ((size_t)F.b0 * SEQ + r) * DM;
        float* outr = F.out + ((size_t)F.b0 * SEQ + r) * DM;
        f32x4 mv[4], x1[4]; float ss = 0.f;
#pragma unroll
        for (int j = 0; j < 4; ++j) { mv[j] = *(const f32x4*)(F.mixed + (size_t)r * 1024 + j * 256 + F.lane * 4); ss += mv[j][0] * mv[j][0] + mv[j][1] * mv[j][1] + mv[j][2] * mv[j][2] + mv[j][3] * mv[j][3]; }
        const float rstd = 1.0f / sqrtf(wave_sum(ss) * (1.0f / DM) + EPS);
        float s1 = 0.f;
#pragma unroll
        for (int j = 0; j < 4; ++j) { const int d = j * 256 + F.lane * 4;
            const f32x4 xv = *(const f32x4*)(xr + d), g = *(const f32x4*)(F.g_post_mix + d), gt = *(const f32x4*)(mrow + 2048 + d);
#pragma unroll
            for (int i = 0; i < 4; ++i) { x1[j][i] = xv[i] + gt[i] * ((mv[j][i] * rstd) * g[i]); s1 += x1[j][i] * x1[j][i]; }
            *(f32x4*)(outr + d) = x1[j]; }
        const float rstd1 = 1.0f / sqrtf(wave_sum(s1) * (1.0f / DM) + EPS);
#pragma unroll
        for (int j = 0; j < 4; ++j) { const int d = j * 256 + F.lane * 4;
            const f32x4 g = *(const f32x4*)(F.g_pre_ffn + d), sh = *(const f32x4*)(mrow + 3072 + d), sc = *(const f32x4*)(mrow + 4096 + d);
            f32x4 o;
#pragma unroll
            for (int i = 0; i < 4; ++i) o[i] = (x1[j][i] * rstd1) * g[i] * (1.0f + sc[i]) + sh[i];
            st4(F.h2 + (size_t)r * 1024 + d, o); }
    }
}
__device__ __forceinline__ void p7_wq(const Frame& F) {
    constexpr int nM = T_ / 128, nN = PQW / 128;
    for (int t = F.bid; t < nM * nN; t += F.G) {
        const int pm = t / nN, pn = t % nN;
        f32x4 acc[2][4]; acc_zero(acc);
        mma_tile(acc, F.lds, F.h2, 1024, F.wq_t, 1024, 1024, pm * 128, pn * 128);
        const int lane = F.lane, wm = F.wid >> 1, wn = F.wid & 1, fr = lane & 15, fq = lane >> 4;
#pragma unroll
        for (int mi = 0; mi < 2; ++mi)
#pragma unroll
            for (int ni = 0; ni < 4; ++ni) {
                const int r = pm * 128 + wm * 32 + mi * 16 + fr, c = pn * 128 + wn * 64 + ni * 16 + 4 * fq;
                st4(F.pq + (size_t)r * PQW + c, acc[mi][ni]);
            }
    }
#if !GOLD
    for (size_t e = (size_t)F.bid * 512 + F.tid; e < (size_t)NEXP * 1024 / 4; e += (size_t)F.G * 512) {
        const f32x4 a = *(const f32x4*)(F.peer_u + e * 4), b = *(const f32x4*)(F.peer_v + e * 4);
        u32x2 wa, wb; wa[0] = pk2(a[0], a[1]); wa[1] = pk2(a[2], a[3]); wb[0] = pk2(b[0], b[1]); wb[1] = pk2(b[2], b[3]);
        *(u32x2*)(F.pu16 + e * 4) = wa; *(u32x2*)(F.pv16 + e * 4) = wb;
    }
#endif
}
__device__ __forceinline__ void p8_scores(const Frame& F) {
    constexpr int SLD = 132;
    float* st = (float*)(F.lds + GEMM_LDS);
    static_assert(GEMM_LDS + 128 * SLD * 4 <= LDS_MISC, "scores LDS");
    constexpr int nM = T_ / 128;
    for (int t = F.bid; t < nM * 16; t += F.G) {
        const int pm = t / 16, hp = t % 16;
        f32x4 acc[2][4]; acc_zero(acc);
        mma_tile(acc, F.lds, F.pq + hp * 128, PQW, F.keys_t + (size_t)hp * 128 * 128, 128, 128, pm * 128, 0);
        const int lane = F.lane, wm = F.wid >> 1, wn = F.wid & 1, fr = lane & 15, fq = lane >> 4;
#pragma unroll
        for (int mi = 0; mi < 2; ++mi)
#pragma unroll
            for (int ni = 0; ni < 4; ++ni) *(f32x4*)(st + (wm * 32 + mi * 16 + fr) * SLD + wn * 64 + ni * 16 + 4 * fq) = acc[mi][ni];
        __syncthreads();
        for (int rr = 0; rr < 16; ++rr) {
            const int row = F.wid * 16 + rr;
            const float* sr = st + row * SLD;
            const float v0 = sr[lane], v1 = sr[lane + 64];
            int c0 = 0, c1 = 0;
            for (int j4 = 0; j4 < 128; j4 += 4) {
                const f32x4 sj = *(const f32x4*)(sr + j4);
#pragma unroll
                for (int i = 0; i < 4; ++i) { const int j = j4 + i;
                    c0 += (sj[i] > v0 || (sj[i] == v0 && j < lane)) ? 1 : 0;
                    c1 += (sj[i] > v1 || (sj[i] == v1 && j < lane + 64)) ? 1 : 0; }
            }
            const size_t ob = ((size_t)(pm * 128 + row) * 16 + hp) * 16;
            if (c0 < 16) { F.topv[ob + c0] = v0; F.topi[ob + c0] = lane; }
            if (c1 < 16) { F.topv[ob + c1] = v1; F.topi[ob + c1] = lane + 64; }
        }
    }
}
__device__ __forceinline__ void p9_topk2(const Frame& F) {
    const int gw = F.bid * 8 + F.wid, NGW = F.G * 8, c = F.lane;
    int ci, cj;
    if (c < 16) { ci = 0; cj = c; } else if (c < 24) { ci = 1; cj = c - 16; } else if (c < 29) { ci = 2; cj = c - 24; } else if (c < 33) { ci = 3; cj = c - 29; }
    else if (c < 36) { ci = 4; cj = c - 33; } else if (c < 42) { ci = 5 + ((c - 36) >> 1); cj = (c - 36) & 1; } else { ci = 8 + (c - 42); cj = 0; }
    const bool valid = c < 50;
    if (!valid) { ci = 0; cj = 0; }
    for (int it = gw; it < T_ * 8; it += NGW) {
        const int r = it >> 3, h = it & 7;
        const size_t oa = ((size_t)r * 16 + 2 * h) * 16, ob = oa + 16;
        const float val = valid ? (F.topv[oa + ci] + F.topv[ob + cj]) : -INFINITY;
        const int pos = valid ? ci * 16 + cj : 1000;
        int rank = 0;
#pragma unroll
        for (int cc = 0; cc < 50; ++cc) {
            const float ov = __uint_as_float(__builtin_amdgcn_readlane(__float_as_uint(val), cc));
            const int op = __builtin_amdgcn_readlane(pos, cc);
            rank += (ov > val || (ov == val && op < pos)) ? 1 : 0;
        }
        const bool sel = valid && rank < 16;
        const float mx = wave_max(sel ? val : -INFINITY);
        const float e = sel ? expf(val - mx) : 0.f;
        const float sum = wave_sum(e);
        if (sel) { const size_t o = (size_t)r * 128 + h * 16 + rank; F.pei[o] = F.topi[oa + ci] * 128 + F.topi[ob + cj]; F.peg[o] = e / sum; }
    }
}
__device__ __forceinline__ void p10_experts(const Frame& F) {
    const int gw = F.bid * 8 + F.wid, NGW = F.G * 8, lane = F.lane;
#if GOLD
    constexpr int EPL = 4, NLD = 4;
    const float* TU = F.peer_u; const float* TV = F.peer_v;
#else
    constexpr int EPL = 8, NLD = 2;
    const bf16_t* TU = F.pu16; const bf16_t* TV = F.pv16;
#endif
    for (int r = gw; r < T_; r += NGW) {
        float hv[NLD][EPL], acc[NLD][EPL];
#pragma unroll
        for (int j = 0; j < NLD; ++j)
#pragma unroll
            for (int i = 0; i < EPL; ++i) { hv[j][i] = ld_act(F.h2 + (size_t)r * 1024 + j * 64 * EPL + lane * EPL + i); acc[j][i] = 0.f; }
        const int id0 = F.pei[(size_t)r * 128 + lane], id1 = F.pei[(size_t)r * 128 + 64 + lane];
        const float g0 = F.peg[(size_t)r * 128 + lane], g1 = F.peg[(size_t)r * 128 + 64 + lane];
        for (int e = 0; e < 128; ++e) {
            const int idx = __shfl((e < 64) ? id0 : id1, e & 63);
            const float gt = __shfl((e < 64) ? g0 : g1, e & 63);
            float uv[NLD][EPL], vv[NLD][EPL];
#pragma unroll
            for (int j = 0; j < NLD; ++j) {
#if GOLD
                const f32x4 a = *(const f32x4*)(TU + (size_t)idx * 1024 + j * 256 + lane * 4), b = *(const f32x4*)(TV + (size_t)idx * 1024 + j * 256 + lane * 4);
#pragma unroll
                for (int i = 0; i < 4; ++i) { uv[j][i] = a[i]; vv[j][i] = b[i]; }
#else
                const u32x4 a = *(const u32x4*)(TU + (size_t)idx * 1024 + j * 512 + lane * 8), b = *(const u32x4*)(TV + (size_t)idx * 1024 + j * 512 + lane * 8);
#pragma unroll
                for (int i = 0; i < 4; ++i) { uv[j][2 * i] = __uint_as_float(a[i] << 16); uv[j][2 * i + 1] = __uint_as_float(a[i] & 0xffff0000u);
                                              vv[j][2 * i] = __uint_as_float(b[i] << 16); vv[j][2 * i + 1] = __uint_as_float(b[i] & 0xffff0000u); }
#endif
            }
            float d = 0.f;
#pragma unroll
            for (int j = 0; j < NLD; ++j)
#pragma unroll
                for (int i = 0; i < EPL; ++i) d += uv[j][i] * hv[j][i];
            d = wave_sum(d);
            const float act = 0.5f * d * (1.0f + erff(d * 0.70710678118654752f));
            const float wgt = gt * act;
#pragma unroll
            for (int j = 0; j < NLD; ++j)
#pragma unroll
                for (int i = 0; i < EPL; ++i) acc[j][i] += wgt * vv[j][i];
        }
        float ss = 0.f;
#pragma unroll
        for (int j = 0; j < NLD; ++j)
#pragma unroll
            for (int i = 0; i < EPL; ++i) ss += acc[j][i] * acc[j][i];
        const float rstd = 1.0f / sqrtf(wave_sum(ss) * (1.0f / DM) + EPS);
        const float* mrow = F.mod + (size_t)(F.b0 + r / SEQ) * 6144 + 5120;
        float* outr = F.out + ((size_t)F.b0 * SEQ + r) * DM;
#pragma unroll
        for (int j = 0; j < NLD; ++j)
#pragma unroll
            for (int i4 = 0; i4 < EPL; i4 += 4) { const int d0 = j * 64 * EPL + lane * EPL + i4;
                const f32x4 x1 = *(const f32x4*)(outr + d0), g = *(const f32x4*)(F.g_post_ffn + d0), gt2 = *(const f32x4*)(mrow + d0);
                f32x4 o;
#pragma unroll
                for (int i = 0; i < 4; ++i) o[i] = x1[i] + gt2[i] * ((acc[j][i4 + i] * rstd) * g[i]);
                *(f32x4*)(outr + d0) = o; }
    }
}

__global__ void __launch_bounds__(512, 2) fwd_kernel(Args a) {
    extern __shared__ __attribute__((aligned(16))) unsigned char lds[];
    Frame F;
    F.lds = lds; F.tid = threadIdx.x; F.lane = F.tid & 63; F.wid = __builtin_amdgcn_readfirstlane(F.tid >> 6); F.G = gridDim.x; F.bid = blockIdx.x; F.b0 = a.b0;
    F.x = a.in[0]; F.c = a.in[1]; F.ctx = a.in[2]; F.c_ctx = a.in[3]; F.w_ada = a.in[4]; F.b_ada = a.in[5]; F.g_pre_mix = a.in[6]; F.g_post_mix = a.in[7];
    F.g_pre_ffn = a.in[8]; F.g_post_ffn = a.in[9]; F.w_in = a.in[10]; F.sink = a.in[11]; F.w_o_attn = a.in[12]; F.conv_dw = a.in[13]; F.conv_dw_b = a.in[14];
    F.conv_ln_g = a.in[15]; F.conv_ln_b = a.in[16]; F.w_o_conv = a.in[17]; F.w_out = a.in[18]; F.peer_wq = a.in[19]; F.peer_keys = a.in[20]; F.peer_u = a.in[21]; F.peer_v = a.in[22];
    F.out = a.out;
    unsigned char* ws = a.ws;
    F.mod = (float*)(ws + WS_MOD); F.rope = (float*)(ws + WS_ROPE);
    F.win_t = (act_t*)(ws + WS_WIN); F.woa_t = (act_t*)(ws + WS_WOA); F.woc_t = (act_t*)(ws + WS_WOC); F.wout_t = (act_t*)(ws + WS_WOUT); F.wq_t = (act_t*)(ws + WS_WQ); F.keys_t = (act_t*)(ws + WS_KEYS);
    F.q = (act_t*)(ws + O_Q); F.k = (act_t*)(ws + O_K); F.vT = (act_t*)(ws + O_VT); F.u = (act_t*)(ws + O_U); F.sg = (act_t*)(ws + O_SG); F.kc = (act_t*)(ws + O_KC); F.vTc = (act_t*)(ws + O_VTC);
    F.att = (act_t*)(ws + O_ATT); F.cact = (act_t*)(ws + O_CACT); F.hx = (act_t*)(ws + O_HX); F.hc = (act_t*)(ws + O_HC); F.m = (act_t*)(ws + O_M); F.h2 = (act_t*)(ws + O_H2); F.pq = (act_t*)(ws + O_PQ);
    F.mixed = (float*)(ws + O_MIXED); F.topv = (float*)(ws + O_TOPV); F.topi = (int*)(ws + O_TOPI); F.pei = (int*)(ws + O_PEI); F.peg = (float*)(ws + O_PEG);
    F.pu16 = (bf16_t*)(ws + O_PU); F.pv16 = (bf16_t*)(ws + O_PV);

    volatile LAS unsigned* misc = (volatile LAS unsigned*)(LAS unsigned char*)(lds + LDS_MISC);
    if (F.tid < 64) misc[F.tid] = 0u;
    __syncthreads();
    const int lo = a.ph_lo, hi = a.ph_hi;
    XcdBarrier bar; bar.bar = (unsigned*)(ws + WS_CTL); bar.x = 0; bar.st = misc;
    if (hi - lo > 1) bar = xcd_barrier_post((unsigned*)(ws + WS_CTL), misc);
#define IN(k) (lo <= (k) && (k) < hi)
#define SEAM(k) do { if (IN(k) && IN((k) + 1)) xcd_barrier(bar); } while (0)
    if (IN(0)) { p0_prep(F); } SEAM(0);
    if (IN(1)) { p1_norm(F); } SEAM(1);
    if (IN(2)) { p2_inproj(F); } SEAM(2);
    if (IN(3)) { p3_attn(F); __syncthreads(); p3_conv(F); } SEAM(3);
    if (IN(4)) { p4_merge(F); } SEAM(4);
    if (IN(5)) { p5_out(F); } SEAM(5);
    if (IN(6)) { p6_rows(F); } SEAM(6);
    if (IN(7)) { p7_wq(F); } SEAM(7);
    if (IN(8)) { p8_scores(F); } SEAM(8);
    if (IN(9)) { p9_topk2(F); } SEAM(9);
    if (IN(10)) { p10_experts(F); }
#undef IN
#undef SEAM
}

extern "C" void kernel_launch(void* const* d_in, const int* in_sizes, int n_in, void* d_out, int out_size, void* d_ws, size_t ws_size, hipStream_t stream) {
    static int grid = 0;
    if (grid == 0) {
        if (n_in != 23 || ws_size < WS_END) { fprintf(stderr, "kernel_launch: need 23 inputs and %zu B of workspace (got %d, %zu)\n", (size_t)WS_END, n_in, ws_size); grid = -1; return; }
        int dev = 0, cus = 0;
        if (hipGetDevice(&dev) != hipSuccess || hipDeviceGetAttribute(&cus, hipDeviceAttributeMultiprocessorCount, dev) != hipSuccess) { grid = -1; return; }
        if (hipFuncSetAttribute((const void*)fwd_kernel, hipFuncAttributeMaxDynamicSharedMemorySize, LDS_BYTES) != hipSuccess) { fprintf(stderr, "kernel_launch: hipFuncSetAttribute failed\n"); grid = -1; return; }
        grid = cus;
    }
    if (grid < 0) return;
    (void)hipMemsetAsync((char*)d_ws + WS_CTL, 0, CTL_BYTES, stream);
    Args a{};
    for (int i = 0; i < 23; ++i) a.in[i] = (const float*)d_in[i];
    a.out = (float*)d_out; a.ws = (unsigned char*)d_ws;
#if ONE_LAUNCH
    a.ph_lo = 0; a.ph_hi = NPHASE; a.b0 = 0;
    hipLaunchKernelGGL(fwd_kernel, dim3(grid), dim3(512), LDS_BYTES, stream, a);
#else
    a.ph_lo = 0; a.ph_hi = 1; a.b0 = 0;
    hipLaunchKernelGGL(fwd_kernel, dim3(grid), dim3(512), LDS_BYTES, stream, a);
    for (int b0 = 0; b0 < BATCH; b0 += CH_B)
        for (int ph = 1; ph < NPHASE; ++ph) { a.ph_lo = ph; a.ph_hi = ph + 1; a.b0 = b0; hipLaunchKernelGGL(fwd_kernel, dim3(grid), dim3(512), LDS_BYTES, stream, a); }
#endif
}
```

```cpp
#include <hip/hip_runtime.h>
#include <cstdint>
#include <cstdio>

#ifndef GOLD
#define GOLD 0
#endif
#ifndef ONE_LAUNCH
#define ONE_LAUNCH 1
#endif

typedef unsigned short bf16_t;
typedef short bf16x8 __attribute__((ext_vector_type(8)));
typedef short s16x4 __attribute__((ext_vector_type(4)));
typedef float f32x4 __attribute__((ext_vector_type(4)));
typedef float f32x16 __attribute__((ext_vector_type(16)));
typedef unsigned u32x2 __attribute__((ext_vector_type(2)));
typedef unsigned u32x4 __attribute__((ext_vector_type(4)));
typedef float f32x2 __attribute__((ext_vector_type(2)));

#if GOLD
typedef float act_t;
#else
typedef bf16_t act_t;
#endif
constexpr int AS = sizeof(act_t);

constexpr int DM = 1024, BATCH = 8, SEQ = 2048, CTXL = 256, NH = 16, NKV = 4, HD = 64;
constexpr int INW = 4608, PQW = 2048, NEXP = 16384;
constexpr int CONV_CH = 512, CONV_W = 31;
constexpr float EPS = 1e-6f;
constexpr float LOG2E = 1.4426950408889634f;
constexpr float QS = 0.125f * LOG2E;
#if GOLD
constexpr int CH_B = 1;
#else
constexpr int CH_B = 8;
#endif
constexpr int T_ = CH_B * SEQ;
constexpr int CT_ = CH_B * CTXL;
constexpr int NPHASE = 11;

constexpr size_t MiB = 1u << 20;
constexpr size_t WS_CTL = 0, CTL_BYTES = 1 * MiB;
constexpr size_t WS_MOD = 512 * 1024;
constexpr size_t WS_ROPE = 1 * MiB;
constexpr size_t WS_WIN = 2 * MiB;
constexpr size_t WS_WOA = 22 * MiB;
constexpr size_t WS_WOC = 26 * MiB;
constexpr size_t WS_WOUT = 28 * MiB;
constexpr size_t WS_WQ = 32 * MiB;
constexpr size_t WS_KEYS = 40 * MiB;
constexpr size_t AR = 42 * MiB;
constexpr size_t A0 = AR;
constexpr size_t O_Q = A0;
constexpr size_t O_K = O_Q + (size_t)T_ * 1024 * AS;
constexpr size_t O_VT = O_K + (size_t)T_ * 256 * AS;
constexpr size_t O_U = O_VT + (size_t)T_ * 256 * AS;
constexpr size_t O_SG = O_U + (size_t)T_ * 512 * AS;
constexpr size_t O_KC = O_SG + (size_t)T_ * 2048 * AS;
constexpr size_t O_VTC = O_KC + (size_t)CT_ * 256 * AS;
constexpr size_t A0_END = O_VTC + (size_t)CT_ * 256 * AS;
constexpr size_t O_MIXED = A0;
constexpr size_t O_PQ = A0 + (size_t)T_ * 4096;
constexpr size_t O_TOPV = A0;
constexpr size_t O_TOPI = A0 + (size_t)T_ * 1024;
constexpr size_t O_PV = A0 + 32 * MiB;
constexpr size_t A1 = A0_END;
constexpr size_t O_ATT = A1;
constexpr size_t O_CACT = O_ATT + (size_t)T_ * 1024 * AS;
constexpr size_t A1_END = O_CACT + (size_t)T_ * 512 * AS;
constexpr size_t O_HX = A1;
constexpr size_t O_HC = A1 + (size_t)T_ * 1024 * AS;
constexpr size_t O_PU = A1;
constexpr size_t O_PEI = O_CACT;
constexpr size_t O_PEG = O_CACT + (size_t)T_ * 512;
constexpr size_t A2 = A1_END;
constexpr size_t O_M = A2;
constexpr size_t O_H2 = A2;
constexpr size_t WS_END = A2 + (size_t)T_ * 1024 * AS;
static_assert(O_PQ + (size_t)T_ * 2048 * AS <= A0_END, "pq overlay");
static_assert(O_TOPI + (size_t)T_ * 1024 <= O_PQ, "topk overlay");
static_assert(GOLD || (O_PV >= O_TOPI + (size_t)T_ * 1024 && O_PV + 32 * MiB <= O_PQ), "pv overlay");
static_assert(GOLD || (O_PU + 32 * MiB <= O_PEI), "pu overlay");
static_assert(O_PEG + (size_t)T_ * 512 <= A1_END, "pe overlay");
static_assert(O_HC + (size_t)CT_ * 1024 * AS <= A1_END, "hc overlay");

constexpr int LDS_BYTES = 147456;
constexpr int LDS_MISC = LDS_BYTES - 256;

__device__ __forceinline__ float bf2f(bf16_t h) { return __uint_as_float((unsigned)h << 16); }
__device__ __forceinline__ unsigned f2bf(float f) { unsigned u = __float_as_uint(f); return (u + 0x7fffu + ((u >> 16) & 1u)) >> 16; }
__device__ __forceinline__ unsigned pk2(float lo, float hi) { return f2bf(lo) | (f2bf(hi) << 16); }
#if GOLD
__device__ __forceinline__ float ld_act(const act_t* p) { return *p; }
__device__ __forceinline__ void st_act(act_t* p, float v) { *p = v; }
__device__ __forceinline__ f32x4 ld4(const act_t* p) { return *(const f32x4*)p; }
__device__ __forceinline__ void st4(act_t* p, f32x4 v) { *(f32x4*)p = v; }
#else
__device__ __forceinline__ float ld_act(const act_t* p) { return bf2f(*p); }
__device__ __forceinline__ void st_act(act_t* p, float v) { *p = (bf16_t)f2bf(v); }
__device__ __forceinline__ f32x4 ld4(const act_t* p) { u32x2 w = *(const u32x2*)p; f32x4 r; r[0] = __uint_as_float(w[0] << 16); r[1] = __uint_as_float(w[0] & 0xffff0000u); r[2] = __uint_as_float(w[1] << 16); r[3] = __uint_as_float(w[1] & 0xffff0000u); return r; }
__device__ __forceinline__ void st4(act_t* p, f32x4 v) { u32x2 w; w[0] = pk2(v[0], v[1]); w[1] = pk2(v[2], v[3]); *(u32x2*)p = w; }
#endif
__device__ __forceinline__ float wave_sum(float v) {
#pragma unroll
    for (int o = 1; o < 64; o <<= 1) v += __shfl_xor(v, o);
    return v;
}
__device__ __forceinline__ float wave_max(float v) {
#pragma unroll
    for (int o = 1; o < 64; o <<= 1) v = fmaxf(v, __shfl_xor(v, o));
    return v;
}
__device__ __forceinline__ float sigmoidf_(float x) { return 1.0f / (1.0f + expf(-x)); }
__device__ __forceinline__ int crow(int r, int hi) { return (r & 3) + 8 * (r >> 2) + 4 * hi; }

#define LAS __attribute__((address_space(3)))
#define XB_TMO      128
#define XB_XCNT(j)  (256  + 64 * (j))
#define XB_XSUB(j)  (1280 + 64 * (j))
#define XB_XGEN(j)  (2304 + 64 * (j))
#define XB_TOP      3328
#define XB_TOPGEN   3392
#define XCD_BAR_WORDS 3456
#define XB_SPIN_CAP (1u << 18)
__device__ __forceinline__ unsigned xb_ld(unsigned* p)              { return __hip_atomic_load(p, __ATOMIC_RELAXED, __HIP_MEMORY_SCOPE_AGENT); }
__device__ __forceinline__ unsigned xb_add(unsigned* p, unsigned v) { return __hip_atomic_fetch_add(p, v, __ATOMIC_RELAXED, __HIP_MEMORY_SCOPE_AGENT); }
__device__ __forceinline__ unsigned xb_xcc_id() { return (unsigned)__builtin_amdgcn_s_getreg((3 << 11) | 20) & 0xFu; }
#define XB_SPIN(cond, bar) do { unsigned _sp = 0; while (cond) { __builtin_amdgcn_s_sleep(1); \
    if ((++_sp & 255u) == 0u) { if (xb_ld(&(bar)[XB_TMO])) break; if (_sp > XB_SPIN_CAP) { atomicAdd(&(bar)[XB_TMO], 1u); break; } } } } while (0)
struct XcdBarrier { unsigned* bar; unsigned x; volatile LAS unsigned* st; };
__device__ __forceinline__ XcdBarrier xcd_barrier_post(unsigned* bar, volatile LAS unsigned* st) {
    XcdBarrier b; b.bar = bar; b.x = xb_xcc_id(); b.st = st;
    if (threadIdx.x == 0) (void)xb_add(&bar[XB_XCNT(b.x)], 1u);
    return b;
}
__device__ __forceinline__ void xcd_barrier_complete(unsigned* bar, unsigned x, unsigned& nloc, unsigned& nx) {
    const unsigned G = gridDim.x * gridDim.y * gridDim.z;
    unsigned sum, cnt, mine, sp = 0u;
    for (;;) {
        sum = 0u; cnt = 0u; mine = 0u;
#pragma unroll
        for (unsigned j = 0; j < 16; ++j) { const unsigned c = xb_ld(&bar[XB_XCNT(j)]); sum += c; cnt += (c > 0u) ? 1u : 0u; mine = (j == x) ? c : mine; }
        if (sum == G) break;
        __builtin_amdgcn_s_sleep(1);
        if ((++sp & 255u) == 0u) { if (xb_ld(&bar[XB_TMO])) break; if (sp > XB_SPIN_CAP) { atomicAdd(&bar[XB_TMO], 1u); break; } }
    }
    nloc = mine > 0u ? mine : 1u; nx = cnt > 0u ? cnt : 1u;
}
__device__ __forceinline__ void xcd_barrier(const XcdBarrier& b) {
    asm volatile("s_waitcnt vmcnt(0)" ::: "memory");
    __syncthreads();
    if (threadIdx.x == 0) {
        unsigned* bar = b.bar;
        __builtin_amdgcn_s_waitcnt(0);
        unsigned nloc = b.st[0], nx = b.st[1];
        if (nloc == 0u) { xcd_barrier_complete(bar, b.x, nloc, nx); b.st[0] = nloc; b.st[1] = nx; }
        const unsigned old = xb_add(&bar[XB_XSUB(b.x)], 1u);
        const unsigned gen = old / nloc;
        if (old + 1u == (gen + 1u) * nloc) {
            __builtin_amdgcn_fence(__ATOMIC_RELEASE, "agent");
            asm volatile("s_waitcnt vmcnt(0)" ::: "memory");
            const unsigned og = xb_add(&bar[XB_TOP], 1u);
            const unsigned tg = og / nx;
            if (og + 1u == (tg + 1u) * nx) xb_add(&bar[XB_TOPGEN], 1u);
            else XB_SPIN(xb_ld(&bar[XB_TOPGEN]) == tg, bar);
            __builtin_amdgcn_fence(__ATOMIC_ACQUIRE, "agent");
            xb_add(&bar[XB_XGEN(b.x)], 1u);
            asm volatile("s_waitcnt vmcnt(0)" ::: "memory");
        } else {
            XB_SPIN(xb_ld(&bar[XB_XGEN(b.x)]) == gen, bar);
            __builtin_amdgcn_fence(__ATOMIC_ACQUIRE, "agent");
            asm volatile("s_waitcnt vmcnt(0)" ::: "memory");
        }
    }
    __syncthreads();
}

struct Args { const float* in[23]; float* out; unsigned char* ws; int ph_lo, ph_hi, b0, pad; };

struct Frame {
    unsigned char* lds;
    int tid, lane, wid, G, bid;
    int b0;
    const float *x, *c, *ctx, *c_ctx, *w_ada, *b_ada, *g_pre_mix, *g_post_mix, *g_pre_ffn, *g_post_ffn, *w_in, *sink, *w_o_attn,
        *conv_dw, *conv_dw_b, *conv_ln_g, *conv_ln_b, *w_o_conv, *w_out, *peer_wq, *peer_keys, *peer_u, *peer_v;
    float* out;
    float* mod; float* rope;
    act_t *win_t, *woa_t, *woc_t, *wout_t, *wq_t, *keys_t;
    act_t *q, *k, *vT, *u, *sg, *kc, *vTc, *att, *cact, *hx, *hc, *m, *h2, *pq;
    float *mixed, *topv, *peg; int *topi, *pei;
    unsigned char *pu8, *pv8;
};

constexpr int BK = 32;
#if GOLD
constexpr int LDT = 36;
#else
constexpr int LDT = 40;
#endif
constexpr int TILE_LDS = 128 * LDT * AS;
constexpr int GEMM_LDS = 2 * TILE_LDS;

__device__ __forceinline__ void acc_zero(f32x4 (&acc)[2][4]) {
#pragma unroll
    for (int i = 0; i < 2; ++i)
#pragma unroll
        for (int j = 0; j < 4; ++j) acc[i][j] = (f32x4){0.f, 0.f, 0.f, 0.f};
}

__device__ __forceinline__ void mma_tile(f32x4 (&acc)[2][4], unsigned char* lds, const act_t* __restrict__ A, int lda,
                                         const act_t* __restrict__ Bt, int ldb, int K, int m0, int n0) {
    const int tid = threadIdx.x, lane = tid & 63, wid = tid >> 6, wm = wid >> 1, wn = wid & 1, fr = lane & 15, fq = lane >> 4;
    act_t* As = (act_t*)lds; act_t* Bs = (act_t*)(lds + TILE_LDS);
    constexpr int EPC = 16 / AS, CPR = BK / EPC, NCH = 128 * CPR / 512;
    u32x4 ra[NCH], rb[NCH];
#pragma unroll
    for (int i = 0; i < NCH; ++i) { const int cidx = tid + 512 * i, row = cidx / CPR, ch = cidx % CPR;
        ra[i] = *(const u32x4*)(A + (size_t)(m0 + row) * lda + ch * EPC);
        rb[i] = *(const u32x4*)(Bt + (size_t)(n0 + row) * ldb + ch * EPC); }
    const int nk = K / BK;
    for (int kt = 0; kt < nk; ++kt) {
        __syncthreads();
#pragma unroll
        for (int i = 0; i < NCH; ++i) { const int cidx = tid + 512 * i, row = cidx / CPR, ch = cidx % CPR;
            *(u32x4*)(As + row * LDT + ch * EPC) = ra[i];
            *(u32x4*)(Bs + row * LDT + ch * EPC) = rb[i]; }
        __syncthreads();
        if (kt + 1 < nk) {
            const int k1 = (kt + 1) * BK;
#pragma unroll
            for (int i = 0; i < NCH; ++i) { const int cidx = tid + 512 * i, row = cidx / CPR, ch = cidx % CPR;
                ra[i] = *(const u32x4*)(A + (size_t)(m0 + row) * lda + k1 + ch * EPC);
                rb[i] = *(const u32x4*)(Bt + (size_t)(n0 + row) * ldb + k1 + ch * EPC); }
        }
#if GOLD
        f32x4 a4[2][2], b4[4][2];
#pragma unroll
        for (int mi = 0; mi < 2; ++mi)
#pragma unroll
            for (int g = 0; g < 2; ++g) a4[mi][g] = *(const f32x4*)(As + (wm * 32 + mi * 16 + fr) * LDT + 16 * g + 4 * fq);
#pragma unroll
        for (int ni = 0; ni < 4; ++ni)
#pragma unroll
            for (int g = 0; g < 2; ++g) b4[ni][g] = *(const f32x4*)(Bs + (wn * 64 + ni * 16 + fr) * LDT + 16 * g + 4 * fq);
#pragma unroll
        for (int mi = 0; mi < 2; ++mi)
#pragma unroll
            for (int ni = 0; ni < 4; ++ni)
#pragma unroll
                for (int g = 0; g < 2; ++g)
#pragma unroll
                    for (int j = 0; j < 4; ++j) acc[mi][ni] = __builtin_amdgcn_mfma_f32_16x16x4f32(b4[ni][g][j], a4[mi][g][j], acc[mi][ni], 0, 0, 0);
#else
        bf16x8 af[2], bfr[4];
#pragma unroll
        for (int mi = 0; mi < 2; ++mi) af[mi] = *(const bf16x8*)(As + (wm * 32 + mi * 16 + fr) * LDT + fq * 8);
#pragma unroll
        for (int ni = 0; ni < 4; ++ni) bfr[ni] = *(const bf16x8*)(Bs + (wn * 64 + ni * 16 + fr) * LDT + fq * 8);
#pragma unroll
        for (int mi = 0; mi < 2; ++mi)
#pragma unroll
            for (int ni = 0; ni < 4; ++ni) acc[mi][ni] = __builtin_amdgcn_mfma_f32_16x16x32_bf16(bfr[ni], af[mi], acc[mi][ni], 0, 0, 0);
#endif
    }
}
template <class F> __device__ __forceinline__ void epi_foreach(const f32x4 (&acc)[2][4], int m0, int n0, F f) {
    const int tid = threadIdx.x, lane = tid & 63, wid = tid >> 6, wm = wid >> 1, wn = wid & 1, fr = lane & 15, fq = lane >> 4;
#pragma unroll
    for (int mi = 0; mi < 2; ++mi)
#pragma unroll
        for (int gp = 0; gp < 2; ++gp) f(m0 + wm * 32 + mi * 16 + fr, n0 + wn * 64 + gp * 32 + 4 * fq, acc[mi][2 * gp], acc[mi][2 * gp + 1]);
}

__device__ __forceinline__ void p0_adaln_item(const Frame& F, int item) {
    float* sc = (float*)F.lds;
    float* part = sc + 9 * 1024;
    __syncthreads();
    for (int e = F.tid; e < 9 * 1024; e += 512) { const int r = e >> 10, kk = e & 1023; const float v = (r < 8) ? F.c[r * DM + kk] : F.c_ctx[kk]; sc[e] = v / (1.0f + expf(-v)); }
    __syncthreads();
    const int col = item * 64 + F.lane, kg = F.wid;
    float a[9];
#pragma unroll
    for (int r = 0; r < 9; ++r) a[r] = 0.f;
    for (int kk = kg * 128; kk < kg * 128 + 128; ++kk) {
        const float w = F.w_ada[(size_t)kk * 6144 + col];
#pragma unroll
        for (int r = 0; r < 9; ++r) a[r] += sc[r * 1024 + kk] * w;
    }
#pragma unroll
    for (int r = 0; r < 9; ++r) part[(kg * 9 + r) * 64 + F.lane] = a[r];
    __syncthreads();
    for (int e = F.tid; e < 9 * 64; e += 512) { const int r = e >> 6, cl = e & 63; float s = F.b_ada[item * 64 + cl];
#pragma unroll
        for (int g = 0; g < 8; ++g) s += part[(g * 9 + r) * 64 + cl];
        F.mod[r * 6144 + item * 64 + cl] = s; }
}
template <class CM> __device__ __forceinline__ void p0_transpose_item(const Frame& F, const float* W, int K, int Nsrc, act_t* dst, int item, int ntn, CM cmap) {
    float* tl = (float*)F.lds;
    const int kb = item / ntn, nb = item % ntn, k0 = kb * 64, n0 = nb * 64;
    __syncthreads();
    { const int j = F.tid & 63, i0 = F.tid >> 6; const int sc = cmap(n0 + j);
#pragma unroll
      for (int i = 0; i < 8; ++i) { const int kk = i0 + 8 * i; tl[kk * 65 + j] = W[(size_t)(k0 + kk) * Nsrc + sc]; } }
    __syncthreads();
    { const int kk = F.tid & 63, nn0 = F.tid >> 6;
#pragma unroll
      for (int i = 0; i < 8; ++i) { const int n = nn0 + 8 * i; st_act(dst + (size_t)(n0 + n) * K + k0 + kk, tl[kk * 65 + n]); } }
}
__device__ __forceinline__ int cmap_in(int n) {
    if (n < 1536 || n >= 2560) return n;
    const int g = (n - 1536) >> 5, e = n & 31;
    return (e < 16) ? (1536 + 16 * g + e) : (2048 + 16 * g + (e - 16));
}
__device__ __forceinline__ void p0_prep(const Frame& F) {
    for (int it = F.bid; it < 96; it += F.G) p0_adaln_item(F, it);
    constexpr int I_IN = 16 * 72, I_OA = 16 * 16, I_OC = 8 * 16, I_OUT = 16 * 16, I_WQ = 16 * 32;
    constexpr int NIT = I_IN + I_OA + I_OC + I_OUT + I_WQ;
    auto ident = [](int n) { return n; };
    for (int it = F.bid; it < NIT; it += F.G) {
        int r = it;
        if (r < I_IN) { p0_transpose_item(F, F.w_in, 1024, INW, F.win_t, r, 72, [](int n) { return cmap_in(n); }); continue; } r -= I_IN;
        if (r < I_OA) { p0_transpose_item(F, F.w_o_attn, 1024, 1024, F.woa_t, r, 16, ident); continue; } r -= I_OA;
        if (r < I_OC) { p0_transpose_item(F, F.w_o_conv, 512, 1024, F.woc_t, r, 16, ident); continue; } r -= I_OC;
        if (r < I_OUT) { p0_transpose_item(F, F.w_out, 1024, 1024, F.wout_t, r, 16, ident); continue; } r -= I_OUT;
        p0_transpose_item(F, F.peer_wq, 1024, PQW, F.wq_t, r, 32, ident);
    }
    for (int e = F.bid * 512 + F.tid; e < 16 * 128 * 128; e += F.G * 512) st_act(F.keys_t + e, F.peer_keys[e]);
    for (int e = F.bid * 512 + F.tid; e < 64 * 16; e += F.G * 512) {
        const int pos = e >> 4, f = e & 15;
        const float freq = powf(10000.0f, -(float)(2 * f) / 32.0f);
        const float ang = (float)pos * freq;
        const double TWO_PI = 6.283185307179586476925286766559;
        double r = (double)ang; r -= TWO_PI * rint(r / TWO_PI);
        const double r2 = r * r;
        double sn = 0.0, cs = 0.0;
        double ts = r, tc = 1.0;
#pragma unroll 1
        for (int n = 0; n < 14; ++n) { sn += ts; cs += tc; ts *= -r2 / (double)((2 * n + 2) * (2 * n + 3)); tc *= -r2 / (double)((2 * n + 1) * (2 * n + 2)); }
        F.rope[e * 2] = (float)cs; F.rope[e * 2 + 1] = (float)sn;
    }
}

__device__ __forceinline__ void p1_norm(const Frame& F) {
    const int gw = F.bid * 8 + F.wid, NGW = F.G * 8;
    for (int r = gw; r < T_ + CT_; r += NGW) {
        const bool isx = r < T_;
        const int rr = isx ? r : r - T_;
        const float* src = isx ? F.x + ((size_t)F.b0 * SEQ + rr) * DM : F.ctx + ((size_t)F.b0 * CTXL + rr) * DM;
        act_t* dst = isx ? F.hx + (size_t)rr * DM : F.hc + (size_t)rr * DM;
        const float* mrow = isx ? F.mod + (size_t)(F.b0 + rr / SEQ) * 6144 : F.mod + (size_t)8 * 6144;
        f32x4 v[4]; float ss = 0.f;
#pragma unroll
        for (int j = 0; j < 4; ++j) { v[j] = *(const f32x4*)(src + j * 256 + F.lane * 4); ss += v[j][0] * v[j][0] + v[j][1] * v[j][1] + v[j][2] * v[j][2] + v[j][3] * v[j][3]; }
        ss = wave_sum(ss);
        const float rstd = 1.0f / sqrtf(ss * (1.0f / DM) + EPS);
#pragma unroll
        for (int j = 0; j < 4; ++j) { const int d = j * 256 + F.lane * 4;
            const f32x4 g = *(const f32x4*)(F.g_pre_mix + d), sh = *(const f32x4*)(mrow + d), sc = *(const f32x4*)(mrow + 1024 + d);
            f32x4 o;
#pragma unroll
            for (int i = 0; i < 4; ++i) o[i] = (v[j][i] * rstd) * g[i] * (1.0f + sc[i]) + sh[i];
            st4(dst + d, o); }
    }
}

__device__ __forceinline__ void p2_inproj(const Frame& F) {
    constexpr int nM = T_ / 128, nN = INW / 128, nMc = CT_ / 128, nNc = 4;
    const int ntile = nM * nN + nMc * nNc;
    for (int t = F.bid; t < ntile; t += F.G) {
        f32x4 acc[2][4]; acc_zero(acc);
        if (t < nM * nN) {
            const int pm = t / nN, pn = t % nN;
            mma_tile(acc, F.lds, F.hx, DM, F.win_t, DM, DM, pm * 128, pn * 128);
            epi_foreach(acc, pm * 128, pn * 128, [&](int r, int c, f32x4 v0, f32x4 v1) {
                const int s = r & (SEQ - 1);
                if (c < 1280) {
                    const int axis = (c >> 5) & 1, pos = axis ? (s & 63) : (s >> 6);
                    const float* rp = F.rope + (pos * 16 + (c & 15)) * 2;
                    const f32x4 cs0 = *(const f32x4*)rp, cs1 = *(const f32x4*)(rp + 4);
                    f32x4 o1, o2;
                    o1[0] = v0[0] * cs0[0] - v1[0] * cs0[1]; o2[0] = v1[0] * cs0[0] + v0[0] * cs0[1];
                    o1[1] = v0[1] * cs0[2] - v1[1] * cs0[3]; o2[1] = v1[1] * cs0[2] + v0[1] * cs0[3];
                    o1[2] = v0[2] * cs1[0] - v1[2] * cs1[1]; o2[2] = v1[2] * cs1[0] + v0[2] * cs1[1];
                    o1[3] = v0[3] * cs1[2] - v1[3] * cs1[3]; o2[3] = v1[3] * cs1[2] + v0[3] * cs1[3];
                    if (c < 1024) { o1 *= QS; o2 *= QS; st4(F.q + (size_t)r * 1024 + c, o1); st4(F.q + (size_t)r * 1024 + c + 16, o2); }
                    else { st4(F.k + (size_t)r * 256 + (c - 1024), o1); st4(F.k + (size_t)r * 256 + (c - 1024) + 16, o2); }
                } else if (c < 1536) {
                    const int cc = c - 1280, hk = cc >> 6, d = cc & 63, bl = r / SEQ;
                    act_t* base = F.vT + ((size_t)(bl * 4 + hk) * 64 + d) * SEQ + s;
#pragma unroll
                    for (int i = 0; i < 4; ++i) { st_act(base + (size_t)i * SEQ, v0[i]); st_act(base + (size_t)(16 + i) * SEQ, v1[i]); }
                } else if (c < 2560) {
                    const int ch = ((c - 1536) >> 5) * 16 + (c & 15);
                    f32x4 o;
#pragma unroll
                    for (int i = 0; i < 4; ++i) o[i] = v0[i] * sigmoidf_(v1[i]);
                    st4(F.u + (size_t)r * 512 + ch, o);
                } else {
                    const int g = c - 2560; f32x4 o0, o1;
#pragma unroll
                    for (int i = 0; i < 4; ++i) { o0[i] = sigmoidf_(v0[i]); o1[i] = sigmoidf_(v1[i]); }
                    st4(F.sg + (size_t)r * 2048 + g, o0); st4(F.sg + (size_t)r * 2048 + g + 16, o1);
                }
            });
        } else {
            const int tt = t - nM * nN, pm = tt / nNc, pn = tt % nNc;
            mma_tile(acc, F.lds, F.hc, DM, F.win_t + (size_t)1024 * DM, DM, DM, pm * 128, pn * 128);
            epi_foreach(acc, pm * 128, pn * 128, [&](int r, int c, f32x4 v0, f32x4 v1) {
                if (c < 256) { st4(F.kc + (size_t)r * 256 + c, v0); st4(F.kc + (size_t)r * 256 + c + 16, v1); }
                else { const int cc = c - 256, hk = cc >> 6, d = cc & 63, bl = r / CTXL, sx = r % CTXL;
                    act_t* base = F.vTc + ((size_t)(bl * 4 + hk) * 64 + d) * CTXL + sx;
#pragma unroll
                    for (int i = 0; i < 4; ++i) { st_act(base + (size_t)i * CTXL, v0[i]); st_act(base + (size_t)(16 + i) * CTXL, v1[i]); } }
            });
        }
    }
}

#if GOLD
__device__ __forceinline__ void p3_attn(const Frame& F) {
    float* qs = (float*)F.lds + F.wid * 64;
    float* ps = (float*)F.lds + 512 + F.wid * 640;
    const int gw = F.bid * 8 + F.wid, NGW = F.G * 8;
    for (int it = gw; it < T_ * NH; it += NGW) {
        const int r = it / NH, head = it % NH, hk = head >> 2, bl = r / SEQ, s = r % SEQ;
        qs[F.lane] = F.q[(size_t)r * 1024 + head * 64 + F.lane];
        const int lo = (s - 128 < 0) ? 0 : s - 128, hi = (s + 128 > SEQ - 1) ? SEQ - 1 : s + 128, nwin = hi - lo + 1, ntot = nwin + CTXL;
        float mx = -1e30f;
        for (int jj = F.lane; jj < ntot; jj += 64) {
            const float* kr = (jj < nwin) ? F.k + ((size_t)(bl * SEQ + lo + jj)) * 256 + hk * 64 : F.kc + ((size_t)(bl * CTXL + jj - nwin)) * 256 + hk * 64;
            float d = 0.f;
            for (int e = 0; e < 64; e += 4) { const f32x4 kv = *(const f32x4*)(kr + e); d += qs[e] * kv[0] + qs[e + 1] * kv[1] + qs[e + 2] * kv[2] + qs[e + 3] * kv[3]; }
            ps[jj] = d; mx = fmaxf(mx, d);
        }
        mx = wave_max(mx);
        float l = 0.f;
        for (int jj = F.lane; jj < ntot; jj += 64) { const float p = exp2f(ps[jj] - mx); ps[jj] = p; l += p; }
        l = wave_sum(l) + exp2f(F.sink[head] * LOG2E - mx);
        const float* vr = F.vT + ((size_t)(bl * 4 + hk) * 64 + F.lane) * SEQ + lo;
        const float* vc = F.vTc + ((size_t)(bl * 4 + hk) * 64 + F.lane) * CTXL;
        float o = 0.f;
        for (int jj = 0; jj < nwin; ++jj) o += ps[jj] * vr[jj];
        for (int jj = 0; jj < CTXL; ++jj) o += ps[nwin + jj] * vc[jj];
        F.att[(size_t)r * 1024 + head * 64 + F.lane] = o / l;
    }
}
#else
__device__ __forceinline__ void p3_attn(const Frame& F) {
    constexpr int KLD = 72;
    bf16_t* Kt = (bf16_t*)F.lds;
    bf16_t* Vt = (bf16_t*)(F.lds + 64 * KLD * 2);
    const int lane = F.lane, l31 = lane & 31, hi = lane >> 5;
    const int g = F.wid >> 1, half = F.wid & 1;
    constexpr int NUNIT = CH_B * NKV * (SEQ / 128);
    for (int un = F.bid; un < NUNIT; un += F.G) {
        const int nb = un & 15, hk = (un >> 4) & 3, bl = un >> 6;
        const int head = hk * 4 + g;
        const int r0 = bl * SEQ + nb * 128 + half * 64;
        bf16x8 qf[2][4];
#pragma unroll
        for (int qt = 0; qt < 2; ++qt)
#pragma unroll
            for (int s = 0; s < 4; ++s) qf[qt][s] = *(const bf16x8*)(F.q + (size_t)(r0 + qt * 32 + l31) * 1024 + head * 64 + s * 16 + 8 * hi);
        float mrun[2] = {-1e30f, -1e30f}, lrun[2] = {0.f, 0.f};
        f32x16 O[2][2];
#pragma unroll
        for (int a = 0; a < 2; ++a)
#pragma unroll
            for (int b = 0; b < 2; ++b)
#pragma unroll
                for (int r = 0; r < 16; ++r) O[a][b][r] = 0.f;
        for (int tile = 0; tile < 10; ++tile) {
            const bool isctx = tile < 4;
            const int ks = isctx ? tile * 64 : nb * 128 - 128 + 64 * (tile - 4);
            if (!isctx && (ks < 0 || ks >= SEQ)) continue;
            __syncthreads();
            { const int row = F.tid >> 3, ch = F.tid & 7;
              const act_t* ksrc = isctx ? F.kc + ((size_t)(bl * CTXL + ks + row)) * 256 + hk * 64 + ch * 8
                                        : F.k + ((size_t)(bl * SEQ + ks + row)) * 256 + hk * 64 + ch * 8;
              const act_t* vsrc = isctx ? F.vTc + ((size_t)(bl * 4 + hk) * 64 + row) * CTXL + ks + ch * 8
                                        : F.vT + ((size_t)(bl * 4 + hk) * 64 + row) * SEQ + ks + ch * 8;
              *(u32x4*)(Kt + row * KLD + ch * 8) = *(const u32x4*)ksrc;
              *(u32x4*)(Vt + row * KLD + ch * 8) = *(const u32x4*)vsrc; }
            __syncthreads();
            const int j = tile - 4;
            const bool need = isctx || (half == 0 ? (j <= 4) : (j >= 1));
            if (need) {
                f32x16 st[2][2];
#pragma unroll
                for (int a = 0; a < 2; ++a)
#pragma unroll
                    for (int b = 0; b < 2; ++b)
#pragma unroll
                        for (int r = 0; r < 16; ++r) st[a][b][r] = 0.f;
#pragma unroll
                for (int s = 0; s < 4; ++s)
#pragma unroll
                    for (int kt = 0; kt < 2; ++kt) {
                        const bf16x8 a = *(const bf16x8*)(Kt + (kt * 32 + l31) * KLD + s * 16 + 8 * hi);
#pragma unroll
                        for (int qt = 0; qt < 2; ++qt) st[kt][qt] = __builtin_amdgcn_mfma_f32_32x32x16_bf16(a, qf[qt][s], st[kt][qt], 0, 0, 0);
                    }
                if (!isctx) {
#pragma unroll
                    for (int kt = 0; kt < 2; ++kt)
#pragma unroll
                        for (int qt = 0; qt < 2; ++qt) {
                            const int qp = nb * 128 + half * 64 + qt * 32 + l31;
#pragma unroll
                            for (int r = 0; r < 16; ++r) { const int kp = ks + kt * 32 + crow(r, hi); const int dd = qp - kp; if (dd > 128 || dd < -128) st[kt][qt][r] = -1e30f; }
                        }
                }
                bf16x8 pf[2][2][2];
#pragma unroll
                for (int qt = 0; qt < 2; ++qt) {
                    float mx = -1e30f;
#pragma unroll
                    for (int kt = 0; kt < 2; ++kt)
#pragma unroll
                        for (int r = 0; r < 16; ++r) mx = fmaxf(mx, st[kt][qt][r]);
                    mx = fmaxf(mx, __shfl_xor(mx, 32));
                    const float mn = fmaxf(mrun[qt], mx);
                    const float alpha = __builtin_amdgcn_exp2f(mrun[qt] - mn);
                    mrun[qt] = mn; lrun[qt] *= alpha;
#pragma unroll
                    for (int dt = 0; dt < 2; ++dt)
#pragma unroll
                        for (int r = 0; r < 16; ++r) O[dt][qt][r] *= alpha;
                    float ls = 0.f;
#pragma unroll
                    for (int kt = 0; kt < 2; ++kt) {
                        float p[16];
#pragma unroll
                        for (int r = 0; r < 16; ++r) { p[r] = __builtin_amdgcn_exp2f(st[kt][qt][r] - mn); ls += p[r]; }
#pragma unroll
                        for (int s2 = 0; s2 < 2; ++s2) {
                            u32x4 w;
                            w[0] = pk2(p[8 * s2 + 0], p[8 * s2 + 1]); w[1] = pk2(p[8 * s2 + 2], p[8 * s2 + 3]);
                            w[2] = pk2(p[8 * s2 + 4], p[8 * s2 + 5]); w[3] = pk2(p[8 * s2 + 6], p[8 * s2 + 7]);
                            pf[kt][s2][qt] = __builtin_bit_cast(bf16x8, w);
                        }
                    }
                    lrun[qt] += ls;
                }
#pragma unroll
                for (int kt = 0; kt < 2; ++kt)
#pragma unroll
                    for (int s2 = 0; s2 < 2; ++s2)
#pragma unroll
                        for (int dt = 0; dt < 2; ++dt) {
                            const bf16_t* vp = Vt + (dt * 32 + l31) * KLD + kt * 32 + s2 * 16 + 4 * hi;
                            const s16x4 lo = *(const s16x4*)vp, hh = *(const s16x4*)(vp + 8);
                            const bf16x8 a = (bf16x8){lo[0], lo[1], lo[2], lo[3], hh[0], hh[1], hh[2], hh[3]};
#pragma unroll
                            for (int qt = 0; qt < 2; ++qt) O[dt][qt] = __builtin_amdgcn_mfma_f32_32x32x16_bf16(a, pf[kt][s2][qt], O[dt][qt], 0, 0, 0);
                        }
            }
        }
        const float sk = F.sink[head] * LOG2E;
#pragma unroll
        for (int qt = 0; qt < 2; ++qt) {
            float lt = lrun[qt] + __shfl_xor(lrun[qt], 32);
            lt += __builtin_amdgcn_exp2f(sk - mrun[qt]);
            const float inv = 1.0f / lt;
            act_t* orow = F.att + (size_t)(r0 + qt * 32 + l31) * 1024 + head * 64;
#pragma unroll
            for (int dt = 0; dt < 2; ++dt)
#pragma unroll
                for (int g4 = 0; g4 < 4; ++g4) {
                    f32x4 o; o[0] = O[dt][qt][4 * g4] * inv; o[1] = O[dt][qt][4 * g4 + 1] * inv; o[2] = O[dt][qt][4 * g4 + 2] * inv; o[3] = O[dt][qt][4 * g4 + 3] * inv;
                    st4(orow + dt * 32 + 8 * g4 + 4 * hi, o);
                }
        }
    }
}
#endif

#if GOLD
constexpr int CTK = 32;
#else
constexpr int CTK = 64;
#endif
__device__ __forceinline__ void p3_conv(const Frame& F) {
    act_t* ub = (act_t*)F.lds;
    float* yb = (float*)(F.lds + (size_t)(CTK + 30) * 512 * AS);
    static_assert((CTK + 30) * 512 * AS + 8 * 512 * 4 <= LDS_MISC, "conv LDS");
    const int c = F.tid;
    float w[CONV_W];
#pragma unroll
    for (int i = 0; i < CONV_W; ++i) w[i] = F.conv_dw[i * CONV_CH + c];
    const float bias = F.conv_dw_b[c];
    constexpr int NT = T_ / CTK;
    for (int t = F.bid; t < NT; t += F.G) {
        const int r0 = t * CTK, bl = r0 / SEQ, s0 = r0 % SEQ;
        __syncthreads();
        constexpr int CPRW = 512 * AS / 16;
        for (int e = F.tid; e < (CTK + 30) * CPRW; e += 512) {
            const int rr = e / CPRW, ch = e % CPRW, sp = s0 + rr - 15;
            u32x4 v = (u32x4){0u, 0u, 0u, 0u};
            if (sp >= 0 && sp < SEQ) v = *(const u32x4*)((const unsigned char*)(F.u + (size_t)(bl * SEQ + sp) * 512) + ch * 16);
            *(u32x4*)((unsigned char*)ub + (size_t)rr * 512 * AS + ch * 16) = v;
        }
        __syncthreads();
        for (int chunk = 0; chunk < CTK / 8; ++chunk) {
#pragma unroll 1
            for (int tt = 0; tt < 8; ++tt) {
                const int tk = chunk * 8 + tt;
                float a = 0.f;
#pragma unroll
                for (int i = 0; i < CONV_W; ++i) a += ld_act(ub + (size_t)(tk + i) * 512 + c) * w[i];
                yb[tt * 512 + c] = a + bias;
            }
            __syncthreads();
            {
                const int tk = chunk * 8 + F.wid;
                float y[8];
                const f32x4 y0 = *(const f32x4*)(yb + F.wid * 512 + F.lane * 8), y1 = *(const f32x4*)(yb + F.wid * 512 + F.lane * 8 + 4);
                y[0] = y0[0]; y[1] = y0[1]; y[2] = y0[2]; y[3] = y0[3]; y[4] = y1[0]; y[5] = y1[1]; y[6] = y1[2]; y[7] = y1[3];
                float s = 0.f;
#pragma unroll
                for (int i = 0; i < 8; ++i) s += y[i];
                const float mean = wave_sum(s) * (1.0f / CONV_CH);
                float q = 0.f;
#pragma unroll
                for (int i = 0; i < 8; ++i) { y[i] -= mean; q += y[i] * y[i]; }
                const float rstd = 1.0f / sqrtf(wave_sum(q) * (1.0f / CONV_CH) + EPS);
                f32x4 o0, o1;
#pragma unroll
                for (int i = 0; i < 8; ++i) { const int ch = F.lane * 8 + i; const float z = y[i] * rstd * F.conv_ln_g[ch] + F.conv_ln_b[ch]; const float o = z * sigmoidf_(z); if (i < 4) o0[i] = o; else o1[i - 4] = o; }
                act_t* dst = F.cact + (size_t)(r0 + tk) * 512 + F.lane * 8;
                st4(dst, o0); st4(dst + 4, o1);
            }
            __syncthreads();
        }
    }
}

__device__ __forceinline__ void p4_merge(const Frame& F) {
    constexpr int nM = T_ / 128, nN = 8;
    for (int t = F.bid; t < nM * nN; t += F.G) {
        const int pm = t / nN, pn = t % nN;
        f32x4 accA[2][4], accC[2][4]; acc_zero(accA); acc_zero(accC);
        mma_tile(accA, F.lds, F.att, 1024, F.woa_t, 1024, 1024, pm * 128, pn * 128);
        mma_tile(accC, F.lds, F.cact, 512, F.woc_t, 512, 512, pm * 128, pn * 128);
        const int lane = F.lane, wm = F.wid >> 1, wn = F.wid & 1, fr = lane & 15, fq = lane >> 4;
#pragma unroll
        for (int mi = 0; mi < 2; ++mi)
#pragma unroll
            for (int ni = 0; ni < 4; ++ni) {
                const int r = pm * 128 + wm * 32 + mi * 16 + fr, c = pn * 128 + wn * 64 + ni * 16 + 4 * fq;
                const f32x4 ga = ld4(F.sg + (size_t)r * 2048 + c), gc = ld4(F.sg + (size_t)r * 2048 + 1024 + c);
                st4(F.m + (size_t)r * 1024 + c, ga * accA[mi][ni] + gc * accC[mi][ni]);
            }
    }
}
__device__ __forceinline__ void p5_out(const Frame& F) {
    constexpr int nM = T_ / 128, nN = 8;
    for (int t = F.bid; t < nM * nN; t += F.G) {
        const int pm = t / nN, pn = t % nN;
        f32x4 acc[2][4]; acc_zero(acc);
        mma_tile(acc, F.lds, F.m, 1024, F.wout_t, 1024, 1024, pm * 128, pn * 128);
        const int lane = F.lane, wm = F.wid >> 1, wn = F.wid & 1, fr = lane & 15, fq = lane >> 4;
#pragma unroll
        for (int mi = 0; mi < 2; ++mi)
#pragma unroll
            for (int ni = 0; ni < 4; ++ni) {
                const int r = pm * 128 + wm * 32 + mi * 16 + fr, c = pn * 128 + wn * 64 + ni * 16 + 4 * fq;
                *(f32x4*)(F.mixed + (size_t)r * 1024 + c) = acc[mi][ni];
            }
    }
}
__device__ __forceinline__ void p6_rows(const Frame& F) {
    const int gw = F.bid * 8 + F.wid, NGW = F.G * 8;
    for (int r = gw; r < T_; r += NGW) {
        const float* mrow = F.mod + (size_t)(F.b0 + r / SEQ) * 6144;
        const float* xr = F.x + ((size_t)F.b0 * SEQ + r) * DM;
        float* outr = F.out + ((size_t)F.b0 * SEQ + r) * DM;
        f32x4 mv[4], x1[4]; float ss = 0.f;
#pragma unroll
        for (int j = 0; j < 4; ++j) { mv[j] = *(const f32x4*)(F.mixed + (size_t)r * 1024 + j * 256 + F.lane * 4); ss += mv[j][0] * mv[j][0] + mv[j][1] * mv[j][1] + mv[j][2] * mv[j][2] + mv[j][3] * mv[j][3]; }
        const float rstd = 1.0f / sqrtf(wave_sum(ss) * (1.0f / DM) + EPS);
        float s1 = 0.f;
#pragma unroll
        for (int j = 0; j < 4; ++j) { const int d = j * 256 + F.lane * 4;
            const f32x4 xv = *(const f32x4*)(xr + d), g = *(const f32x4*)(F.g_post_mix + d), gt = *(const f32x4*)(mrow + 2048 + d);
#pragma unroll
            for (int i = 0; i < 4; ++i) { x1[j][i] = xv[i] + gt[i] * ((mv[j][i] * rstd) * g[i]); s1 += x1[j][i] * x1[j][i]; }
            *(f32x4*)(outr + d) = x1[j]; }
        const float rstd1 = 1.0f / sqrtf(wave_sum(s1) * (1.0f / DM) + EPS);
#pragma unroll
        for (int j = 0; j < 4; ++j) { const int d = j * 256 + F.lane * 4;
            const f32x4 g = *(const f32x4*)(F.g_pre_ffn + d), sh = *(const f32x4*)(mrow + 3072 + d), sc = *(const f32x4*)(mrow + 4096 + d);
            f32x4 o;
#pragma unroll
            for (int i = 0; i < 4; ++i) o[i] = (x1[j][i] * rstd1) * g[i] * (1.0f + sc[i]) + sh[i];
            st4(F.h2 + (size_t)r * 1024 + d, o); }
    }
}
__device__ __forceinline__ void p7_wq(const Frame& F) {
    constexpr int nM = T_ / 128, nN = PQW / 128;
    for (int t = F.bid; t < nM * nN; t += F.G) {
        const int pm = t / nN, pn = t % nN;
        f32x4 acc[2][4]; acc_zero(acc);
        mma_tile(acc, F.lds, F.h2, 1024, F.wq_t, 1024, 1024, pm * 128, pn * 128);
        const int lane = F.lane, wm = F.wid >> 1, wn = F.wid & 1, fr = lane & 15, fq = lane >> 4;
#pragma unroll
        for (int mi = 0; mi < 2; ++mi)
#pragma unroll
            for (int ni = 0; ni < 4; ++ni) {
                const int r = pm * 128 + wm * 32 + mi * 16 + fr, c = pn * 128 + wn * 64 + ni * 16 + 4 * fq;
                st4(F.pq + (size_t)r * PQW + c, acc[mi][ni]);
            }
    }
#if !GOLD
    for (size_t e = (size_t)F.bid * 512 + F.tid; e < (size_t)NEXP * 1024 / 16; e += (size_t)F.G * 512) {
        u32x4 wa, wb;
#pragma unroll
        for (int j = 0; j < 4; ++j) { const f32x4 a = *(const f32x4*)(F.peer_u + e * 16 + 4 * j), b = *(const f32x4*)(F.peer_v + e * 16 + 4 * j);
            int pa = 0, pb = 0;
            pa = __builtin_amdgcn_cvt_pk_fp8_f32(a[0] * 256.0f, a[1] * 256.0f, pa, false); pa = __builtin_amdgcn_cvt_pk_fp8_f32(a[2] * 256.0f, a[3] * 256.0f, pa, true);
            pb = __builtin_amdgcn_cvt_pk_fp8_f32(b[0] * 256.0f, b[1] * 256.0f, pb, false); pb = __builtin_amdgcn_cvt_pk_fp8_f32(b[2] * 256.0f, b[3] * 256.0f, pb, true);
            wa[j] = (unsigned)pa; wb[j] = (unsigned)pb; }
        *(u32x4*)(F.pu8 + e * 16) = wa; *(u32x4*)(F.pv8 + e * 16) = wb;
    }
#endif
}
__device__ __forceinline__ void p8_scores(const Frame& F) {
    constexpr int SLD = 132;
    float* st = (float*)(F.lds + GEMM_LDS);
    static_assert(GEMM_LDS + 128 * SLD * 4 <= LDS_MISC, "scores LDS");
    constexpr int nM = T_ / 128;
    for (int t = F.bid; t < nM * 16; t += F.G) {
        const int pm = t / 16, hp = t % 16;
        f32x4 acc[2][4]; acc_zero(acc);
        mma_tile(acc, F.lds, F.pq + hp * 128, PQW, F.keys_t + (size_t)hp * 128 * 128, 128, 128, pm * 128, 0);
        const int lane = F.lane, wm = F.wid >> 1, wn = F.wid & 1, fr = lane & 15, fq = lane >> 4;
#pragma unroll
        for (int mi = 0; mi < 2; ++mi)
#pragma unroll
            for (int ni = 0; ni < 4; ++ni) *(f32x4*)(st + (wm * 32 + mi * 16 + fr) * SLD + wn * 64 + ni * 16 + 4 * fq) = acc[mi][ni];
        __syncthreads();
        for (int rr = 0; rr < 16; ++rr) {
            const int row = F.wid * 16 + rr;
            const float* sr = st + row * SLD;
            const float v0 = sr[lane], v1 = sr[lane + 64];
            int c0 = 0, c1 = 0;
            for (int j4 = 0; j4 < 128; j4 += 4) {
                const f32x4 sj = *(const f32x4*)(sr + j4);
#pragma unroll
                for (int i = 0; i < 4; ++i) { const int j = j4 + i;
                    c0 += (sj[i] > v0 || (sj[i] == v0 && j < lane)) ? 1 : 0;
                    c1 += (sj[i] > v1 || (sj[i] == v1 && j < lane + 64)) ? 1 : 0; }
            }
            const size_t ob = ((size_t)(pm * 128 + row) * 16 + hp) * 16;
            if (c0 < 16) { F.topv[ob + c0] = v0; F.topi[ob + c0] = lane; }
            if (c1 < 16) { F.topv[ob + c1] = v1; F.topi[ob + c1] = lane + 64; }
        }
    }
}
__device__ __forceinline__ void p9_topk2(const Frame& F) {
    const int gw = F.bid * 8 + F.wid, NGW = F.G * 8, c = F.lane;
    int ci, cj;
    if (c < 16) { ci = 0; cj = c; } else if (c < 24) { ci = 1; cj = c - 16; } else if (c < 29) { ci = 2; cj = c - 24; } else if (c < 33) { ci = 3; cj = c - 29; }
    else if (c < 36) { ci = 4; cj = c - 33; } else if (c < 42) { ci = 5 + ((c - 36) >> 1); cj = (c - 36) & 1; } else { ci = 8 + (c - 42); cj = 0; }
    const bool valid = c < 50;
    if (!valid) { ci = 0; cj = 0; }
    for (int it = gw; it < T_ * 8; it += NGW) {
        const int r = it >> 3, h = it & 7;
        const size_t oa = ((size_t)r * 16 + 2 * h) * 16, ob = oa + 16;
        const float val = valid ? (F.topv[oa + ci] + F.topv[ob + cj]) : -INFINITY;
        const int pos = valid ? ci * 16 + cj : 1000;
        int rank = 0;
#pragma unroll
        for (int cc = 0; cc < 50; ++cc) {
            const float ov = __uint_as_float(__builtin_amdgcn_readlane(__float_as_uint(val), cc));
            const int op = __builtin_amdgcn_readlane(pos, cc);
            rank += (ov > val || (ov == val && op < pos)) ? 1 : 0;
        }
        const bool sel = valid && rank < 16;
        const float mx = wave_max(sel ? val : -INFINITY);
        const float e = sel ? expf(val - mx) : 0.f;
        const float sum = wave_sum(e);
        if (sel) { const size_t o = (size_t)r * 128 + h * 16 + rank; F.pei[o] = F.topi[oa + ci] * 128 + F.topi[ob + cj]; F.peg[o] = e / sum; }
    }
}
#if GOLD
__device__ __forceinline__ void p10_experts(const Frame& F) {
    const int gw = F.bid * 8 + F.wid, NGW = F.G * 8, lane = F.lane;
    constexpr int EPL = 4, NLD = 4;
    const float* TU = F.peer_u; const float* TV = F.peer_v;
    for (int r = gw; r < T_; r += NGW) {
        float hv[NLD][EPL], acc[NLD][EPL];
#pragma unroll
        for (int j = 0; j < NLD; ++j)
#pragma unroll
            for (int i = 0; i < EPL; ++i) { hv[j][i] = ld_act(F.h2 + (size_t)r * 1024 + j * 64 * EPL + lane * EPL + i); acc[j][i] = 0.f; }
        const int id0 = F.pei[(size_t)r * 128 + lane], id1 = F.pei[(size_t)r * 128 + 64 + lane];
        const float g0 = F.peg[(size_t)r * 128 + lane], g1 = F.peg[(size_t)r * 128 + 64 + lane];
        for (int e = 0; e < 128; ++e) {
            const int idx = __shfl((e < 64) ? id0 : id1, e & 63);
            const float gt = __shfl((e < 64) ? g0 : g1, e & 63);
            float uv[NLD][EPL], vv[NLD][EPL];
#pragma unroll
            for (int j = 0; j < NLD; ++j) {
                const f32x4 a = *(const f32x4*)(TU + (size_t)idx * 1024 + j * 256 + lane * 4), b = *(const f32x4*)(TV + (size_t)idx * 1024 + j * 256 + lane * 4);
#pragma unroll
                for (int i = 0; i < 4; ++i) { uv[j][i] = a[i]; vv[j][i] = b[i]; }
            }
            float d = 0.f;
#pragma unroll
            for (int j = 0; j < NLD; ++j)
#pragma unroll
                for (int i = 0; i < EPL; ++i) d += uv[j][i] * hv[j][i];
            d = wave_sum(d);
            const float act = 0.5f * d * (1.0f + erff(d * 0.70710678118654752f));
            const float wgt = gt * act;
#pragma unroll
            for (int j = 0; j < NLD; ++j)
#pragma unroll
                for (int i = 0; i < EPL; ++i) acc[j][i] += wgt * vv[j][i];
        }
        float ss = 0.f;
#pragma unroll
        for (int j = 0; j < NLD; ++j)
#pragma unroll
            for (int i = 0; i < EPL; ++i) ss += acc[j][i] * acc[j][i];
        const float rstd = 1.0f / sqrtf(wave_sum(ss) * (1.0f / DM) + EPS);
        const float* mrow = F.mod + (size_t)(F.b0 + r / SEQ) * 6144 + 5120;
        float* outr = F.out + ((size_t)F.b0 * SEQ + r) * DM;
#pragma unroll
        for (int j = 0; j < NLD; ++j)
#pragma unroll
            for (int i4 = 0; i4 < EPL; i4 += 4) { const int d0 = j * 64 * EPL + lane * EPL + i4;
                const f32x4 x1 = *(const f32x4*)(outr + d0), g = *(const f32x4*)(F.g_post_ffn + d0), gt2 = *(const f32x4*)(mrow + d0);
                f32x4 o;
#pragma unroll
                for (int i = 0; i < 4; ++i) o[i] = x1[i] + gt2[i] * ((acc[j][i4 + i] * rstd) * g[i]);
                *(f32x4*)(outr + d0) = o; }
    }
}
#else
#define P10_LOAD(U, V, b) do { _Pragma("unroll") for (int e_ = 0; e_ < 4; ++e_) { const int ent_ = 4 * (b) + e_; \
        const int idx_ = __builtin_amdgcn_readlane(((b) < 16) ? id0 : id1, ent_ & 63); \
        U[e_] = *(const u32x4*)(TU + (size_t)idx_ * 1024 + lane * 16); V[e_] = *(const u32x4*)(TV + (size_t)idx_ * 1024 + lane * 16); } } while (0)
#define P10_COMPUTE(U, V, b) do { float d_[4]; \
        _Pragma("unroll") for (int e_ = 0; e_ < 4; ++e_) { float s_ = 0.f; \
            _Pragma("unroll") for (int w_ = 0; w_ < 4; ++w_) { const f32x2 lo_ = __builtin_amdgcn_cvt_pk_f32_fp8((int)U[e_][w_], false), hi_ = __builtin_amdgcn_cvt_pk_f32_fp8((int)U[e_][w_], true); \
                s_ += lo_[0] * hv[4 * w_] + lo_[1] * hv[4 * w_ + 1] + hi_[0] * hv[4 * w_ + 2] + hi_[1] * hv[4 * w_ + 3]; } d_[e_] = s_; } \
        float d2_[2], d1_; \
        _Pragma("unroll") for (int e_ = 0; e_ < 2; ++e_) { const float k_ = b5 ? d_[e_ + 2] : d_[e_], s_ = b5 ? d_[e_] : d_[e_ + 2]; d2_[e_] = k_ + __shfl_xor(s_, 32); } \
        { const float k_ = b4 ? d2_[1] : d2_[0], s_ = b4 ? d2_[0] : d2_[1]; d1_ = k_ + __shfl_xor(s_, 16); } \
        d1_ += __shfl_xor(d1_, 8); d1_ += __shfl_xor(d1_, 4); d1_ += __shfl_xor(d1_, 2); d1_ += __shfl_xor(d1_, 1); \
        const float dot_ = d1_ * (1.0f / 256.0f); \
        const float act_ = 0.5f * dot_ * (1.0f + erff(dot_ * 0.70710678118654752f)); \
        const float gate_ = __shfl(((b) < 16) ? g0 : g1, (4 * (b) + eid) & 63); \
        const float wl_ = gate_ * act_ * (1.0f / 256.0f); \
        _Pragma("unroll") for (int e_ = 0; e_ < 4; ++e_) { \
            const float we_ = __uint_as_float(__builtin_amdgcn_readlane(__float_as_uint(wl_), (e_ & 1) * 16 + ((e_ >> 1) & 1) * 32)); \
            _Pragma("unroll") for (int w_ = 0; w_ < 4; ++w_) { const f32x2 lo_ = __builtin_amdgcn_cvt_pk_f32_fp8((int)V[e_][w_], false), hi_ = __builtin_amdgcn_cvt_pk_f32_fp8((int)V[e_][w_], true); \
                acc[4 * w_] += we_ * lo_[0]; acc[4 * w_ + 1] += we_ * lo_[1]; acc[4 * w_ + 2] += we_ * hi_[0]; acc[4 * w_ + 3] += we_ * hi_[1]; } } } while (0)
__device__ __forceinline__ void p10_experts(const Frame& F) {
    const int gw = F.bid * 8 + F.wid, NGW = F.G * 8, lane = F.lane;
    const unsigned char* TU = F.pu8; const unsigned char* TV = F.pv8;
    const bool b5 = (lane & 32) != 0, b4 = (lane & 16) != 0;
    const int eid = ((lane >> 4) & 1) | (((lane >> 5) & 1) << 1);
    for (int r = gw; r < T_; r += NGW) {
        float hv[16], acc[16];
        { const act_t* hp = F.h2 + (size_t)r * 1024 + lane * 16;
#pragma unroll
          for (int j = 0; j < 4; ++j) { const f32x4 t = ld4(hp + 4 * j); hv[4 * j] = t[0]; hv[4 * j + 1] = t[1]; hv[4 * j + 2] = t[2]; hv[4 * j + 3] = t[3]; } }
#pragma unroll
        for (int i = 0; i < 16; ++i) acc[i] = 0.f;
        const int id0 = F.pei[(size_t)r * 128 + lane], id1 = F.pei[(size_t)r * 128 + 64 + lane];
        const float g0 = F.peg[(size_t)r * 128 + lane], g1 = F.peg[(size_t)r * 128 + 64 + lane];
        u32x4 ua[4], va[4], ub[4], vb[4];
        P10_LOAD(ua, va, 0);
        for (int bb = 0; bb < 32; bb += 2) {
            P10_LOAD(ub, vb, bb + 1);
            P10_COMPUTE(ua, va, bb);
            if (bb + 2 < 32) P10_LOAD(ua, va, bb + 2);
            P10_COMPUTE(ub, vb, bb + 1);
        }
        float ss = 0.f;
#pragma unroll
        for (int i = 0; i < 16; ++i) ss += acc[i] * acc[i];
        const float rstd = 1.0f / sqrtf(wave_sum(ss) * (1.0f / DM) + EPS);
        const float* mrow = F.mod + (size_t)(F.b0 + r / SEQ) * 6144 + 5120;
        float* outr = F.out + ((size_t)F.b0 * SEQ + r) * DM;
#pragma unroll
        for (int j = 0; j < 4; ++j) { const int d0 = lane * 16 + 4 * j;
            const f32x4 x1 = *(const f32x4*)(outr + d0), g = *(const f32x4*)(F.g_post_ffn + d0), gt2 = *(const f32x4*)(mrow + d0);
            f32x4 o;
#pragma unroll
            for (int i = 0; i < 4; ++i) o[i] = x1[i] + gt2[i] * ((acc[4 * j + i] * rstd) * g[i]);
            *(f32x4*)(outr + d0) = o; }
    }
}
#endif

__global__ void __launch_bounds__(512, 2) fwd_kernel(Args a) {
    extern __shared__ __attribute__((aligned(16))) unsigned char lds[];
    Frame F;
    F.lds = lds; F.tid = threadIdx.x; F.lane = F.tid & 63; F.wid = __builtin_amdgcn_readfirstlane(F.tid >> 6); F.G = gridDim.x; F.bid = blockIdx.x; F.b0 = a.b0;
    F.x = a.in[0]; F.c = a.in[1]; F.ctx = a.in[2]; F.c_ctx = a.in[3]; F.w_ada = a.in[4]; F.b_ada = a.in[5]; F.g_pre_mix = a.in[6]; F.g_post_mix = a.in[7];
    F.g_pre_ffn = a.in[8]; F.g_post_ffn = a.in[9]; F.w_in = a.in[10]; F.sink = a.in[11]; F.w_o_attn = a.in[12]; F.conv_dw = a.in[13]; F.conv_dw_b = a.in[14];
    F.conv_ln_g = a.in[15]; F.conv_ln_b = a.in[16]; F.w_o_conv = a.in[17]; F.w_out = a.in[18]; F.peer_wq = a.in[19]; F.peer_keys = a.in[20]; F.peer_u = a.in[21]; F.peer_v = a.in[22];
    F.out = a.out;
    unsigned char* ws = a.ws;
    F.mod = (float*)(ws + WS_MOD); F.rope = (float*)(ws + WS_ROPE);
    F.win_t = (act_t*)(ws + WS_WIN); F.woa_t = (act_t*)(ws + WS_WOA); F.woc_t = (act_t*)(ws + WS_WOC); F.wout_t = (act_t*)(ws + WS_WOUT); F.wq_t = (act_t*)(ws + WS_WQ); F.keys_t = (act_t*)(ws + WS_KEYS);
    F.q = (act_t*)(ws + O_Q); F.k = (act_t*)(ws + O_K); F.vT = (act_t*)(ws + O_VT); F.u = (act_t*)(ws + O_U); F.sg = (act_t*)(ws + O_SG); F.kc = (act_t*)(ws + O_KC); F.vTc = (act_t*)(ws + O_VTC);
    F.att = (act_t*)(ws + O_ATT); F.cact = (act_t*)(ws + O_CACT); F.hx = (act_t*)(ws + O_HX); F.hc = (act_t*)(ws + O_HC); F.m = (act_t*)(ws + O_M); F.h2 = (act_t*)(ws + O_H2); F.pq = (act_t*)(ws + O_PQ);
    F.mixed = (float*)(ws + O_MIXED); F.topv = (float*)(ws + O_TOPV); F.topi = (int*)(ws + O_TOPI); F.pei = (int*)(ws + O_PEI); F.peg = (float*)(ws + O_PEG);
    F.pu8 = ws + O_PU; F.pv8 = ws + O_PV;

    volatile LAS unsigned* misc = (volatile LAS unsigned*)(LAS unsigned char*)(lds + LDS_MISC);
    if (F.tid < 64) misc[F.tid] = 0u;
    __syncthreads();
    const int lo = a.ph_lo, hi = a.ph_hi;
    XcdBarrier bar; bar.bar = (unsigned*)(ws + WS_CTL); bar.x = 0; bar.st = misc;
    if (hi - lo > 1) bar = xcd_barrier_post((unsigned*)(ws + WS_CTL), misc);
#define IN(k) (lo <= (k) && (k) < hi)
#define SEAM(k) do { if (IN(k) && IN((k) + 1)) xcd_barrier(bar); } while (0)
    if (IN(0)) { p0_prep(F); } SEAM(0);
    if (IN(1)) { p1_norm(F); } SEAM(1);
    if (IN(2)) { p2_inproj(F); } SEAM(2);
    if (IN(3)) { p3_attn(F); __syncthreads(); p3_conv(F); } SEAM(3);
    if (IN(4)) { p4_merge(F); } SEAM(4);
    if (IN(5)) { p5_out(F); } SEAM(5);
    if (IN(6)) { p6_rows(F); } SEAM(6);
    if (IN(7)) { p7_wq(F); } SEAM(7);
    if (IN(8)) { p8_scores(F); } SEAM(8);
    if (IN(9)) { p9_topk2(F); } SEAM(9);
    if (IN(10)) { p10_experts(F); }
#undef IN
#undef SEAM
}

extern "C" void kernel_launch(void* const* d_in, const int* in_sizes, int n_in, void* d_out, int out_size, void* d_ws, size_t ws_size, hipStream_t stream) {
    static int grid = 0;
    if (grid == 0) {
        if (n_in != 23 || ws_size < WS_END) { fprintf(stderr, "kernel_launch: need 23 inputs and %zu B of workspace (got %d, %zu)\n", (size_t)WS_END, n_in, ws_size); grid = -1; return; }
        int dev = 0, cus = 0;
        if (hipGetDevice(&dev) != hipSuccess || hipDeviceGetAttribute(&cus, hipDeviceAttributeMultiprocessorCount, dev) != hipSuccess) { grid = -1; return; }
        if (hipFuncSetAttribute((const void*)fwd_kernel, hipFuncAttributeMaxDynamicSharedMemorySize, LDS_BYTES) != hipSuccess) { fprintf(stderr, "kernel_launch: hipFuncSetAttribute failed\n"); grid = -1; return; }
        grid = cus;
    }
    if (grid < 0) return;
    (void)hipMemsetAsync((char*)d_ws + WS_CTL, 0, CTL_BYTES, stream);
    Args a{};
    for (int i = 0; i < 23; ++i) a.in[i] = (const float*)d_in[i];
    a.out = (float*)d_out; a.ws = (unsigned char*)d_ws;
#if ONE_LAUNCH
    a.ph_lo = 0; a.ph_hi = NPHASE; a.b0 = 0;
    hipLaunchKernelGGL(fwd_kernel, dim3(grid), dim3(512), LDS_BYTES, stream, a);
#else
    a.ph_lo = 0; a.ph_hi = 1; a.b0 = 0;
    hipLaunchKernelGGL(fwd_kernel, dim3(grid), dim3(512), LDS_BYTES, stream, a);
    for (int b0 = 0; b0 < BATCH; b0 += CH_B)
        for (int ph = 1; ph < NPHASE; ++ph) { a.ph_lo = ph; a.ph_hi = ph + 1; a.b0 = b0; hipLaunchKernelGGL(fwd_kernel, dim3(grid), dim3(512), LDS_BYTES, stream, a); }
#endif
}
```

```cpp
#include <hip/hip_runtime.h>
#include <cstdint>
#include <cstdio>

#ifndef GOLD
#define GOLD 0
#endif
#ifndef ONE_LAUNCH
#define ONE_LAUNCH 1
#endif

typedef unsigned short bf16_t;
typedef short bf16x8 __attribute__((ext_vector_type(8)));
typedef short s16x4 __attribute__((ext_vector_type(4)));
typedef float f32x4 __attribute__((ext_vector_type(4)));
typedef float f32x16 __attribute__((ext_vector_type(16)));
typedef unsigned u32x2 __attribute__((ext_vector_type(2)));
typedef unsigned u32x4 __attribute__((ext_vector_type(4)));
typedef float f32x2 __attribute__((ext_vector_type(2)));

#if GOLD
typedef float act_t;
#else
typedef bf16_t act_t;
#endif
constexpr int AS = sizeof(act_t);

constexpr int DM = 1024, BATCH = 8, SEQ = 2048, CTXL = 256, NH = 16, NKV = 4, HD = 64;
constexpr int INW = 4608, PQW = 2048, NEXP = 16384;
constexpr int CONV_CH = 512, CONV_W = 31;
constexpr float EPS = 1e-6f;
constexpr float LOG2E = 1.4426950408889634f;
constexpr float QS = 0.125f * LOG2E;
#if GOLD
constexpr int CH_B = 1;
#else
constexpr int CH_B = 8;
#endif
constexpr int T_ = CH_B * SEQ;
constexpr int CT_ = CH_B * CTXL;
constexpr int NPHASE = 11;

constexpr size_t MiB = 1u << 20;
constexpr size_t WS_CTL = 0, CTL_BYTES = 1 * MiB;
constexpr size_t WS_MOD = 512 * 1024;
constexpr size_t WS_ROPE = 1 * MiB;
constexpr size_t WS_WIN = 2 * MiB;
constexpr size_t WS_WOA = 22 * MiB;
constexpr size_t WS_WOC = 26 * MiB;
constexpr size_t WS_WOUT = 28 * MiB;
constexpr size_t WS_WQ = 32 * MiB;
constexpr size_t WS_KEYS = 40 * MiB;
constexpr size_t AR = 42 * MiB;
constexpr size_t A0 = AR;
constexpr size_t O_Q = A0;
constexpr size_t O_K = O_Q + (size_t)T_ * 1024 * AS;
constexpr size_t O_VT = O_K + (size_t)T_ * 256 * AS;
constexpr size_t O_U = O_VT + (size_t)T_ * 256 * AS;
constexpr size_t O_SG = O_U + (size_t)T_ * 512 * AS;
constexpr size_t O_KC = O_SG + (size_t)T_ * 2048 * AS;
constexpr size_t O_VTC = O_KC + (size_t)CT_ * 256 * AS;
constexpr size_t A0_END = O_VTC + (size_t)CT_ * 256 * AS;
constexpr size_t O_MIXED = A0;
constexpr size_t O_PQ = A0 + (size_t)T_ * 4096;
constexpr size_t O_TOPV = A0;
constexpr size_t O_TOPI = A0 + (size_t)T_ * 1024;
constexpr size_t O_PV = A0 + 32 * MiB;
constexpr size_t A1 = A0_END;
constexpr size_t O_ATT = A1;
constexpr size_t O_CACT = O_ATT + (size_t)T_ * 1024 * AS;
constexpr size_t A1_END = O_CACT + (size_t)T_ * 512 * AS;
constexpr size_t O_HX = A1;
constexpr size_t O_HC = A1 + (size_t)T_ * 1024 * AS;
constexpr size_t O_PU = A1;
constexpr size_t O_PEI = O_CACT;
constexpr size_t O_PEG = O_CACT + (size_t)T_ * 512;
constexpr size_t A2 = A1_END;
constexpr size_t O_M = A2;
constexpr size_t O_H2 = A2;
constexpr size_t WS_END = A2 + (size_t)T_ * 1024 * AS;
static_assert(O_PQ + (size_t)T_ * 2048 * AS <= A0_END, "pq overlay");
static_assert(O_TOPI + (size_t)T_ * 1024 <= O_PQ, "topk overlay");
static_assert(GOLD || (O_PV >= O_TOPI + (size_t)T_ * 1024 && O_PV + 32 * MiB <= O_PQ), "pv overlay");
static_assert(GOLD || (O_PU + 32 * MiB <= O_PEI), "pu overlay");
static_assert(O_PEG + (size_t)T_ * 512 <= A1_END, "pe overlay");
static_assert(O_HC + (size_t)CT_ * 1024 * AS <= A1_END, "hc overlay");

constexpr int LDS_BYTES = 147456;
constexpr int LDS_MISC = LDS_BYTES - 256;

__device__ __forceinline__ float bf2f(bf16_t h) { return __uint_as_float((unsigned)h << 16); }
__device__ __forceinline__ unsigned f2bf(float f) { unsigned u = __float_as_uint(f); return (u + 0x7fffu + ((u >> 16) & 1u)) >> 16; }
__device__ __forceinline__ unsigned pk2(float lo, float hi) { return f2bf(lo) | (f2bf(hi) << 16); }
#if GOLD
__device__ __forceinline__ float ld_act(const act_t* p) { return *p; }
__device__ __forceinline__ void st_act(act_t* p, float v) { *p = v; }
__device__ __forceinline__ f32x4 ld4(const act_t* p) { return *(const f32x4*)p; }
__device__ __forceinline__ void st4(act_t* p, f32x4 v) { *(f32x4*)p = v; }
#else
__device__ __forceinline__ float ld_act(const act_t* p) { return bf2f(*p); }
__device__ __forceinline__ void st_act(act_t* p, float v) { *p = (bf16_t)f2bf(v); }
__device__ __forceinline__ f32x4 ld4(const act_t* p) { u32x2 w = *(const u32x2*)p; f32x4 r; r[0] = __uint_as_float(w[0] << 16); r[1] = __uint_as_float(w[0] & 0xffff0000u); r[2] = __uint_as_float(w[1] << 16); r[3] = __uint_as_float(w[1] & 0xffff0000u); return r; }
__device__ __forceinline__ void st4(act_t* p, f32x4 v) { u32x2 w; w[0] = pk2(v[0], v[1]); w[1] = pk2(v[2], v[3]); *(u32x2*)p = w; }
#endif
__device__ __forceinline__ float wave_sum(float v) {
#pragma unroll
    for (int o = 1; o < 64; o <<= 1) v += __shfl_xor(v, o);
    return v;
}
__device__ __forceinline__ float wave_max(float v) {
#pragma unroll
    for (int o = 1; o < 64; o <<= 1) v = fmaxf(v, __shfl_xor(v, o));
    return v;
}
__device__ __forceinline__ float sigmoidf_(float x) { return 1.0f / (1.0f + expf(-x)); }
__device__ __forceinline__ int crow(int r, int hi) { return (r & 3) + 8 * (r >> 2) + 4 * hi; }

#define LAS __attribute__((address_space(3)))
#define XB_TMO      128
#define XB_XCNT(j)  (256  + 64 * (j))
#define XB_XSUB(j)  (1280 + 64 * (j))
#define XB_XGEN(j)  (2304 + 64 * (j))
#define XB_TOP      3328
#define XB_TOPGEN   3392
#define XCD_BAR_WORDS 3456
#define XB_SPIN_CAP (1u << 18)
__device__ __forceinline__ unsigned xb_ld(unsigned* p)              { return __hip_atomic_load(p, __ATOMIC_RELAXED, __HIP_MEMORY_SCOPE_AGENT); }
__device__ __forceinline__ unsigned xb_add(unsigned* p, unsigned v) { return __hip_atomic_fetch_add(p, v, __ATOMIC_RELAXED, __HIP_MEMORY_SCOPE_AGENT); }
__device__ __forceinline__ unsigned xb_xcc_id() { return (unsigned)__builtin_amdgcn_s_getreg((3 << 11) | 20) & 0xFu; }
#define XB_SPIN(cond, bar) do { unsigned _sp = 0; while (cond) { __builtin_amdgcn_s_sleep(1); \
    if ((++_sp & 255u) == 0u) { if (xb_ld(&(bar)[XB_TMO])) break; if (_sp > XB_SPIN_CAP) { atomicAdd(&(bar)[XB_TMO], 1u); break; } } } } while (0)
struct XcdBarrier { unsigned* bar; unsigned x; volatile LAS unsigned* st; };
__device__ __forceinline__ XcdBarrier xcd_barrier_post(unsigned* bar, volatile LAS unsigned* st) {
    XcdBarrier b; b.bar = bar; b.x = xb_xcc_id(); b.st = st;
    if (threadIdx.x == 0) (void)xb_add(&bar[XB_XCNT(b.x)], 1u);
    return b;
}
__device__ __forceinline__ void xcd_barrier_complete(unsigned* bar, unsigned x, unsigned& nloc, unsigned& nx) {
    const unsigned G = gridDim.x * gridDim.y * gridDim.z;
    unsigned sum, cnt, mine, sp = 0u;
    for (;;) {
        sum = 0u; cnt = 0u; mine = 0u;
#pragma unroll
        for (unsigned j = 0; j < 16; ++j) { const unsigned c = xb_ld(&bar[XB_XCNT(j)]); sum += c; cnt += (c > 0u) ? 1u : 0u; mine = (j == x) ? c : mine; }
        if (sum == G) break;
        __builtin_amdgcn_s_sleep(1);
        if ((++sp & 255u) == 0u) { if (xb_ld(&bar[XB_TMO])) break; if (sp > XB_SPIN_CAP) { atomicAdd(&bar[XB_TMO], 1u); break; } }
    }
    nloc = mine > 0u ? mine : 1u; nx = cnt > 0u ? cnt : 1u;
}
__device__ __forceinline__ void xcd_barrier(const XcdBarrier& b) {
    asm volatile("s_waitcnt vmcnt(0)" ::: "memory");
    __syncthreads();
    if (threadIdx.x == 0) {
        unsigned* bar = b.bar;
        __builtin_amdgcn_s_waitcnt(0);
        unsigned nloc = b.st[0], nx = b.st[1];
        if (nloc == 0u) { xcd_barrier_complete(bar, b.x, nloc, nx); b.st[0] = nloc; b.st[1] = nx; }
        const unsigned old = xb_add(&bar[XB_XSUB(b.x)], 1u);
        const unsigned gen = old / nloc;
        if (old + 1u == (gen + 1u) * nloc) {
            __builtin_amdgcn_fence(__ATOMIC_RELEASE, "agent");
            asm volatile("s_waitcnt vmcnt(0)" ::: "memory");
            const unsigned og = xb_add(&bar[XB_TOP], 1u);
            const unsigned tg = og / nx;
            if (og + 1u == (tg + 1u) * nx) xb_add(&bar[XB_TOPGEN], 1u);
            else XB_SPIN(xb_ld(&bar[XB_TOPGEN]) == tg, bar);
            __builtin_amdgcn_fence(__ATOMIC_ACQUIRE, "agent");
            xb_add(&bar[XB_XGEN(b.x)], 1u);
            asm volatile("s_waitcnt vmcnt(0)" ::: "memory");
        } else {
            XB_SPIN(xb_ld(&bar[XB_XGEN(b.x)]) == gen, bar);
            __builtin_amdgcn_fence(__ATOMIC_ACQUIRE, "agent");
            asm volatile("s_waitcnt vmcnt(0)" ::: "memory");
        }
    }
    __syncthreads();
}

struct Args { const float* in[23]; float* out; unsigned char* ws; int ph_lo, ph_hi, b0, pad; };

struct Frame {
    unsigned char* lds;
    int tid, lane, wid, G, bid;
    int b0;
    const float *x, *c, *ctx, *c_ctx, *w_ada, *b_ada, *g_pre_mix, *g_post_mix, *g_pre_ffn, *g_post_ffn, *w_in, *sink, *w_o_attn,
        *conv_dw, *conv_dw_b, *conv_ln_g, *conv_ln_b, *w_o_conv, *w_out, *peer_wq, *peer_keys, *peer_u, *peer_v;
    float* out;
    float* mod; float* rope;
    act_t *win_t, *woa_t, *woc_t, *wout_t, *wq_t, *keys_t;
    act_t *q, *k, *vT, *u, *sg, *kc, *vTc, *att, *cact, *hx, *hc, *m, *h2, *pq;
    float *mixed, *topv, *peg; int *topi, *pei;
    unsigned char *pu8, *pv8;
};

constexpr int BK = 32;
#if GOLD
constexpr int LDT = 36;
#else
constexpr int LDT = 40;
#endif
constexpr int TILE_LDS = 128 * LDT * AS;
constexpr int GEMM_LDS = 2 * TILE_LDS;

__device__ __forceinline__ void acc_zero(f32x4 (&acc)[2][4]) {
#pragma unroll
    for (int i = 0; i < 2; ++i)
#pragma unroll
        for (int j = 0; j < 4; ++j) acc[i][j] = (f32x4){0.f, 0.f, 0.f, 0.f};
}

__device__ __forceinline__ void mma_tile(f32x4 (&acc)[2][4], unsigned char* lds, const act_t* __restrict__ A, int lda,
                                         const act_t* __restrict__ Bt, int ldb, int K, int m0, int n0) {
    const int tid = threadIdx.x, lane = tid & 63, wid = tid >> 6, wm = wid >> 1, wn = wid & 1, fr = lane & 15, fq = lane >> 4;
    act_t* As = (act_t*)lds; act_t* Bs = (act_t*)(lds + TILE_LDS);
    constexpr int EPC = 16 / AS, CPR = BK / EPC, NCH = 128 * CPR / 512;
    u32x4 ra[NCH], rb[NCH];
#pragma unroll
    for (int i = 0; i < NCH; ++i) { const int cidx = tid + 512 * i, row = cidx / CPR, ch = cidx % CPR;
        ra[i] = *(const u32x4*)(A + (size_t)(m0 + row) * lda + ch * EPC);
        rb[i] = *(const u32x4*)(Bt + (size_t)(n0 + row) * ldb + ch * EPC); }
    const int nk = K / BK;
    for (int kt = 0; kt < nk; ++kt) {
        __syncthreads();
#pragma unroll
        for (int i = 0; i < NCH; ++i) { const int cidx = tid + 512 * i, row = cidx / CPR, ch = cidx % CPR;
            *(u32x4*)(As + row * LDT + ch * EPC) = ra[i];
            *(u32x4*)(Bs + row * LDT + ch * EPC) = rb[i]; }
        __syncthreads();
        if (kt + 1 < nk) {
            const int k1 = (kt + 1) * BK;
#pragma unroll
            for (int i = 0; i < NCH; ++i) { const int cidx = tid + 512 * i, row = cidx / CPR, ch = cidx % CPR;
                ra[i] = *(const u32x4*)(A + (size_t)(m0 + row) * lda + k1 + ch * EPC);
                rb[i] = *(const u32x4*)(Bt + (size_t)(n0 + row) * ldb + k1 + ch * EPC); }
        }
#if GOLD
        f32x4 a4[2][2], b4[4][2];
#pragma unroll
        for (int mi = 0; mi < 2; ++mi)
#pragma unroll
            for (int g = 0; g < 2; ++g) a4[mi][g] = *(const f32x4*)(As + (wm * 32 + mi * 16 + fr) * LDT + 16 * g + 4 * fq);
#pragma unroll
        for (int ni = 0; ni < 4; ++ni)
#pragma unroll
            for (int g = 0; g < 2; ++g) b4[ni][g] = *(const f32x4*)(Bs + (wn * 64 + ni * 16 + fr) * LDT + 16 * g + 4 * fq);
#pragma unroll
        for (int mi = 0; mi < 2; ++mi)
#pragma unroll
            for (int ni = 0; ni < 4; ++ni)
#pragma unroll
                for (int g = 0; g < 2; ++g)
#pragma unroll
                    for (int j = 0; j < 4; ++j) acc[mi][ni] = __builtin_amdgcn_mfma_f32_16x16x4f32(b4[ni][g][j], a4[mi][g][j], acc[mi][ni], 0, 0, 0);
#else
        bf16x8 af[2], bfr[4];
#pragma unroll
        for (int mi = 0; mi < 2; ++mi) af[mi] = *(const bf16x8*)(As + (wm * 32 + mi * 16 + fr) * LDT + fq * 8);
#pragma unroll
        for (int ni = 0; ni < 4; ++ni) bfr[ni] = *(const bf16x8*)(Bs + (wn * 64 + ni * 16 + fr) * LDT + fq * 8);
#pragma unroll
        for (int mi = 0; mi < 2; ++mi)
#pragma unroll
            for (int ni = 0; ni < 4; ++ni) acc[mi][ni] = __builtin_amdgcn_mfma_f32_16x16x32_bf16(bfr[ni], af[mi], acc[mi][ni], 0, 0, 0);
#endif
    }
}
template <class F> __device__ __forceinline__ void epi_foreach(const f32x4 (&acc)[2][4], int m0, int n0, F f) {
    const int tid = threadIdx.x, lane = tid & 63, wid = tid >> 6, wm = wid >> 1, wn = wid & 1, fr = lane & 15, fq = lane >> 4;
#pragma unroll
    for (int mi = 0; mi < 2; ++mi)
#pragma unroll
        for (int gp = 0; gp < 2; ++gp) f(m0 + wm * 32 + mi * 16 + fr, n0 + wn * 64 + gp * 32 + 4 * fq, acc[mi][2 * gp], acc[mi][2 * gp + 1]);
}


#if !GOLD
namespace pg8 {
#define PG8_LAS __attribute__((address_space(3)))
typedef unsigned short bf16_t;
typedef short bf16x8 __attribute__((ext_vector_type(8)));
typedef float f32x4 __attribute__((ext_vector_type(4)));
typedef unsigned u32x4 __attribute__((ext_vector_type(4)));
constexpr int BM = 256, BK = 64, HALF = 128, HTB = HALF * BK * 2  , STAGE_BYTES = 8 * HTB, NXCD = 8, WGM = 8;

__host__ __device__ __forceinline__ int lds_byte(int r, int c) { const int st = (r >> 4) * 2 + (c >> 5), rr = r & 15, cc = c & 31, ob = rr * 64 + cc * 2; return st * 1024 + (ob ^ (((ob >> 9) & 1) << 5)); }
__host__ __device__ __forceinline__ void stage_rc(int b, int& R, int& C) { const int st = b / 1024, sb = b % 1024, swz = sb ^ (((sb >> 9) & 1) << 5); R = (st >> 1) * 16 + swz / 64; C = (st & 1) * 32 + (swz % 64) / 2; }
__host__ __device__ __forceinline__ int perm32(int rho) { const int n = rho >> 4, i = rho & 15; return 8 * (i >> 2) + 4 * n + (i & 3); }

struct Unit { int pm, pn; };
struct Gemm { const bf16_t* A; const bf16_t* Bt; int M, N, K; };

struct StaticOrder {
    int nM, nN, nwg, G, c;
    __host__ __device__ void init(int M, int N, int G_, int c_) { nM = M / BM; nN = N / BM; nwg = nM * nN; G = G_; c = c_; }
    __host__ __device__ bool next(int i, Unit& u) const {
        const long L = (long)i * G + c; if (L >= nwg) return false;
        int wgid = (int)L; { const int q = nwg / NXCD, r = nwg % NXCD, xcd = wgid % NXCD, off = wgid / NXCD; wgid = (xcd < r ? xcd * (q + 1) : r * (q + 1) + (xcd - r) * q) + off; }
        const int nig = WGM * nN, gid = wgid / nig, fm = gid * WGM, gsz = (nM - fm) < WGM ? (nM - fm) : WGM;
        u.pm = fm + ((wgid % nig) % gsz); u.pn = (wgid % nig) / gsz; return true;
    }
    __device__ __forceinline__ void a_ready(const Unit&) const {}
    __device__ __forceinline__ void done(const Unit&) const {}
};
template <class Epi, class Sched, bool ALIGN_EPI = false, bool SP2 = false>
__device__ __forceinline__ void gemm_phase(PG8_LAS unsigned char* lds, const Gemm g, const Sched& S, const Epi& E) {
    const int tid = threadIdx.x, wid = __builtin_amdgcn_readfirstlane(tid >> 6), lane = tid & 63, wr = wid >> 2, wc = wid & 3, fr = lane & 15, fq = lane >> 4;
    const int K = g.K, nt = K / BK;
    unsigned voffA[2], voffB[2];
#pragma unroll
    for (int i = 0; i < 2; ++i) { int R, C; stage_rc(tid * 16 + i * 8192, R, C); const int Rb = Epi::PERM ? ((R & ~31) + perm32(R & 31)) : R;
        voffA[i] = (unsigned)(R * K + C) * 2u; voffB[i] = (unsigned)(Rb * K + C) * 2u; }
    const size_t kstep = (size_t)(BK * 2);
    const size_t hstep = (size_t)HALF * K * 2;
    const size_t tstep = 2 * hstep;
    const unsigned ldsw = (unsigned)wid * 1024u;
    const int aoff = lds_byte(wr * 64 + fr, fq * 8), boff = lds_byte(wc * 32 + fr, fq * 8);
#define PG8_SA(b, h) (((b) * 2 + (h)) * HTB)
#define PG8_SB(b, h) ((4 + (b) * 2 + (h)) * HTB)
#define PG8_STAGE(bufoff, gbase, voff) do { _Pragma("unroll") for (int _i = 0; _i < 2; ++_i) \
        __builtin_amdgcn_global_load_lds((const unsigned*)((const char*)(gbase) + (voff)[_i]), (PG8_LAS unsigned*)(lds + (bufoff) + ldsw + _i * 8192), 16, 0, 0); } while (0)
#define PG8_LDA(dst, b, h) do { _Pragma("unroll") for (int m = 0; m < 4; ++m) _Pragma("unroll") for (int k = 0; k < 2; ++k) dst[m][k] = *(const PG8_LAS bf16x8*)(lds + PG8_SA(b, h) + aoff + m * 2048 + k * 1024); } while (0)
#define PG8_LDB(dst, b, h) do { _Pragma("unroll") for (int n = 0; n < 2; ++n) _Pragma("unroll") for (int k = 0; k < 2; ++k) dst[n][k] = *(const PG8_LAS bf16x8*)(lds + PG8_SB(b, h) + boff + n * 2048 + k * 1024); } while (0)
#define PG8_MMA(ai, bj, At, Bt) do { __builtin_amdgcn_s_setprio(1); _Pragma("unroll") for (int m = 0; m < 4; ++m) _Pragma("unroll") for (int n = 0; n < 2; ++n) _Pragma("unroll") for (int k = 0; k < 2; ++k) \
        acc[ai][bj][m][n] = __builtin_amdgcn_mfma_f32_16x16x32_bf16(Bt[n][k], At[m][k], acc[ai][bj][m][n], 0, 0, 0); __builtin_amdgcn_s_setprio(0); } while (0)
#define PG8_WAIT_V(n) asm volatile("s_waitcnt vmcnt(" #n ")" ::: "memory")
#define PG8_WAIT_L(n) asm volatile("s_waitcnt lgkmcnt(" #n ")" ::: "memory")
#define PG8_BAR __builtin_amdgcn_s_barrier()
#define PG8_SCHED __builtin_amdgcn_sched_barrier(0)
    Unit cur, nxt; int ui = 0;
    if (!S.next(0, cur)) return;
    f32x4 acc[2][2][4][2];
#pragma unroll
    for (int a = 0; a < 2; ++a)
#pragma unroll
        for (int b = 0; b < 2; ++b)
#pragma unroll
            for (int m = 0; m < 4; ++m)
#pragma unroll
                for (int n = 0; n < 2; ++n) acc[a][b][m][n] = (f32x4){0.f, 0.f, 0.f, 0.f};
    bf16x8 At[4][2], B0[2][2], B1[2][2];
    const char* cA = (const char*)g.A + (size_t)cur.pm * tstep; const char* cB = (const char*)g.Bt + (size_t)cur.pn * tstep;
    S.a_ready(cur);
    if constexpr (SP2) {
        PG8_STAGE(PG8_SB(0, 0), cB, voffB); PG8_STAGE(PG8_SB(0, 1), cB + hstep, voffB); PG8_STAGE(PG8_SA(0, 0), cA, voffA); PG8_STAGE(PG8_SA(0, 1), cA + hstep, voffA);
        if (wr == 1) PG8_BAR;
        PG8_WAIT_V(2); PG8_BAR;
        PG8_STAGE(PG8_SB(1, 0), cB + kstep, voffB); PG8_STAGE(PG8_SA(1, 0), cA + kstep, voffA); PG8_STAGE(PG8_SB(1, 1), cB + hstep + kstep, voffB);
        PG8_WAIT_V(6); PG8_BAR;
    } else {
        PG8_STAGE(PG8_SB(0, 0), cB, voffB); PG8_STAGE(PG8_SA(0, 0), cA, voffA); PG8_STAGE(PG8_SB(0, 1), cB + hstep, voffB); PG8_STAGE(PG8_SA(0, 1), cA + hstep, voffA);
        if (wr == 1) PG8_BAR;
        PG8_WAIT_V(4); PG8_BAR;
        PG8_STAGE(PG8_SB(1, 0), cB + kstep, voffB); PG8_STAGE(PG8_SA(1, 0), cA + kstep, voffA); PG8_STAGE(PG8_SB(1, 1), cB + hstep + kstep, voffB);
        PG8_WAIT_V(6); PG8_BAR;
    }
    for (;;) {
        const bool has_next = S.next(ui + 1, nxt);
        const char* nA = has_next ? (const char*)g.A + (size_t)nxt.pm * tstep : cA; const char* nB = has_next ? (const char*)g.Bt + (size_t)nxt.pn * tstep : cB;
        for (int t = 0; t < nt; t += 2) {
            const bool last = (t == nt - 2);
            const char* a1 = cA + (size_t)(t + 1) * kstep;
            const char* a2 = last ? nA : cA + (size_t)(t + 2) * kstep; const char* b2 = last ? nB : cB + (size_t)(t + 2) * kstep;
            const char* a3 = a2 + kstep; const char* b3 = b2 + kstep;
            if (last && has_next) S.a_ready(nxt);
            if constexpr (SP2) {
            PG8_LDB(B0, 0, 0); PG8_LDB(B1, 0, 1); PG8_SCHED; PG8_LDA(At, 0, 0); PG8_STAGE(PG8_SA(1, 1), a1 + hstep, voffA);
            PG8_WAIT_V(8); PG8_WAIT_L(0); PG8_BAR; PG8_MMA(0, 0, At, B0); PG8_MMA(0, 1, At, B1); PG8_BAR; PG8_SCHED;
            PG8_LDA(At, 0, 1); PG8_STAGE(PG8_SB(0, 0), b2, voffB); PG8_STAGE(PG8_SB(0, 1), b2 + hstep, voffB); PG8_STAGE(PG8_SA(0, 0), a2, voffA);
            PG8_WAIT_V(8); PG8_WAIT_L(0); PG8_BAR; PG8_MMA(1, 0, At, B0); PG8_MMA(1, 1, At, B1); PG8_BAR; PG8_SCHED;
            PG8_LDB(B0, 1, 0); PG8_LDB(B1, 1, 1); PG8_SCHED; PG8_LDA(At, 1, 0); PG8_STAGE(PG8_SA(0, 1), a2 + hstep, voffA);
            PG8_WAIT_V(8); PG8_WAIT_L(0); PG8_BAR; PG8_MMA(0, 0, At, B0); PG8_MMA(0, 1, At, B1); PG8_BAR; PG8_SCHED;
            PG8_LDA(At, 1, 1); PG8_STAGE(PG8_SB(1, 0), b3, voffB); PG8_STAGE(PG8_SB(1, 1), b3 + hstep, voffB); PG8_STAGE(PG8_SA(1, 0), a3, voffA);
            PG8_WAIT_V(8); PG8_WAIT_L(0); PG8_BAR; PG8_MMA(1, 0, At, B0); PG8_MMA(1, 1, At, B1); PG8_BAR; PG8_SCHED;
            } else {
            PG8_LDB(B0, 0, 0); PG8_SCHED; PG8_LDA(At, 0, 0); PG8_STAGE(PG8_SA(1, 1), a1 + hstep, voffA);
            PG8_WAIT_L(8); PG8_BAR; PG8_WAIT_L(0); PG8_MMA(0, 0, At, B0); PG8_BAR; PG8_SCHED;
            PG8_LDB(B1, 0, 1); PG8_STAGE(PG8_SB(0, 0), b2, voffB);
            PG8_BAR; PG8_WAIT_L(0); PG8_MMA(0, 1, At, B1); PG8_BAR;
            PG8_LDA(At, 0, 1); PG8_STAGE(PG8_SA(0, 0), a2, voffA);
            PG8_BAR; PG8_WAIT_L(0); PG8_MMA(1, 0, At, B0); PG8_BAR; PG8_SCHED;
            PG8_STAGE(PG8_SB(0, 1), b2 + hstep, voffB);
            PG8_WAIT_V(6); PG8_BAR; PG8_MMA(1, 1, At, B1); PG8_BAR;
            PG8_LDB(B0, 1, 0); PG8_SCHED; PG8_LDA(At, 1, 0); PG8_STAGE(PG8_SA(0, 1), a2 + hstep, voffA);
            PG8_WAIT_L(8); PG8_BAR; PG8_WAIT_L(0); PG8_MMA(0, 0, At, B0); PG8_BAR; PG8_SCHED;
            PG8_LDB(B1, 1, 1); PG8_STAGE(PG8_SB(1, 0), b3, voffB);
            PG8_BAR; PG8_WAIT_L(0); PG8_MMA(0, 1, At, B1); PG8_BAR;
            PG8_LDA(At, 1, 1); PG8_STAGE(PG8_SA(1, 0), a3, voffA);
            PG8_BAR; PG8_WAIT_L(0); PG8_MMA(1, 0, At, B0); PG8_BAR; PG8_SCHED;
            PG8_STAGE(PG8_SB(1, 1), b3 + hstep, voffB);
            PG8_WAIT_V(6); PG8_BAR; PG8_MMA(1, 1, At, B1); PG8_BAR;
            }
        }
        if constexpr (ALIGN_EPI) { if (wr == 0) PG8_BAR; }
        if constexpr (!Epi::AFTER_DRAIN) { E(acc, cur, wr, wc, fr, fq); S.done(cur); }
        if (!has_next) break;
#pragma unroll
        for (int a = 0; a < 2; ++a)
#pragma unroll
            for (int b = 0; b < 2; ++b)
#pragma unroll
                for (int m = 0; m < 4; ++m)
#pragma unroll
                    for (int n = 0; n < 2; ++n) acc[a][b][m][n] = (f32x4){0.f, 0.f, 0.f, 0.f};
        cur = nxt; cA = nA; cB = nB; ++ui;
        if constexpr (ALIGN_EPI) { if (wr == 1) PG8_BAR; }
    }
    PG8_WAIT_V(0);
    if constexpr (!ALIGN_EPI) { if (wr == 0) PG8_BAR; }
    PG8_BAR;
    if constexpr (Epi::AFTER_DRAIN) { E.fused(acc, cur, wr, wc, fr, fq, lds, wid, lane); S.done(cur); }
#undef PG8_SA
#undef PG8_SB
#undef PG8_STAGE
#undef PG8_LDA
#undef PG8_LDB
#undef PG8_MMA
#undef PG8_WAIT_V
#undef PG8_WAIT_L
#undef PG8_BAR
#undef PG8_SCHED
}
}

template <class Fn> struct EpiFn {
    static constexpr bool PERM = false, AFTER_DRAIN = false;
    Fn f;
    __device__ __forceinline__ void operator()(const f32x4 (&acc)[2][2][4][2], const pg8::Unit& u, int wr, int wc, int fr, int fq) const {
#pragma unroll
        for (int ai = 0; ai < 2; ++ai)
#pragma unroll
            for (int m = 0; m < 4; ++m) { const int row = u.pm * 256 + ai * 128 + wr * 64 + m * 16 + fr;
#pragma unroll
                for (int bj = 0; bj < 2; ++bj) f(row, u.pn * 256 + bj * 128 + wc * 32 + 4 * fq, acc[ai][bj][m][0], acc[ai][bj][m][1]); }
    }
};
template <class Fn> __device__ __forceinline__ void run_gemm(const Frame& F, const act_t* A, const act_t* Bt, int M, int N, int K, Fn fn) {
    const pg8::Gemm g{A, Bt, M, N, K}; pg8::StaticOrder S; S.init(M, N, F.G, F.bid);
    const EpiFn<Fn> E{fn};
    pg8::gemm_phase<EpiFn<Fn>, pg8::StaticOrder, true, true>((PG8_LAS unsigned char*)F.lds, g, S, E);
}
__device__ __forceinline__ float fsig(float x) { return __builtin_amdgcn_rcpf(1.0f + __builtin_amdgcn_exp2f(-LOG2E * x)); }
#else
__device__ __forceinline__ float fsig(float x) { return 1.0f / (1.0f + expf(-x)); }
#endif

__device__ __forceinline__ void p0_adaln_item(const Frame& F, int item) {
    float* sc = (float*)F.lds;
    float* part = sc + 9 * 1024;
    __syncthreads();
    for (int e = F.tid; e < 9 * 1024; e += 512) { const int r = e >> 10, kk = e & 1023; const float v = (r < 8) ? F.c[r * DM + kk] : F.c_ctx[kk]; sc[e] = v / (1.0f + expf(-v)); }
    __syncthreads();
    const int col = item * 64 + F.lane, kg = F.wid;
    float a[9];
#pragma unroll
    for (int r = 0; r < 9; ++r) a[r] = 0.f;
    for (int kk = kg * 128; kk < kg * 128 + 128; ++kk) {
        const float w = F.w_ada[(size_t)kk * 6144 + col];
#pragma unroll
        for (int r = 0; r < 9; ++r) a[r] += sc[r * 1024 + kk] * w;
    }
#pragma unroll
    for (int r = 0; r < 9; ++r) part[(kg * 9 + r) * 64 + F.lane] = a[r];
    __syncthreads();
    for (int e = F.tid; e < 9 * 64; e += 512) { const int r = e >> 6, cl = e & 63; float s = F.b_ada[item * 64 + cl];
#pragma unroll
        for (int g = 0; g < 8; ++g) s += part[(g * 9 + r) * 64 + cl];
        F.mod[r * 6144 + item * 64 + cl] = s; }
}
template <class CM> __device__ __forceinline__ void p0_transpose_item(const Frame& F, const float* W, int K, int Nsrc, act_t* dst, int item, int ntn, CM cmap) {
    float* tl = (float*)F.lds;
    const int kb = item / ntn, nb = item % ntn, k0 = kb * 64, n0 = nb * 64;
    __syncthreads();
    { const int j = F.tid & 63, i0 = F.tid >> 6; const int sc = cmap(n0 + j);
#pragma unroll
      for (int i = 0; i < 8; ++i) { const int kk = i0 + 8 * i; tl[kk * 65 + j] = W[(size_t)(k0 + kk) * Nsrc + sc]; } }
    __syncthreads();
    { const int kk = F.tid & 63, nn0 = F.tid >> 6;
#pragma unroll
      for (int i = 0; i < 8; ++i) { const int n = nn0 + 8 * i; st_act(dst + (size_t)(n0 + n) * K + k0 + kk, tl[kk * 65 + n]); } }
}
__device__ __forceinline__ int cmap_in(int n) {
    if (n < 1536 || n >= 2560) return n;
    const int g = (n - 1536) >> 5, e = n & 31;
    return (e < 16) ? (1536 + 16 * g + e) : (2048 + 16 * g + (e - 16));
}
__device__ __forceinline__ void p0_prep(const Frame& F) {
    for (int it = F.bid; it < 96; it += F.G) p0_adaln_item(F, it);
    constexpr int I_IN = 16 * 72, I_OA = 16 * 16, I_OC = 8 * 16, I_OUT = 16 * 16, I_WQ = 16 * 32;
    constexpr int NIT = I_IN + I_OA + I_OC + I_OUT + I_WQ;
    auto ident = [](int n) { return n; };
    for (int it = F.bid; it < NIT; it += F.G) {
        int r = it;
        if (r < I_IN) { p0_transpose_item(F, F.w_in, 1024, INW, F.win_t, r, 72, [](int n) { return cmap_in(n); }); continue; } r -= I_IN;
        if (r < I_OA) { p0_transpose_item(F, F.w_o_attn, 1024, 1024, F.woa_t, r, 16, ident); continue; } r -= I_OA;
        if (r < I_OC) { p0_transpose_item(F, F.w_o_conv, 512, 1024, F.woc_t, r, 16, ident); continue; } r -= I_OC;
        if (r < I_OUT) { p0_transpose_item(F, F.w_out, 1024, 1024, F.wout_t, r, 16, ident); continue; } r -= I_OUT;
        p0_transpose_item(F, F.peer_wq, 1024, PQW, F.wq_t, r, 32, ident);
    }
    for (int e = F.bid * 512 + F.tid; e < 16 * 128 * 128; e += F.G * 512) st_act(F.keys_t + e, F.peer_keys[e]);
    for (int e = F.bid * 512 + F.tid; e < 64 * 16; e += F.G * 512) {
        const int pos = e >> 4, f = e & 15;
        const float freq = powf(10000.0f, -(float)(2 * f) / 32.0f);
        const float ang = (float)pos * freq;
        const double TWO_PI = 6.283185307179586476925286766559;
        double r = (double)ang; r -= TWO_PI * rint(r / TWO_PI);
        const double r2 = r * r;
        double sn = 0.0, cs = 0.0;
        double ts = r, tc = 1.0;
#pragma unroll 1
        for (int n = 0; n < 14; ++n) { sn += ts; cs += tc; ts *= -r2 / (double)((2 * n + 2) * (2 * n + 3)); tc *= -r2 / (double)((2 * n + 1) * (2 * n + 2)); }
        F.rope[e * 2] = (float)cs; F.rope[e * 2 + 1] = (float)sn;
    }
}

__device__ __forceinline__ void p1_norm(const Frame& F) {
    const int gw = F.bid * 8 + F.wid, NGW = F.G * 8;
    for (int r = gw; r < T_ + CT_; r += NGW) {
        const bool isx = r < T_;
        const int rr = isx ? r : r - T_;
        const float* src = isx ? F.x + ((size_t)F.b0 * SEQ + rr) * DM : F.ctx + ((size_t)F.b0 * CTXL + rr) * DM;
        act_t* dst = isx ? F.hx + (size_t)rr * DM : F.hc + (size_t)rr * DM;
        const float* mrow = isx ? F.mod + (size_t)(F.b0 + rr / SEQ) * 6144 : F.mod + (size_t)8 * 6144;
        f32x4 v[4]; float ss = 0.f;
#pragma unroll
        for (int j = 0; j < 4; ++j) { v[j] = *(const f32x4*)(src + j * 256 + F.lane * 4); ss += v[j][0] * v[j][0] + v[j][1] * v[j][1] + v[j][2] * v[j][2] + v[j][3] * v[j][3]; }
        ss = wave_sum(ss);
        const float rstd = 1.0f / sqrtf(ss * (1.0f / DM) + EPS);
#pragma unroll
        for (int j = 0; j < 4; ++j) { const int d = j * 256 + F.lane * 4;
            const f32x4 g = *(const f32x4*)(F.g_pre_mix + d), sh = *(const f32x4*)(mrow + d), sc = *(const f32x4*)(mrow + 1024 + d);
            f32x4 o;
#pragma unroll
            for (int i = 0; i < 4; ++i) o[i] = (v[j][i] * rstd) * g[i] * (1.0f + sc[i]) + sh[i];
            st4(dst + d, o); }
    }
}

__device__ __forceinline__ void epi_in(const Frame& F, int r, int c, f32x4 v0, f32x4 v1) {
    const int s = r & (SEQ - 1);
    if (c < 1280) {
        const int axis = (c >> 5) & 1, pos = axis ? (s & 63) : (s >> 6);
        const float* rp = F.rope + (pos * 16 + (c & 15)) * 2;
        const f32x4 cs0 = *(const f32x4*)rp, cs1 = *(const f32x4*)(rp + 4);
        f32x4 o1, o2;
        o1[0] = v0[0] * cs0[0] - v1[0] * cs0[1]; o2[0] = v1[0] * cs0[0] + v0[0] * cs0[1];
        o1[1] = v0[1] * cs0[2] - v1[1] * cs0[3]; o2[1] = v1[1] * cs0[2] + v0[1] * cs0[3];
        o1[2] = v0[2] * cs1[0] - v1[2] * cs1[1]; o2[2] = v1[2] * cs1[0] + v0[2] * cs1[1];
        o1[3] = v0[3] * cs1[2] - v1[3] * cs1[3]; o2[3] = v1[3] * cs1[2] + v0[3] * cs1[3];
        if (c < 1024) { o1 *= QS; o2 *= QS; st4(F.q + (size_t)r * 1024 + c, o1); st4(F.q + (size_t)r * 1024 + c + 16, o2); }
        else { st4(F.k + (size_t)r * 256 + (c - 1024), o1); st4(F.k + (size_t)r * 256 + (c - 1024) + 16, o2); }
    } else if (c < 1536) {
        const int cc = c - 1280, hk = cc >> 6, d = cc & 63, bl = r / SEQ;
        act_t* base = F.vT + ((size_t)(bl * 4 + hk) * 64 + d) * SEQ + s;
#pragma unroll
        for (int i = 0; i < 4; ++i) { st_act(base + (size_t)i * SEQ, v0[i]); st_act(base + (size_t)(16 + i) * SEQ, v1[i]); }
    } else if (c < 2560) {
        const int ch = ((c - 1536) >> 5) * 16 + (c & 15);
        f32x4 o;
#pragma unroll
        for (int i = 0; i < 4; ++i) o[i] = v0[i] * fsig(v1[i]);
        st4(F.u + (size_t)r * 512 + ch, o);
    } else {
        const int g = c - 2560; f32x4 o0, o1;
#pragma unroll
        for (int i = 0; i < 4; ++i) { o0[i] = fsig(v0[i]); o1[i] = fsig(v1[i]); }
        st4(F.sg + (size_t)r * 2048 + g, o0); st4(F.sg + (size_t)r * 2048 + g + 16, o1);
    }
}
__device__ __forceinline__ void epi_ctx(const Frame& F, int r, int c, f32x4 v0, f32x4 v1) {
    if (c < 256) { st4(F.kc + (size_t)r * 256 + c, v0); st4(F.kc + (size_t)r * 256 + c + 16, v1); }
    else { const int cc = c - 256, hk = cc >> 6, d = cc & 63, bl = r / CTXL, sx = r % CTXL;
        act_t* base = F.vTc + ((size_t)(bl * 4 + hk) * 64 + d) * CTXL + sx;
#pragma unroll
        for (int i = 0; i < 4; ++i) { st_act(base + (size_t)i * CTXL, v0[i]); st_act(base + (size_t)(16 + i) * CTXL, v1[i]); } }
}
#if GOLD
__device__ __forceinline__ void p2_inproj(const Frame& F) {
    constexpr int nM = T_ / 128, nN = INW / 128, nMc = CT_ / 128, nNc = 4;
    const int ntile = nM * nN + nMc * nNc;
    for (int t = F.bid; t < ntile; t += F.G) {
        f32x4 acc[2][4]; acc_zero(acc);
        if (t < nM * nN) {
            const int pm = t / nN, pn = t % nN;
            mma_tile(acc, F.lds, F.hx, DM, F.win_t, DM, DM, pm * 128, pn * 128);
            epi_foreach(acc, pm * 128, pn * 128, [&](int r, int c, f32x4 v0, f32x4 v1) { epi_in(F, r, c, v0, v1); });
        } else {
            const int tt = t - nM * nN, pm = tt / nNc, pn = tt % nNc;
            mma_tile(acc, F.lds, F.hc, DM, F.win_t + (size_t)1024 * DM, DM, DM, pm * 128, pn * 128);
            epi_foreach(acc, pm * 128, pn * 128, [&](int r, int c, f32x4 v0, f32x4 v1) { epi_ctx(F, r, c, v0, v1); });
        }
    }
}
#else
__device__ __forceinline__ void p2_inproj(const Frame& F) {
    run_gemm(F, F.hx, F.win_t, T_, INW, DM, [&](int r, int c, f32x4 v0, f32x4 v1) { epi_in(F, r, c, v0, v1); });
    run_gemm(F, F.hc, F.win_t + (size_t)1024 * DM, CT_, 512, DM, [&](int r, int c, f32x4 v0, f32x4 v1) { epi_ctx(F, r, c, v0, v1); });
}
#endif

#if GOLD
__device__ __forceinline__ void p3_attn(const Frame& F) {
    float* qs = (float*)F.lds + F.wid * 64;
    float* ps = (float*)F.lds + 512 + F.wid * 640;
    const int gw = F.bid * 8 + F.wid, NGW = F.G * 8;
    for (int it = gw; it < T_ * NH; it += NGW) {
        const int r = it / NH, head = it % NH, hk = head >> 2, bl = r / SEQ, s = r % SEQ;
        qs[F.lane] = F.q[(size_t)r * 1024 + head * 64 + F.lane];
        const int lo = (s - 128 < 0) ? 0 : s - 128, hi = (s + 128 > SEQ - 1) ? SEQ - 1 : s + 128, nwin = hi - lo + 1, ntot = nwin + CTXL;
        float mx = -1e30f;
        for (int jj = F.lane; jj < ntot; jj += 64) {
            const float* kr = (jj < nwin) ? F.k + ((size_t)(bl * SEQ + lo + jj)) * 256 + hk * 64 : F.kc + ((size_t)(bl * CTXL + jj - nwin)) * 256 + hk * 64;
            float d = 0.f;
            for (int e = 0; e < 64; e += 4) { const f32x4 kv = *(const f32x4*)(kr + e); d += qs[e] * kv[0] + qs[e + 1] * kv[1] + qs[e + 2] * kv[2] + qs[e + 3] * kv[3]; }
            ps[jj] = d; mx = fmaxf(mx, d);
        }
        mx = wave_max(mx);
        float l = 0.f;
        for (int jj = F.lane; jj < ntot; jj += 64) { const float p = exp2f(ps[jj] - mx); ps[jj] = p; l += p; }
        l = wave_sum(l) + exp2f(F.sink[head] * LOG2E - mx);
        const float* vr = F.vT + ((size_t)(bl * 4 + hk) * 64 + F.lane) * SEQ + lo;
        const float* vc = F.vTc + ((size_t)(bl * 4 + hk) * 64 + F.lane) * CTXL;
        float o = 0.f;
        for (int jj = 0; jj < nwin; ++jj) o += ps[jj] * vr[jj];
        for (int jj = 0; jj < CTXL; ++jj) o += ps[nwin + jj] * vc[jj];
        F.att[(size_t)r * 1024 + head * 64 + F.lane] = o / l;
    }
}
#else
__device__ __forceinline__ void p3_attn(const Frame& F) {
    constexpr int KLD = 72;
    bf16_t* Kt = (bf16_t*)F.lds;
    bf16_t* Vt = (bf16_t*)(F.lds + 64 * KLD * 2);
    const int lane = F.lane, l31 = lane & 31, hi = lane >> 5;
    const int g = F.wid >> 1, half = F.wid & 1;
    constexpr int NUNIT = CH_B * NKV * (SEQ / 128);
    for (int un = F.bid; un < NUNIT; un += F.G) {
        const int nb = un & 15, hk = (un >> 4) & 3, bl = un >> 6;
        const int head = hk * 4 + g;
        const int r0 = bl * SEQ + nb * 128 + half * 64;
        bf16x8 qf[2][4];
#pragma unroll
        for (int qt = 0; qt < 2; ++qt)
#pragma unroll
            for (int s = 0; s < 4; ++s) qf[qt][s] = *(const bf16x8*)(F.q + (size_t)(r0 + qt * 32 + l31) * 1024 + head * 64 + s * 16 + 8 * hi);
        float mrun[2] = {-1e30f, -1e30f}, lrun[2] = {0.f, 0.f};
        f32x16 O[2][2];
#pragma unroll
        for (int a = 0; a < 2; ++a)
#pragma unroll
            for (int b = 0; b < 2; ++b)
#pragma unroll
                for (int r = 0; r < 16; ++r) O[a][b][r] = 0.f;
        for (int tile = 0; tile < 10; ++tile) {
            const bool isctx = tile < 4;
            const int ks = isctx ? tile * 64 : nb * 128 - 128 + 64 * (tile - 4);
            if (!isctx && (ks < 0 || ks >= SEQ)) continue;
            __syncthreads();
            { const int row = F.tid >> 3, ch = F.tid & 7;
              const act_t* ksrc = isctx ? F.kc + ((size_t)(bl * CTXL + ks + row)) * 256 + hk * 64 + ch * 8
                                        : F.k + ((size_t)(bl * SEQ + ks + row)) * 256 + hk * 64 + ch * 8;
              const act_t* vsrc = isctx ? F.vTc + ((size_t)(bl * 4 + hk) * 64 + row) * CTXL + ks + ch * 8
                                        : F.vT + ((size_t)(bl * 4 + hk) * 64 + row) * SEQ + ks + ch * 8;
              *(u32x4*)(Kt + row * KLD + ch * 8) = *(const u32x4*)ksrc;
              *(u32x4*)(Vt + row * KLD + ch * 8) = *(const u32x4*)vsrc; }
            __syncthreads();
            const int j = tile - 4;
            const bool need = isctx || (half == 0 ? (j <= 4) : (j >= 1));
            if (need) {
                f32x16 st[2][2];
#pragma unroll
                for (int a = 0; a < 2; ++a)
#pragma unroll
                    for (int b = 0; b < 2; ++b)
#pragma unroll
                        for (int r = 0; r < 16; ++r) st[a][b][r] = 0.f;
#pragma unroll
                for (int s = 0; s < 4; ++s)
#pragma unroll
                    for (int kt = 0; kt < 2; ++kt) {
                        const bf16x8 a = *(const bf16x8*)(Kt + (kt * 32 + l31) * KLD + s * 16 + 8 * hi);
#pragma unroll
                        for (int qt = 0; qt < 2; ++qt) st[kt][qt] = __builtin_amdgcn_mfma_f32_32x32x16_bf16(a, qf[qt][s], st[kt][qt], 0, 0, 0);
                    }
                if (!isctx) {
#pragma unroll
                    for (int kt = 0; kt < 2; ++kt)
#pragma unroll
                        for (int qt = 0; qt < 2; ++qt) {
                            const int qp = nb * 128 + half * 64 + qt * 32 + l31;
#pragma unroll
                            for (int r = 0; r < 16; ++r) { const int kp = ks + kt * 32 + crow(r, hi); const int dd = qp - kp; if (dd > 128 || dd < -128) st[kt][qt][r] = -1e30f; }
                        }
                }
                bf16x8 pf[2][2][2];
#pragma unroll
                for (int qt = 0; qt < 2; ++qt) {
                    float mx = -1e30f;
#pragma unroll
                    for (int kt = 0; kt < 2; ++kt)
#pragma unroll
                        for (int r = 0; r < 16; ++r) mx = fmaxf(mx, st[kt][qt][r]);
                    mx = fmaxf(mx, __shfl_xor(mx, 32));
                    const float mn = fmaxf(mrun[qt], mx);
                    const float alpha = __builtin_amdgcn_exp2f(mrun[qt] - mn);
                    mrun[qt] = mn; lrun[qt] *= alpha;
#pragma unroll
                    for (int dt = 0; dt < 2; ++dt)
#pragma unroll
                        for (int r = 0; r < 16; ++r) O[dt][qt][r] *= alpha;
                    float ls = 0.f;
#pragma unroll
                    for (int kt = 0; kt < 2; ++kt) {
                        float p[16];
#pragma unroll
                        for (int r = 0; r < 16; ++r) { p[r] = __builtin_amdgcn_exp2f(st[kt][qt][r] - mn); ls += p[r]; }
#pragma unroll
                        for (int s2 = 0; s2 < 2; ++s2) {
                            u32x4 w;
                            w[0] = pk2(p[8 * s2 + 0], p[8 * s2 + 1]); w[1] = pk2(p[8 * s2 + 2], p[8 * s2 + 3]);
                            w[2] = pk2(p[8 * s2 + 4], p[8 * s2 + 5]); w[3] = pk2(p[8 * s2 + 6], p[8 * s2 + 7]);
                            pf[kt][s2][qt] = __builtin_bit_cast(bf16x8, w);
                        }
                    }
                    lrun[qt] += ls;
                }
#pragma unroll
                for (int kt = 0; kt < 2; ++kt)
#pragma unroll
                    for (int s2 = 0; s2 < 2; ++s2)
#pragma unroll
                        for (int dt = 0; dt < 2; ++dt) {
                            const bf16_t* vp = Vt + (dt * 32 + l31) * KLD + kt * 32 + s2 * 16 + 4 * hi;
                            const s16x4 lo = *(const s16x4*)vp, hh = *(const s16x4*)(vp + 8);
                            const bf16x8 a = (bf16x8){lo[0], lo[1], lo[2], lo[3], hh[0], hh[1], hh[2], hh[3]};
#pragma unroll
                            for (int qt = 0; qt < 2; ++qt) O[dt][qt] = __builtin_amdgcn_mfma_f32_32x32x16_bf16(a, pf[kt][s2][qt], O[dt][qt], 0, 0, 0);
                        }
            }
        }
        const float sk = F.sink[head] * LOG2E;
#pragma unroll
        for (int qt = 0; qt < 2; ++qt) {
            float lt = lrun[qt] + __shfl_xor(lrun[qt], 32);
            lt += __builtin_amdgcn_exp2f(sk - mrun[qt]);
            const float inv = 1.0f / lt;
            act_t* orow = F.att + (size_t)(r0 + qt * 32 + l31) * 1024 + head * 64;
#pragma unroll
            for (int dt = 0; dt < 2; ++dt)
#pragma unroll
                for (int g4 = 0; g4 < 4; ++g4) {
                    f32x4 o; o[0] = O[dt][qt][4 * g4] * inv; o[1] = O[dt][qt][4 * g4 + 1] * inv; o[2] = O[dt][qt][4 * g4 + 2] * inv; o[3] = O[dt][qt][4 * g4 + 3] * inv;
                    st4(orow + dt * 32 + 8 * g4 + 4 * hi, o);
                }
        }
    }
}
#endif

#if GOLD
constexpr int CTK = 32;
#else
constexpr int CTK = 64;
#endif
__device__ __forceinline__ void p3_conv(const Frame& F) {
    act_t* ub = (act_t*)F.lds;
    float* yb = (float*)(F.lds + (size_t)(CTK + 30) * 512 * AS);
    static_assert((CTK + 30) * 512 * AS + 8 * 512 * 4 <= LDS_MISC, "conv LDS");
    const int c = F.tid;
    float w[CONV_W];
#pragma unroll
    for (int i = 0; i < CONV_W; ++i) w[i] = F.conv_dw[i * CONV_CH + c];
    const float bias = F.conv_dw_b[c];
    constexpr int NT = T_ / CTK;
    for (int t = F.bid; t < NT; t += F.G) {
        const int r0 = t * CTK, bl = r0 / SEQ, s0 = r0 % SEQ;
        __syncthreads();
        constexpr int CPRW = 512 * AS / 16;
        for (int e = F.tid; e < (CTK + 30) * CPRW; e += 512) {
            const int rr = e / CPRW, ch = e % CPRW, sp = s0 + rr - 15;
            u32x4 v = (u32x4){0u, 0u, 0u, 0u};
            if (sp >= 0 && sp < SEQ) v = *(const u32x4*)((const unsigned char*)(F.u + (size_t)(bl * SEQ + sp) * 512) + ch * 16);
            *(u32x4*)((unsigned char*)ub + (size_t)rr * 512 * AS + ch * 16) = v;
        }
        __syncthreads();
        for (int chunk = 0; chunk < CTK / 8; ++chunk) {
#pragma unroll 1
            for (int tt = 0; tt < 8; ++tt) {
                const int tk = chunk * 8 + tt;
                float a = 0.f;
#pragma unroll
                for (int i = 0; i < CONV_W; ++i) a += ld_act(ub + (size_t)(tk + i) * 512 + c) * w[i];
                yb[tt * 512 + c] = a + bias;
            }
            __syncthreads();
            {
                const int tk = chunk * 8 + F.wid;
                float y[8];
                const f32x4 y0 = *(const f32x4*)(yb + F.wid * 512 + F.lane * 8), y1 = *(const f32x4*)(yb + F.wid * 512 + F.lane * 8 + 4);
                y[0] = y0[0]; y[1] = y0[1]; y[2] = y0[2]; y[3] = y0[3]; y[4] = y1[0]; y[5] = y1[1]; y[6] = y1[2]; y[7] = y1[3];
                float s = 0.f;
#pragma unroll
                for (int i = 0; i < 8; ++i) s += y[i];
                const float mean = wave_sum(s) * (1.0f / CONV_CH);
                float q = 0.f;
#pragma unroll
                for (int i = 0; i < 8; ++i) { y[i] -= mean; q += y[i] * y[i]; }
                const float rstd = 1.0f / sqrtf(wave_sum(q) * (1.0f / CONV_CH) + EPS);
                f32x4 o0, o1;
#pragma unroll
                for (int i = 0; i < 8; ++i) { const int ch = F.lane * 8 + i; const float z = y[i] * rstd * F.conv_ln_g[ch] + F.conv_ln_b[ch]; const float o = z * fsig(z); if (i < 4) o0[i] = o; else o1[i - 4] = o; }
                act_t* dst = F.cact + (size_t)(r0 + tk) * 512 + F.lane * 8;
                st4(dst, o0); st4(dst + 4, o1);
            }
            __syncthreads();
        }
    }
}

#if GOLD
__device__ __forceinline__ void p4_merge(const Frame& F) {
    constexpr int nM = T_ / 128, nN = 8;
    for (int t = F.bid; t < nM * nN; t += F.G) {
        const int pm = t / nN, pn = t % nN;
        f32x4 accA[2][4], accC[2][4]; acc_zero(accA); acc_zero(accC);
        mma_tile(accA, F.lds, F.att, 1024, F.woa_t, 1024, 1024, pm * 128, pn * 128);
        mma_tile(accC, F.lds, F.cact, 512, F.woc_t, 512, 512, pm * 128, pn * 128);
        const int lane = F.lane, wm = F.wid >> 1, wn = F.wid & 1, fr = lane & 15, fq = lane >> 4;
#pragma unroll
        for (int mi = 0; mi < 2; ++mi)
#pragma unroll
            for (int ni = 0; ni < 4; ++ni) {
                const int r = pm * 128 + wm * 32 + mi * 16 + fr, c = pn * 128 + wn * 64 + ni * 16 + 4 * fq;
                const f32x4 ga = ld4(F.sg + (size_t)r * 2048 + c), gc = ld4(F.sg + (size_t)r * 2048 + 1024 + c);
                st4(F.m + (size_t)r * 1024 + c, ga * accA[mi][ni] + gc * accC[mi][ni]);
            }
    }
}
__device__ __forceinline__ void p5_out(const Frame& F) {
    constexpr int nM = T_ / 128, nN = 8;
    for (int t = F.bid; t < nM * nN; t += F.G) {
        const int pm = t / nN, pn = t % nN;
        f32x4 acc[2][4]; acc_zero(acc);
        mma_tile(acc, F.lds, F.m, 1024, F.wout_t, 1024, 1024, pm * 128, pn * 128);
        const int lane = F.lane, wm = F.wid >> 1, wn = F.wid & 1, fr = lane & 15, fq = lane >> 4;
#pragma unroll
        for (int mi = 0; mi < 2; ++mi)
#pragma unroll
            for (int ni = 0; ni < 4; ++ni) {
                const int r = pm * 128 + wm * 32 + mi * 16 + fr, c = pn * 128 + wn * 64 + ni * 16 + 4 * fq;
                *(f32x4*)(F.mixed + (size_t)r * 1024 + c) = acc[mi][ni];
            }
    }
}
#else
__device__ __forceinline__ void p4_merge(const Frame& F) {
    run_gemm(F, F.att, F.woa_t, T_, 1024, 1024, [&](int r, int c, f32x4 v0, f32x4 v1) {
        const act_t* gp = F.sg + (size_t)r * 2048 + c; act_t* mp = F.m + (size_t)r * 1024 + c;
        st4(mp, ld4(gp) * v0); st4(mp + 16, ld4(gp + 16) * v1); });
    run_gemm(F, F.cact, F.woc_t, T_, 1024, 512, [&](int r, int c, f32x4 v0, f32x4 v1) {
        const act_t* gp = F.sg + (size_t)r * 2048 + 1024 + c; act_t* mp = F.m + (size_t)r * 1024 + c;
        st4(mp, ld4(mp) + ld4(gp) * v0); st4(mp + 16, ld4(mp + 16) + ld4(gp + 16) * v1); });
}
__device__ __forceinline__ void p5_out(const Frame& F) {
    run_gemm(F, F.m, F.wout_t, T_, 1024, 1024, [&](int r, int c, f32x4 v0, f32x4 v1) {
        float* p = F.mixed + (size_t)r * 1024 + c; *(f32x4*)p = v0; *(f32x4*)(p + 16) = v1; });
}
#endif
__device__ __forceinline__ void p6_rows(const Frame& F) {
    const int gw = F.bid * 8 + F.wid, NGW = F.G * 8;
    for (int r = gw; r < T_; r += NGW) {
        const float* mrow = F.mod + (size_t)(F.b0 + r / SEQ) * 6144;
        const float* xr = F.x + ((size_t)F.b0 * SEQ + r) * DM;
        float* outr = F.out + ((size_t)F.b0 * SEQ + r) * DM;
        f32x4 mv[4], x1[4]; float ss = 0.f;
#pragma unroll
        for (int j = 0; j < 4; ++j) { mv[j] = *(const f32x4*)(F.mixed + (size_t)r * 1024 + j * 256 + F.lane * 4); ss += mv[j][0] * mv[j][0] + mv[j][1] * mv[j][1] + mv[j][2] * mv[j][2] + mv[j][3] * mv[j][3]; }
        const float rstd = 1.0f / sqrtf(wave_sum(ss) * (1.0f / DM) + EPS);
        float s1 = 0.f;
#pragma unroll
        for (int j = 0; j < 4; ++j) { const int d = j * 256 + F.lane * 4;
            const f32x4 xv = *(const f32x4*)(xr + d), g = *(const f32x4*)(F.g_post_mix + d), gt = *(const f32x4*)(mrow + 2048 + d);
#pragma unroll
            for (int i = 0; i < 4; ++i) { x1[j][i] = xv[i] + gt[i] * ((mv[j][i] * rstd) * g[i]); s1 += x1[j][i] * x1[j][i]; }
            *(f32x4*)(outr + d) = x1[j]; }
        const float rstd1 = 1.0f / sqrtf(wave_sum(s1) * (1.0f / DM) + EPS);
#pragma unroll
        for (int j = 0; j < 4; ++j) { const int d = j * 256 + F.lane * 4;
            const f32x4 g = *(const f32x4*)(F.g_pre_ffn + d), sh = *(const f32x4*)(mrow + 3072 + d), sc = *(const f32x4*)(mrow + 4096 + d);
            f32x4 o;
#pragma unroll
            for (int i = 0; i < 4; ++i) o[i] = (x1[j][i] * rstd1) * g[i] * (1.0f + sc[i]) + sh[i];
            st4(F.h2 + (size_t)r * 1024 + d, o); }
    }
}
__device__ __forceinline__ void p7_wq(const Frame& F) {
#if GOLD
    constexpr int nM = T_ / 128, nN = PQW / 128;
    for (int t = F.bid; t < nM * nN; t += F.G) {
        const int pm = t / nN, pn = t % nN;
        f32x4 acc[2][4]; acc_zero(acc);
        mma_tile(acc, F.lds, F.h2, 1024, F.wq_t, 1024, 1024, pm * 128, pn * 128);
        const int lane = F.lane, wm = F.wid >> 1, wn = F.wid & 1, fr = lane & 15, fq = lane >> 4;
#pragma unroll
        for (int mi = 0; mi < 2; ++mi)
#pragma unroll
            for (int ni = 0; ni < 4; ++ni) {
                const int r = pm * 128 + wm * 32 + mi * 16 + fr, c = pn * 128 + wn * 64 + ni * 16 + 4 * fq;
                st4(F.pq + (size_t)r * PQW + c, acc[mi][ni]);
            }
    }
#else
    run_gemm(F, F.h2, F.wq_t, T_, PQW, 1024, [&](int r, int c, f32x4 v0, f32x4 v1) {
        act_t* p = F.pq + (size_t)r * PQW + c; st4(p, v0); st4(p + 16, v1); });
#endif
#if !GOLD
    for (size_t e = (size_t)F.bid * 512 + F.tid; e < (size_t)NEXP * 1024 / 16; e += (size_t)F.G * 512) {
        u32x4 wa, wb;
#pragma unroll
        for (int j = 0; j < 4; ++j) { const f32x4 a = *(const f32x4*)(F.peer_u + e * 16 + 4 * j), b = *(const f32x4*)(F.peer_v + e * 16 + 4 * j);
            int pa = 0, pb = 0;
            pa = __builtin_amdgcn_cvt_pk_fp8_f32(a[0] * 256.0f, a[1] * 256.0f, pa, false); pa = __builtin_amdgcn_cvt_pk_fp8_f32(a[2] * 256.0f, a[3] * 256.0f, pa, true);
            pb = __builtin_amdgcn_cvt_pk_fp8_f32(b[0] * 256.0f, b[1] * 256.0f, pb, false); pb = __builtin_amdgcn_cvt_pk_fp8_f32(b[2] * 256.0f, b[3] * 256.0f, pb, true);
            wa[j] = (unsigned)pa; wb[j] = (unsigned)pb; }
        *(u32x4*)(F.pu8 + e * 16) = wa; *(u32x4*)(F.pv8 + e * 16) = wb;
    }
#endif
}
__device__ __forceinline__ void p8_scores(const Frame& F) {
    constexpr int SLD = 132;
    float* st = (float*)(F.lds + GEMM_LDS);
    static_assert(GEMM_LDS + 128 * SLD * 4 <= LDS_MISC, "scores LDS");
    constexpr int nM = T_ / 128;
    for (int t = F.bid; t < nM * 16; t += F.G) {
        const int pm = t / 16, hp = t % 16;
        f32x4 acc[2][4]; acc_zero(acc);
        mma_tile(acc, F.lds, F.pq + hp * 128, PQW, F.keys_t + (size_t)hp * 128 * 128, 128, 128, pm * 128, 0);
        const int lane = F.lane, wm = F.wid >> 1, wn = F.wid & 1, fr = lane & 15, fq = lane >> 4;
#pragma unroll
        for (int mi = 0; mi < 2; ++mi)
#pragma unroll
            for (int ni = 0; ni < 4; ++ni) *(f32x4*)(st + (wm * 32 + mi * 16 + fr) * SLD + wn * 64 + ni * 16 + 4 * fq) = acc[mi][ni];
        __syncthreads();
        for (int rr = 0; rr < 16; ++rr) {
            const int row = F.wid * 16 + rr;
            const float* sr = st + row * SLD;
            const float v0 = sr[lane], v1 = sr[lane + 64];
            int c0 = 0, c1 = 0;
            for (int j4 = 0; j4 < 128; j4 += 4) {
                const f32x4 sj = *(const f32x4*)(sr + j4);
#pragma unroll
                for (int i = 0; i < 4; ++i) { const int j = j4 + i;
                    c0 += (sj[i] > v0 || (sj[i] == v0 && j < lane)) ? 1 : 0;
                    c1 += (sj[i] > v1 || (sj[i] == v1 && j < lane + 64)) ? 1 : 0; }
            }
            const size_t ob = ((size_t)(pm * 128 + row) * 16 + hp) * 16;
            if (c0 < 16) { F.topv[ob + c0] = v0; F.topi[ob + c0] = lane; }
            if (c1 < 16) { F.topv[ob + c1] = v1; F.topi[ob + c1] = lane + 64; }
        }
    }
}
__device__ __forceinline__ void p9_topk2(const Frame& F) {
    const int gw = F.bid * 8 + F.wid, NGW = F.G * 8, c = F.lane;
    int ci, cj;
    if (c < 16) { ci = 0; cj = c; } else if (c < 24) { ci = 1; cj = c - 16; } else if (c < 29) { ci = 2; cj = c - 24; } else if (c < 33) { ci = 3; cj = c - 29; }
    else if (c < 36) { ci = 4; cj = c - 33; } else if (c < 42) { ci = 5 + ((c - 36) >> 1); cj = (c - 36) & 1; } else { ci = 8 + (c - 42); cj = 0; }
    const bool valid = c < 50;
    if (!valid) { ci = 0; cj = 0; }
    for (int it = gw; it < T_ * 8; it += NGW) {
        const int r = it >> 3, h = it & 7;
        const size_t oa = ((size_t)r * 16 + 2 * h) * 16, ob = oa + 16;
        const float val = valid ? (F.topv[oa + ci] + F.topv[ob + cj]) : -INFINITY;
        const int pos = valid ? ci * 16 + cj : 1000;
        int rank = 0;
#pragma unroll
        for (int cc = 0; cc < 50; ++cc) {
            const float ov = __uint_as_float(__builtin_amdgcn_readlane(__float_as_uint(val), cc));
            const int op = __builtin_amdgcn_readlane(pos, cc);
            rank += (ov > val || (ov == val && op < pos)) ? 1 : 0;
        }
        const bool sel = valid && rank < 16;
        const float mx = wave_max(sel ? val : -INFINITY);
        const float e = sel ? expf(val - mx) : 0.f;
        const float sum = wave_sum(e);
        if (sel) { const size_t o = (size_t)r * 128 + h * 16 + rank; F.pei[o] = F.topi[oa + ci] * 128 + F.topi[ob + cj]; F.peg[o] = e / sum; }
    }
}
#if GOLD
__device__ __forceinline__ void p10_experts(const Frame& F) {
    const int gw = F.bid * 8 + F.wid, NGW = F.G * 8, lane = F.lane;
    constexpr int EPL = 4, NLD = 4;
    const float* TU = F.peer_u; const float* TV = F.peer_v;
    for (int r = gw; r < T_; r += NGW) {
        float hv[NLD][EPL], acc[NLD][EPL];
#pragma unroll
        for (int j = 0; j < NLD; ++j)
#pragma unroll
            for (int i = 0; i < EPL; ++i) { hv[j][i] = ld_act(F.h2 + (size_t)r * 1024 + j * 64 * EPL + lane * EPL + i); acc[j][i] = 0.f; }
        const int id0 = F.pei[(size_t)r * 128 + lane], id1 = F.pei[(size_t)r * 128 + 64 + lane];
        const float g0 = F.peg[(size_t)r * 128 + lane], g1 = F.peg[(size_t)r * 128 + 64 + lane];
        for (int e = 0; e < 128; ++e) {
            const int idx = __shfl((e < 64) ? id0 : id1, e & 63);
            const float gt = __shfl((e < 64) ? g0 : g1, e & 63);
            float uv[NLD][EPL], vv[NLD][EPL];
#pragma unroll
            for (int j = 0; j < NLD; ++j) {
                const f32x4 a = *(const f32x4*)(TU + (size_t)idx * 1024 + j * 256 + lane * 4), b = *(const f32x4*)(TV + (size_t)idx * 1024 + j * 256 + lane * 4);
#pragma unroll
                for (int i = 0; i < 4; ++i) { uv[j][i] = a[i]; vv[j][i] = b[i]; }
            }
            float d = 0.f;
#pragma unroll
            for (int j = 0; j < NLD; ++j)
#pragma unroll
                for (int i = 0; i < EPL; ++i) d += uv[j][i] * hv[j][i];
            d = wave_sum(d);
            const float act = 0.5f * d * (1.0f + erff(d * 0.70710678118654752f));
            const float wgt = gt * act;
#pragma unroll
            for (int j = 0; j < NLD; ++j)
#pragma unroll
                for (int i = 0; i < EPL; ++i) acc[j][i] += wgt * vv[j][i];
        }
        float ss = 0.f;
#pragma unroll
        for (int j = 0; j < NLD; ++j)
#pragma unroll
            for (int i = 0; i < EPL; ++i) ss += acc[j][i] * acc[j][i];
        const float rstd = 1.0f / sqrtf(wave_sum(ss) * (1.0f / DM) + EPS);
        const float* mrow = F.mod + (size_t)(F.b0 + r / SEQ) * 6144 + 5120;
        float* outr = F.out + ((size_t)F.b0 * SEQ + r) * DM;
#pragma unroll
        for (int j = 0; j < NLD; ++j)
#pragma unroll
            for (int i4 = 0; i4 < EPL; i4 += 4) { const int d0 = j * 64 * EPL + lane * EPL + i4;
                const f32x4 x1 = *(const f32x4*)(outr + d0), g = *(const f32x4*)(F.g_post_ffn + d0), gt2 = *(const f32x4*)(mrow + d0);
                f32x4 o;
#pragma unroll
                for (int i = 0; i < 4; ++i) o[i] = x1[i] + gt2[i] * ((acc[j][i4 + i] * rstd) * g[i]);
                *(f32x4*)(outr + d0) = o; }
    }
}
#else
#define P10_LOAD(U, V, b) do { _Pragma("unroll") for (int e_ = 0; e_ < 4; ++e_) { const int ent_ = 4 * (b) + e_; \
        const int idx_ = __builtin_amdgcn_readlane(((b) < 16) ? id0 : id1, ent_ & 63); \
        U[e_] = *(const u32x4*)(TU + (size_t)idx_ * 1024 + lane * 16); V[e_] = *(const u32x4*)(TV + (size_t)idx_ * 1024 + lane * 16); } } while (0)
#define P10_COMPUTE(U, V, b) do { float d_[4]; \
        _Pragma("unroll") for (int e_ = 0; e_ < 4; ++e_) { float s_ = 0.f; \
            _Pragma("unroll") for (int w_ = 0; w_ < 4; ++w_) { const f32x2 lo_ = __builtin_amdgcn_cvt_pk_f32_fp8((int)U[e_][w_], false), hi_ = __builtin_amdgcn_cvt_pk_f32_fp8((int)U[e_][w_], true); \
                s_ += lo_[0] * hv[4 * w_] + lo_[1] * hv[4 * w_ + 1] + hi_[0] * hv[4 * w_ + 2] + hi_[1] * hv[4 * w_ + 3]; } d_[e_] = s_; } \
        float d2_[2], d1_; \
        _Pragma("unroll") for (int e_ = 0; e_ < 2; ++e_) { const float k_ = b5 ? d_[e_ + 2] : d_[e_], s_ = b5 ? d_[e_] : d_[e_ + 2]; d2_[e_] = k_ + __shfl_xor(s_, 32); } \
        { const float k_ = b4 ? d2_[1] : d2_[0], s_ = b4 ? d2_[0] : d2_[1]; d1_ = k_ + __shfl_xor(s_, 16); } \
        d1_ += __shfl_xor(d1_, 8); d1_ += __shfl_xor(d1_, 4); d1_ += __shfl_xor(d1_, 2); d1_ += __shfl_xor(d1_, 1); \
        const float dot_ = d1_ * (1.0f / 256.0f); \
        const float act_ = 0.5f * dot_ * (1.0f + erff(dot_ * 0.70710678118654752f)); \
        const float gate_ = __shfl(((b) < 16) ? g0 : g1, (4 * (b) + eid) & 63); \
        const float wl_ = gate_ * act_ * (1.0f / 256.0f); \
        _Pragma("unroll") for (int e_ = 0; e_ < 4; ++e_) { \
            const float we_ = __uint_as_float(__builtin_amdgcn_readlane(__float_as_uint(wl_), (e_ & 1) * 16 + ((e_ >> 1) & 1) * 32)); \
            _Pragma("unroll") for (int w_ = 0; w_ < 4; ++w_) { const f32x2 lo_ = __builtin_amdgcn_cvt_pk_f32_fp8((int)V[e_][w_], false), hi_ = __builtin_amdgcn_cvt_pk_f32_fp8((int)V[e_][w_], true); \
                acc[4 * w_] += we_ * lo_[0]; acc[4 * w_ + 1] += we_ * lo_[1]; acc[4 * w_ + 2] += we_ * hi_[0]; acc[4 * w_ + 3] += we_ * hi_[1]; } } } while (0)
__device__ __forceinline__ void p10_experts(const Frame& F) {
    const int gw = F.bid * 8 + F.wid, NGW = F.G * 8, lane = F.lane;
    const unsigned char* TU = F.pu8; const unsigned char* TV = F.pv8;
    const bool b5 = (lane & 32) != 0, b4 = (lane & 16) != 0;
    const int eid = ((lane >> 4) & 1) | (((lane >> 5) & 1) << 1);
    for (int r = gw; r < T_; r += NGW) {
        float hv[16], acc[16];
        { const act_t* hp = F.h2 + (size_t)r * 1024 + lane * 16;
#pragma unroll
          for (int j = 0; j < 4; ++j) { const f32x4 t = ld4(hp + 4 * j); hv[4 * j] = t[0]; hv[4 * j + 1] = t[1]; hv[4 * j + 2] = t[2]; hv[4 * j + 3] = t[3]; } }
#pragma unroll
        for (int i = 0; i < 16; ++i) acc[i] = 0.f;
        const int id0 = F.pei[(size_t)r * 128 + lane], id1 = F.pei[(size_t)r * 128 + 64 + lane];
        const float g0 = F.peg[(size_t)r * 128 + lane], g1 = F.peg[(size_t)r * 128 + 64 + lane];
        u32x4 ua[4], va[4], ub[4], vb[4];
        P10_LOAD(ua, va, 0);
        for (int bb = 0; bb < 32; bb += 2) {
            P10_LOAD(ub, vb, bb + 1);
            P10_COMPUTE(ua, va, bb);
            if (bb + 2 < 32) P10_LOAD(ua, va, bb + 2);
            P10_COMPUTE(ub, vb, bb + 1);
        }
        float ss = 0.f;
#pragma unroll
        for (int i = 0; i < 16; ++i) ss += acc[i] * acc[i];
        const float rstd = 1.0f / sqrtf(wave_sum(ss) * (1.0f / DM) + EPS);
        const float* mrow = F.mod + (size_t)(F.b0 + r / SEQ) * 6144 + 5120;
        float* outr = F.out + ((size_t)F.b0 * SEQ + r) * DM;
#pragma unroll
        for (int j = 0; j < 4; ++j) { const int d0 = lane * 16 + 4 * j;
            const f32x4 x1 = *(const f32x4*)(outr + d0), g = *(const f32x4*)(F.g_post_ffn + d0), gt2 = *(const f32x4*)(mrow + d0);
            f32x4 o;
#pragma unroll
            for (int i = 0; i < 4; ++i) o[i] = x1[i] + gt2[i] * ((acc[4 * j + i] * rstd) * g[i]);
            *(f32x4*)(outr + d0) = o; }
    }
}
#endif

__global__ void __launch_bounds__(512, 2) fwd_kernel(Args a) {
    extern __shared__ __attribute__((aligned(16))) unsigned char lds[];
    Frame F;
    F.lds = lds; F.tid = threadIdx.x; F.lane = F.tid & 63; F.wid = __builtin_amdgcn_readfirstlane(F.tid >> 6); F.G = gridDim.x; F.bid = blockIdx.x; F.b0 = a.b0;
    F.x = a.in[0]; F.c = a.in[1]; F.ctx = a.in[2]; F.c_ctx = a.in[3]; F.w_ada = a.in[4]; F.b_ada = a.in[5]; F.g_pre_mix = a.in[6]; F.g_post_mix = a.in[7];
    F.g_pre_ffn = a.in[8]; F.g_post_ffn = a.in[9]; F.w_in = a.in[10]; F.sink = a.in[11]; F.w_o_attn = a.in[12]; F.conv_dw = a.in[13]; F.conv_dw_b = a.in[14];
    F.conv_ln_g = a.in[15]; F.conv_ln_b = a.in[16]; F.w_o_conv = a.in[17]; F.w_out = a.in[18]; F.peer_wq = a.in[19]; F.peer_keys = a.in[20]; F.peer_u = a.in[21]; F.peer_v = a.in[22];
    F.out = a.out;
    unsigned char* ws = a.ws;
    F.mod = (float*)(ws + WS_MOD); F.rope = (float*)(ws + WS_ROPE);
    F.win_t = (act_t*)(ws + WS_WIN); F.woa_t = (act_t*)(ws + WS_WOA); F.woc_t = (act_t*)(ws + WS_WOC); F.wout_t = (act_t*)(ws + WS_WOUT); F.wq_t = (act_t*)(ws + WS_WQ); F.keys_t = (act_t*)(ws + WS_KEYS);
    F.q = (act_t*)(ws + O_Q); F.k = (act_t*)(ws + O_K); F.vT = (act_t*)(ws + O_VT); F.u = (act_t*)(ws + O_U); F.sg = (act_t*)(ws + O_SG); F.kc = (act_t*)(ws + O_KC); F.vTc = (act_t*)(ws + O_VTC);
    F.att = (act_t*)(ws + O_ATT); F.cact = (act_t*)(ws + O_CACT); F.hx = (act_t*)(ws + O_HX); F.hc = (act_t*)(ws + O_HC); F.m = (act_t*)(ws + O_M); F.h2 = (act_t*)(ws + O_H2); F.pq = (act_t*)(ws + O_PQ);
    F.mixed = (float*)(ws + O_MIXED); F.topv = (float*)(ws + O_TOPV); F.topi = (int*)(ws + O_TOPI); F.pei = (int*)(ws + O_PEI); F.peg = (float*)(ws + O_PEG);
    F.pu8 = ws + O_PU; F.pv8 = ws + O_PV;

    volatile LAS unsigned* misc = (volatile LAS unsigned*)(LAS unsigned char*)(lds + LDS_MISC);
    if (F.tid < 64) misc[F.tid] = 0u;
    __syncthreads();
    const int lo = a.ph_lo, hi = a.ph_hi;
    XcdBarrier bar; bar.bar = (unsigned*)(ws + WS_CTL); bar.x = 0; bar.st = misc;
    if (hi - lo > 1) bar = xcd_barrier_post((unsigned*)(ws + WS_CTL), misc);
#define IN(k) (lo <= (k) && (k) < hi)
#define SEAM(k) do { if (IN(k) && IN((k) + 1)) xcd_barrier(bar); } while (0)
    if (IN(0)) { p0_prep(F); } SEAM(0);
    if (IN(1)) { p1_norm(F); } SEAM(1);
    if (IN(2)) { p2_inproj(F); } SEAM(2);
    if (IN(3)) { p3_attn(F); __syncthreads(); p3_conv(F); } SEAM(3);
    if (IN(4)) { p4_merge(F); } SEAM(4);
    if (IN(5)) { p5_out(F); } SEAM(5);
    if (IN(6)) { p6_rows(F); } SEAM(6);
    if (IN(7)) { p7_wq(F); } SEAM(7);
    if (IN(8)) { p8_scores(F); } SEAM(8);
    if (IN(9)) { p9_topk2(F); } SEAM(9);
    if (IN(10)) { p10_experts(F); }
#undef IN
#undef SEAM
}

extern "C" void kernel_launch(void* const* d_in, const int* in_sizes, int n_in, void* d_out, int out_size, void* d_ws, size_t ws_size, hipStream_t stream) {
    static int grid = 0;
    if (grid == 0) {
        if (n_in != 23 || ws_size < WS_END) { fprintf(stderr, "kernel_launch: need 23 inputs and %zu B of workspace (got %d, %zu)\n", (size_t)WS_END, n_in, ws_size); grid = -1; return; }
        int dev = 0, cus = 0;
        if (hipGetDevice(&dev) != hipSuccess || hipDeviceGetAttribute(&cus, hipDeviceAttributeMultiprocessorCount, dev) != hipSuccess) { grid = -1; return; }
        if (hipFuncSetAttribute((const void*)fwd_kernel, hipFuncAttributeMaxDynamicSharedMemorySize, LDS_BYTES) != hipSuccess) { fprintf(stderr, "kernel_launch: hipFuncSetAttribute failed\n"); grid = -1; return; }
        grid = cus;
    }
    if (grid < 0) return;
    (void)hipMemsetAsync((char*)d_ws + WS_CTL, 0, CTL_BYTES, stream);
    Args a{};
    for (int i = 0; i < 23; ++i) a.in[i] = (const float*)d_in[i];
    a.out = (float*)d_out; a.ws = (unsigned char*)d_ws;
#if ONE_LAUNCH
    a.ph_lo = 0; a.ph_hi = NPHASE; a.b0 = 0;
    hipLaunchKernelGGL(fwd_kernel, dim3(grid), dim3(512), LDS_BYTES, stream, a);
#else
    a.ph_lo = 0; a.ph_hi = 1; a.b0 = 0;
    hipLaunchKernelGGL(fwd_kernel, dim3(grid), dim3(512), LDS_BYTES, stream, a);
    for (int b0 = 0; b0 < BATCH; b0 += CH_B)
        for (int ph = 1; ph < NPHASE; ++ph) { a.ph_lo = ph; a.ph_hi = ph + 1; a.b0 = b0; hipLaunchKernelGGL(fwd_kernel, dim3(grid), dim3(512), LDS_BYTES, stream, a); }
#endif
}
```

```cpp
#include <hip/hip_runtime.h>
#include <cstdint>
#include <cstdio>

#ifndef GOLD
#define GOLD 0
#endif
#ifndef PROBE_PH
#define PROBE_PH -1
#endif
#ifndef PROBE_N
#define PROBE_N 2
#endif
#ifndef ONE_LAUNCH
#define ONE_LAUNCH 1
#endif

typedef unsigned short bf16_t;
typedef short bf16x8 __attribute__((ext_vector_type(8)));
typedef short s16x4 __attribute__((ext_vector_type(4)));
typedef float f32x4 __attribute__((ext_vector_type(4)));
typedef float f32x16 __attribute__((ext_vector_type(16)));
typedef unsigned u32x2 __attribute__((ext_vector_type(2)));
typedef unsigned u32x4 __attribute__((ext_vector_type(4)));
typedef float f32x2 __attribute__((ext_vector_type(2)));

#if GOLD
typedef float act_t;
#else
typedef bf16_t act_t;
#endif
constexpr int AS = sizeof(act_t);

constexpr int DM = 1024, BATCH = 8, SEQ = 2048, CTXL = 256, NH = 16, NKV = 4, HD = 64;
constexpr int INW = 4608, PQW = 2048, NEXP = 16384;
constexpr int CONV_CH = 512, CONV_W = 31;
constexpr float EPS = 1e-6f;
constexpr float LOG2E = 1.4426950408889634f;
constexpr float QS = 0.125f * LOG2E;
#if GOLD
constexpr int CH_B = 1;
#else
constexpr int CH_B = 8;
#endif
constexpr int T_ = CH_B * SEQ;
constexpr int CT_ = CH_B * CTXL;
constexpr int NPHASE = 10;

constexpr size_t MiB = 1u << 20;
constexpr size_t WS_CTL = 0, CTL_BYTES = 1 * MiB;
constexpr size_t WS_MOD = 512 * 1024;
constexpr size_t WS_ROPE = 1 * MiB;
constexpr size_t WS_WIN = 2 * MiB;
constexpr size_t WS_WOA = 22 * MiB;
constexpr size_t WS_WOC = 26 * MiB;
constexpr size_t WS_WOUT = 28 * MiB;
constexpr size_t WS_WQ = 32 * MiB;
constexpr size_t WS_KEYS = 40 * MiB;
constexpr size_t AR = 42 * MiB;
constexpr size_t A0 = AR;
constexpr size_t O_Q = A0;
constexpr size_t O_K = O_Q + (size_t)T_ * 1024 * AS;
constexpr size_t O_VT = O_K + (size_t)T_ * 256 * AS;
constexpr size_t O_U = O_VT + (size_t)T_ * 256 * AS;
constexpr size_t O_SG = O_U + (size_t)T_ * 512 * AS;
constexpr size_t O_KC = O_SG + (size_t)T_ * 2048 * AS;
constexpr size_t O_VTC = O_KC + (size_t)CT_ * 256 * AS;
constexpr size_t A0_END = O_VTC + (size_t)CT_ * 256 * AS;
constexpr size_t O_MIXED = A0;
constexpr size_t O_PQ = A0 + (size_t)T_ * 4096;
constexpr size_t O_TOPV = A0;
constexpr size_t O_TOPI = A0 + (size_t)T_ * 1024;
constexpr size_t O_PV = A0 + 32 * MiB;
constexpr size_t A1 = A0_END;
constexpr size_t O_ATT = A1;
constexpr size_t O_CACT = O_ATT + (size_t)T_ * 1024 * AS;
constexpr size_t A1_END = O_CACT + (size_t)T_ * 512 * AS;
constexpr size_t O_HX = A1;
constexpr size_t O_HC = A1 + (size_t)T_ * 1024 * AS;
constexpr size_t O_PU = A1;
constexpr size_t O_PEI = O_CACT;
constexpr size_t O_PEG = O_CACT + (size_t)T_ * 512;
constexpr size_t A2 = A1_END;
constexpr size_t O_M = A2;
constexpr size_t O_H2 = A2;
constexpr size_t WS_END = A2 + (size_t)T_ * 1024 * AS;
static_assert(O_PQ + (size_t)T_ * 2048 * AS <= A0_END, "pq overlay");
static_assert(O_TOPI + (size_t)T_ * 1024 <= O_PQ, "topk overlay");
static_assert(GOLD || (O_PV >= O_TOPI + (size_t)T_ * 1024 && O_PV + 32 * MiB <= O_PQ), "pv overlay");
static_assert(GOLD || (O_PU + 32 * MiB <= O_PEI), "pu overlay");
static_assert(O_PEG + (size_t)T_ * 512 <= A1_END, "pe overlay");
static_assert(O_HC + (size_t)CT_ * 1024 * AS <= A1_END, "hc overlay");

constexpr int LDS_BYTES = 147456;
constexpr int LDS_MISC = LDS_BYTES - 256;

__device__ __forceinline__ float bf2f(bf16_t h) { return __uint_as_float((unsigned)h << 16); }
__device__ __forceinline__ unsigned f2bf(float f) { unsigned u = __float_as_uint(f); return (u + 0x7fffu + ((u >> 16) & 1u)) >> 16; }
__device__ __forceinline__ unsigned pk2(float lo, float hi) { return f2bf(lo) | (f2bf(hi) << 16); }
#if GOLD
__device__ __forceinline__ float ld_act(const act_t* p) { return *p; }
__device__ __forceinline__ void st_act(act_t* p, float v) { *p = v; }
__device__ __forceinline__ f32x4 ld4(const act_t* p) { return *(const f32x4*)p; }
__device__ __forceinline__ void st4(act_t* p, f32x4 v) { *(f32x4*)p = v; }
#else
__device__ __forceinline__ float ld_act(const act_t* p) { return bf2f(*p); }
__device__ __forceinline__ void st_act(act_t* p, float v) { *p = (bf16_t)f2bf(v); }
__device__ __forceinline__ f32x4 ld4(const act_t* p) { u32x2 w = *(const u32x2*)p; f32x4 r; r[0] = __uint_as_float(w[0] << 16); r[1] = __uint_as_float(w[0] & 0xffff0000u); r[2] = __uint_as_float(w[1] << 16); r[3] = __uint_as_float(w[1] & 0xffff0000u); return r; }
__device__ __forceinline__ void st4(act_t* p, f32x4 v) { u32x2 w; w[0] = pk2(v[0], v[1]); w[1] = pk2(v[2], v[3]); *(u32x2*)p = w; }
#endif
__device__ __forceinline__ float wave_sum(float v) {
#pragma unroll
    for (int o = 1; o < 64; o <<= 1) v += __shfl_xor(v, o);
    return v;
}
__device__ __forceinline__ float wave_max(float v) {
#pragma unroll
    for (int o = 1; o < 64; o <<= 1) v = fmaxf(v, __shfl_xor(v, o));
    return v;
}
__device__ __forceinline__ float sigmoidf_(float x) { return 1.0f / (1.0f + expf(-x)); }
__device__ __forceinline__ int crow(int r, int hi) { return (r & 3) + 8 * (r >> 2) + 4 * hi; }

#define LAS __attribute__((address_space(3)))
#define XB_TMO      128
#define XB_XCNT(j)  (256  + 64 * (j))
#define XB_XSUB(j)  (1280 + 64 * (j))
#define XB_XGEN(j)  (2304 + 64 * (j))
#define XB_TOP      3328
#define XB_TOPGEN   3392
#define XCD_BAR_WORDS 3456
#define XB_SPIN_CAP (1u << 18)
__device__ __forceinline__ unsigned xb_ld(unsigned* p)              { return __hip_atomic_load(p, __ATOMIC_RELAXED, __HIP_MEMORY_SCOPE_AGENT); }
__device__ __forceinline__ unsigned xb_add(unsigned* p, unsigned v) { return __hip_atomic_fetch_add(p, v, __ATOMIC_RELAXED, __HIP_MEMORY_SCOPE_AGENT); }
__device__ __forceinline__ unsigned xb_xcc_id() { return (unsigned)__builtin_amdgcn_s_getreg((3 << 11) | 20) & 0xFu; }
#define XB_SPIN(cond, bar) do { unsigned _sp = 0; while (cond) { __builtin_amdgcn_s_sleep(1); \
    if ((++_sp & 255u) == 0u) { if (xb_ld(&(bar)[XB_TMO])) break; if (_sp > XB_SPIN_CAP) { atomicAdd(&(bar)[XB_TMO], 1u); break; } } } } while (0)
struct XcdBarrier { unsigned* bar; unsigned x; volatile LAS unsigned* st; };
__device__ __forceinline__ XcdBarrier xcd_barrier_post(unsigned* bar, volatile LAS unsigned* st) {
    XcdBarrier b; b.bar = bar; b.x = xb_xcc_id(); b.st = st;
    if (threadIdx.x == 0) (void)xb_add(&bar[XB_XCNT(b.x)], 1u);
    return b;
}
__device__ __forceinline__ void xcd_barrier_complete(unsigned* bar, unsigned x, unsigned& nloc, unsigned& nx) {
    const unsigned G = gridDim.x * gridDim.y * gridDim.z;
    unsigned sum, cnt, mine, sp = 0u;
    for (;;) {
        sum = 0u; cnt = 0u; mine = 0u;
#pragma unroll
        for (unsigned j = 0; j < 16; ++j) { const unsigned c = xb_ld(&bar[XB_XCNT(j)]); sum += c; cnt += (c > 0u) ? 1u : 0u; mine = (j == x) ? c : mine; }
        if (sum == G) break;
        __builtin_amdgcn_s_sleep(1);
        if ((++sp & 255u) == 0u) { if (xb_ld(&bar[XB_TMO])) break; if (sp > XB_SPIN_CAP) { atomicAdd(&bar[XB_TMO], 1u); break; } }
    }
    nloc = mine > 0u ? mine : 1u; nx = cnt > 0u ? cnt : 1u;
}
__device__ __forceinline__ void xcd_barrier(const XcdBarrier& b) {
    asm volatile("s_waitcnt vmcnt(0)" ::: "memory");
    __syncthreads();
    if (threadIdx.x == 0) {
        unsigned* bar = b.bar;
        __builtin_amdgcn_s_waitcnt(0);
        unsigned nloc = b.st[0], nx = b.st[1];
        if (nloc == 0u) { xcd_barrier_complete(bar, b.x, nloc, nx); b.st[0] = nloc; b.st[1] = nx; }
        const unsigned old = xb_add(&bar[XB_XSUB(b.x)], 1u);
        const unsigned gen = old / nloc;
        if (old + 1u == (gen + 1u) * nloc) {
            __builtin_amdgcn_fence(__ATOMIC_RELEASE, "agent");
            asm volatile("s_waitcnt vmcnt(0)" ::: "memory");
            const unsigned og = xb_add(&bar[XB_TOP], 1u);
            const unsigned tg = og / nx;
            if (og + 1u == (tg + 1u) * nx) xb_add(&bar[XB_TOPGEN], 1u);
            else XB_SPIN(xb_ld(&bar[XB_TOPGEN]) == tg, bar);
            __builtin_amdgcn_fence(__ATOMIC_ACQUIRE, "agent");
            xb_add(&bar[XB_XGEN(b.x)], 1u);
            asm volatile("s_waitcnt vmcnt(0)" ::: "memory");
        } else {
            XB_SPIN(xb_ld(&bar[XB_XGEN(b.x)]) == gen, bar);
            __builtin_amdgcn_fence(__ATOMIC_ACQUIRE, "agent");
            asm volatile("s_waitcnt vmcnt(0)" ::: "memory");
        }
    }
    __syncthreads();
}

struct Args { const float* in[23]; float* out; unsigned char* ws; int ph_lo, ph_hi, b0, pad; };

struct Frame {
    unsigned char* lds;
    int tid, lane, wid, G, bid;
    int b0;
    const float *x, *c, *ctx, *c_ctx, *w_ada, *b_ada, *g_pre_mix, *g_post_mix, *g_pre_ffn, *g_post_ffn, *w_in, *sink, *w_o_attn,
        *conv_dw, *conv_dw_b, *conv_ln_g, *conv_ln_b, *w_o_conv, *w_out, *peer_wq, *peer_keys, *peer_u, *peer_v;
    float* out;
    float* mod; float* rope;
    act_t *win_t, *woa_t, *woc_t, *wout_t, *wq_t, *keys_t;
    act_t *q, *k, *vT, *u, *sg, *kc, *vTc, *att, *cact, *hx, *hc, *m, *h2, *pq;
    float *mixed, *topv, *peg; int *topi, *pei;
    unsigned char *pu8, *pv8;
};

constexpr int BK = 32;
#if GOLD
constexpr int LDT = 36;
#else
constexpr int LDT = 40;
#endif
constexpr int TILE_LDS = 128 * LDT * AS;
constexpr int GEMM_LDS = 2 * TILE_LDS;

__device__ __forceinline__ void acc_zero(f32x4 (&acc)[2][4]) {
#pragma unroll
    for (int i = 0; i < 2; ++i)
#pragma unroll
        for (int j = 0; j < 4; ++j) acc[i][j] = (f32x4){0.f, 0.f, 0.f, 0.f};
}

__device__ __forceinline__ void mma_tile(f32x4 (&acc)[2][4], unsigned char* lds, const act_t* __restrict__ A, int lda,
                                         const act_t* __restrict__ Bt, int ldb, int K, int m0, int n0) {
    const int tid = threadIdx.x, lane = tid & 63, wid = tid >> 6, wm = wid >> 1, wn = wid & 1, fr = lane & 15, fq = lane >> 4;
    act_t* As = (act_t*)lds; act_t* Bs = (act_t*)(lds + TILE_LDS);
    constexpr int EPC = 16 / AS, CPR = BK / EPC, NCH = 128 * CPR / 512;
    u32x4 ra[NCH], rb[NCH];
#pragma unroll
    for (int i = 0; i < NCH; ++i) { const int cidx = tid + 512 * i, row = cidx / CPR, ch = cidx % CPR;
        ra[i] = *(const u32x4*)(A + (size_t)(m0 + row) * lda + ch * EPC);
        rb[i] = *(const u32x4*)(Bt + (size_t)(n0 + row) * ldb + ch * EPC); }
    const int nk = K / BK;
    for (int kt = 0; kt < nk; ++kt) {
        __syncthreads();
#pragma unroll
        for (int i = 0; i < NCH; ++i) { const int cidx = tid + 512 * i, row = cidx / CPR, ch = cidx % CPR;
            *(u32x4*)(As + row * LDT + ch * EPC) = ra[i];
            *(u32x4*)(Bs + row * LDT + ch * EPC) = rb[i]; }
        __syncthreads();
        if (kt + 1 < nk) {
            const int k1 = (kt + 1) * BK;
#pragma unroll
            for (int i = 0; i < NCH; ++i) { const int cidx = tid + 512 * i, row = cidx / CPR, ch = cidx % CPR;
                ra[i] = *(const u32x4*)(A + (size_t)(m0 + row) * lda + k1 + ch * EPC);
                rb[i] = *(const u32x4*)(Bt + (size_t)(n0 + row) * ldb + k1 + ch * EPC); }
        }
#if GOLD
        f32x4 a4[2][2], b4[4][2];
#pragma unroll
        for (int mi = 0; mi < 2; ++mi)
#pragma unroll
            for (int g = 0; g < 2; ++g) a4[mi][g] = *(const f32x4*)(As + (wm * 32 + mi * 16 + fr) * LDT + 16 * g + 4 * fq);
#pragma unroll
        for (int ni = 0; ni < 4; ++ni)
#pragma unroll
            for (int g = 0; g < 2; ++g) b4[ni][g] = *(const f32x4*)(Bs + (wn * 64 + ni * 16 + fr) * LDT + 16 * g + 4 * fq);
#pragma unroll
        for (int mi = 0; mi < 2; ++mi)
#pragma unroll
            for (int ni = 0; ni < 4; ++ni)
#pragma unroll
                for (int g = 0; g < 2; ++g)
#pragma unroll
                    for (int j = 0; j < 4; ++j) acc[mi][ni] = __builtin_amdgcn_mfma_f32_16x16x4f32(b4[ni][g][j], a4[mi][g][j], acc[mi][ni], 0, 0, 0);
#else
        bf16x8 af[2], bfr[4];
#pragma unroll
        for (int mi = 0; mi < 2; ++mi) af[mi] = *(const bf16x8*)(As + (wm * 32 + mi * 16 + fr) * LDT + fq * 8);
#pragma unroll
        for (int ni = 0; ni < 4; ++ni) bfr[ni] = *(const bf16x8*)(Bs + (wn * 64 + ni * 16 + fr) * LDT + fq * 8);
#pragma unroll
        for (int mi = 0; mi < 2; ++mi)
#pragma unroll
            for (int ni = 0; ni < 4; ++ni) acc[mi][ni] = __builtin_amdgcn_mfma_f32_16x16x32_bf16(bfr[ni], af[mi], acc[mi][ni], 0, 0, 0);
#endif
    }
}
template <class F> __device__ __forceinline__ void epi_foreach(const f32x4 (&acc)[2][4], int m0, int n0, F f) {
    const int tid = threadIdx.x, lane = tid & 63, wid = tid >> 6, wm = wid >> 1, wn = wid & 1, fr = lane & 15, fq = lane >> 4;
#pragma unroll
    for (int mi = 0; mi < 2; ++mi)
#pragma unroll
        for (int gp = 0; gp < 2; ++gp) f(m0 + wm * 32 + mi * 16 + fr, n0 + wn * 64 + gp * 32 + 4 * fq, acc[mi][2 * gp], acc[mi][2 * gp + 1]);
}


#if !GOLD
namespace pg8 {
#define PG8_LAS __attribute__((address_space(3)))
typedef unsigned short bf16_t;
typedef short bf16x8 __attribute__((ext_vector_type(8)));
typedef float f32x4 __attribute__((ext_vector_type(4)));
typedef unsigned u32x4 __attribute__((ext_vector_type(4)));
constexpr int BM = 256, BK = 64, HALF = 128, HTB = HALF * BK * 2  , STAGE_BYTES = 8 * HTB, NXCD = 8, WGM = 8;

__host__ __device__ __forceinline__ int lds_byte(int r, int c) { const int st = (r >> 4) * 2 + (c >> 5), rr = r & 15, cc = c & 31, ob = rr * 64 + cc * 2; return st * 1024 + (ob ^ (((ob >> 9) & 1) << 5)); }
__host__ __device__ __forceinline__ void stage_rc(int b, int& R, int& C) { const int st = b / 1024, sb = b % 1024, swz = sb ^ (((sb >> 9) & 1) << 5); R = (st >> 1) * 16 + swz / 64; C = (st & 1) * 32 + (swz % 64) / 2; }
__host__ __device__ __forceinline__ int perm32(int rho) { const int n = rho >> 4, i = rho & 15; return 8 * (i >> 2) + 4 * n + (i & 3); }

struct Unit { int pm, pn; };
struct Gemm { const bf16_t* A; const bf16_t* Bt; int M, N, K; };

struct StaticOrder {
    int nM, nN, nwg, G, c;
    __host__ __device__ void init(int M, int N, int G_, int c_) { nM = M / BM; nN = N / BM; nwg = nM * nN; G = G_; c = c_; }
    __host__ __device__ bool next(int i, Unit& u) const {
        const long L = (long)i * G + c; if (L >= nwg) return false;
        int wgid = (int)L; { const int q = nwg / NXCD, r = nwg % NXCD, xcd = wgid % NXCD, off = wgid / NXCD; wgid = (xcd < r ? xcd * (q + 1) : r * (q + 1) + (xcd - r) * q) + off; }
        const int nig = WGM * nN, gid = wgid / nig, fm = gid * WGM, gsz = (nM - fm) < WGM ? (nM - fm) : WGM;
        u.pm = fm + ((wgid % nig) % gsz); u.pn = (wgid % nig) / gsz; return true;
    }
    __device__ __forceinline__ void a_ready(const Unit&) const {}
    __device__ __forceinline__ void done(const Unit&) const {}
};
template <class Epi, class Sched, bool ALIGN_EPI = false, bool SP2 = false>
__device__ __forceinline__ void gemm_phase(PG8_LAS unsigned char* lds, const Gemm g, const Sched& S, const Epi& E) {
    const int tid = threadIdx.x, wid = __builtin_amdgcn_readfirstlane(tid >> 6), lane = tid & 63, wr = wid >> 2, wc = wid & 3, fr = lane & 15, fq = lane >> 4;
    const int K = g.K, nt = K / BK;
    unsigned voffA[2], voffB[2];
#pragma unroll
    for (int i = 0; i < 2; ++i) { int R, C; stage_rc(tid * 16 + i * 8192, R, C); const int Rb = Epi::PERM ? ((R & ~31) + perm32(R & 31)) : R;
        voffA[i] = (unsigned)(R * K + C) * 2u; voffB[i] = (unsigned)(Rb * K + C) * 2u; }
    const size_t kstep = (size_t)(BK * 2);
    const size_t hstep = (size_t)HALF * K * 2;
    const size_t tstep = 2 * hstep;
    const unsigned ldsw = (unsigned)wid * 1024u;
    const int aoff = lds_byte(wr * 64 + fr, fq * 8), boff = lds_byte(wc * 32 + fr, fq * 8);
#define PG8_SA(b, h) (((b) * 2 + (h)) * HTB)
#define PG8_SB(b, h) ((4 + (b) * 2 + (h)) * HTB)
#define PG8_STAGE(bufoff, gbase, voff) do { _Pragma("unroll") for (int _i = 0; _i < 2; ++_i) \
        __builtin_amdgcn_global_load_lds((const unsigned*)((const char*)(gbase) + (voff)[_i]), (PG8_LAS unsigned*)(lds + (bufoff) + ldsw + _i * 8192), 16, 0, 0); } while (0)
#define PG8_LDA(dst, b, h) do { _Pragma("unroll") for (int m = 0; m < 4; ++m) _Pragma("unroll") for (int k = 0; k < 2; ++k) dst[m][k] = *(const PG8_LAS bf16x8*)(lds + PG8_SA(b, h) + aoff + m * 2048 + k * 1024); } while (0)
#define PG8_LDB(dst, b, h) do { _Pragma("unroll") for (int n = 0; n < 2; ++n) _Pragma("unroll") for (int k = 0; k < 2; ++k) dst[n][k] = *(const PG8_LAS bf16x8*)(lds + PG8_SB(b, h) + boff + n * 2048 + k * 1024); } while (0)
#define PG8_MMA(ai, bj, At, Bt) do { __builtin_amdgcn_s_setprio(1); _Pragma("unroll") for (int m = 0; m < 4; ++m) _Pragma("unroll") for (int n = 0; n < 2; ++n) _Pragma("unroll") for (int k = 0; k < 2; ++k) \
        acc[ai][bj][m][n] = __builtin_amdgcn_mfma_f32_16x16x32_bf16(Bt[n][k], At[m][k], acc[ai][bj][m][n], 0, 0, 0); __builtin_amdgcn_s_setprio(0); } while (0)
#define PG8_WAIT_V(n) asm volatile("s_waitcnt vmcnt(" #n ")" ::: "memory")
#define PG8_WAIT_L(n) asm volatile("s_waitcnt lgkmcnt(" #n ")" ::: "memory")
#define PG8_BAR __builtin_amdgcn_s_barrier()
#define PG8_SCHED __builtin_amdgcn_sched_barrier(0)
    Unit cur, nxt; int ui = 0;
    if (!S.next(0, cur)) return;
    f32x4 acc[2][2][4][2];
#pragma unroll
    for (int a = 0; a < 2; ++a)
#pragma unroll
        for (int b = 0; b < 2; ++b)
#pragma unroll
            for (int m = 0; m < 4; ++m)
#pragma unroll
                for (int n = 0; n < 2; ++n) acc[a][b][m][n] = (f32x4){0.f, 0.f, 0.f, 0.f};
    bf16x8 At[4][2], B0[2][2], B1[2][2];
    const char* cA = (const char*)g.A + (size_t)cur.pm * tstep; const char* cB = (const char*)g.Bt + (size_t)cur.pn * tstep;
    S.a_ready(cur);
    if constexpr (SP2) {
        PG8_STAGE(PG8_SB(0, 0), cB, voffB); PG8_STAGE(PG8_SB(0, 1), cB + hstep, voffB); PG8_STAGE(PG8_SA(0, 0), cA, voffA); PG8_STAGE(PG8_SA(0, 1), cA + hstep, voffA);
        if (wr == 1) PG8_BAR;
        PG8_WAIT_V(2); PG8_BAR;
        PG8_STAGE(PG8_SB(1, 0), cB + kstep, voffB); PG8_STAGE(PG8_SA(1, 0), cA + kstep, voffA); PG8_STAGE(PG8_SB(1, 1), cB + hstep + kstep, voffB);
        PG8_WAIT_V(6); PG8_BAR;
    } else {
        PG8_STAGE(PG8_SB(0, 0), cB, voffB); PG8_STAGE(PG8_SA(0, 0), cA, voffA); PG8_STAGE(PG8_SB(0, 1), cB + hstep, voffB); PG8_STAGE(PG8_SA(0, 1), cA + hstep, voffA);
        if (wr == 1) PG8_BAR;
        PG8_WAIT_V(4); PG8_BAR;
        PG8_STAGE(PG8_SB(1, 0), cB + kstep, voffB); PG8_STAGE(PG8_SA(1, 0), cA + kstep, voffA); PG8_STAGE(PG8_SB(1, 1), cB + hstep + kstep, voffB);
        PG8_WAIT_V(6); PG8_BAR;
    }
    for (;;) {
        const bool has_next = S.next(ui + 1, nxt);
        const char* nA = has_next ? (const char*)g.A + (size_t)nxt.pm * tstep : cA; const char* nB = has_next ? (const char*)g.Bt + (size_t)nxt.pn * tstep : cB;
        for (int t = 0; t < nt; t += 2) {
            const bool last = (t == nt - 2);
            const char* a1 = cA + (size_t)(t + 1) * kstep;
            const char* a2 = last ? nA : cA + (size_t)(t + 2) * kstep; const char* b2 = last ? nB : cB + (size_t)(t + 2) * kstep;
            const char* a3 = a2 + kstep; const char* b3 = b2 + kstep;
            if (last && has_next) S.a_ready(nxt);
            if constexpr (SP2) {
            PG8_LDB(B0, 0, 0); PG8_LDB(B1, 0, 1); PG8_SCHED; PG8_LDA(At, 0, 0); PG8_STAGE(PG8_SA(1, 1), a1 + hstep, voffA);
            PG8_WAIT_V(8); PG8_WAIT_L(0); PG8_BAR; PG8_MMA(0, 0, At, B0); PG8_MMA(0, 1, At, B1); PG8_BAR; PG8_SCHED;
            PG8_LDA(At, 0, 1); PG8_STAGE(PG8_SB(0, 0), b2, voffB); PG8_STAGE(PG8_SB(0, 1), b2 + hstep, voffB); PG8_STAGE(PG8_SA(0, 0), a2, voffA);
            PG8_WAIT_V(8); PG8_WAIT_L(0); PG8_BAR; PG8_MMA(1, 0, At, B0); PG8_MMA(1, 1, At, B1); PG8_BAR; PG8_SCHED;
            PG8_LDB(B0, 1, 0); PG8_LDB(B1, 1, 1); PG8_SCHED; PG8_LDA(At, 1, 0); PG8_STAGE(PG8_SA(0, 1), a2 + hstep, voffA);
            PG8_WAIT_V(8); PG8_WAIT_L(0); PG8_BAR; PG8_MMA(0, 0, At, B0); PG8_MMA(0, 1, At, B1); PG8_BAR; PG8_SCHED;
            PG8_LDA(At, 1, 1); PG8_STAGE(PG8_SB(1, 0), b3, voffB); PG8_STAGE(PG8_SB(1, 1), b3 + hstep, voffB); PG8_STAGE(PG8_SA(1, 0), a3, voffA);
            PG8_WAIT_V(8); PG8_WAIT_L(0); PG8_BAR; PG8_MMA(1, 0, At, B0); PG8_MMA(1, 1, At, B1); PG8_BAR; PG8_SCHED;
            } else {
            PG8_LDB(B0, 0, 0); PG8_SCHED; PG8_LDA(At, 0, 0); PG8_STAGE(PG8_SA(1, 1), a1 + hstep, voffA);
            PG8_WAIT_L(8); PG8_BAR; PG8_WAIT_L(0); PG8_MMA(0, 0, At, B0); PG8_BAR; PG8_SCHED;
            PG8_LDB(B1, 0, 1); PG8_STAGE(PG8_SB(0, 0), b2, voffB);
            PG8_BAR; PG8_WAIT_L(0); PG8_MMA(0, 1, At, B1); PG8_BAR;
            PG8_LDA(At, 0, 1); PG8_STAGE(PG8_SA(0, 0), a2, voffA);
            PG8_BAR; PG8_WAIT_L(0); PG8_MMA(1, 0, At, B0); PG8_BAR; PG8_SCHED;
            PG8_STAGE(PG8_SB(0, 1), b2 + hstep, voffB);
            PG8_WAIT_V(6); PG8_BAR; PG8_MMA(1, 1, At, B1); PG8_BAR;
            PG8_LDB(B0, 1, 0); PG8_SCHED; PG8_LDA(At, 1, 0); PG8_STAGE(PG8_SA(0, 1), a2 + hstep, voffA);
            PG8_WAIT_L(8); PG8_BAR; PG8_WAIT_L(0); PG8_MMA(0, 0, At, B0); PG8_BAR; PG8_SCHED;
            PG8_LDB(B1, 1, 1); PG8_STAGE(PG8_SB(1, 0), b3, voffB);
            PG8_BAR; PG8_WAIT_L(0); PG8_MMA(0, 1, At, B1); PG8_BAR;
            PG8_LDA(At, 1, 1); PG8_STAGE(PG8_SA(1, 0), a3, voffA);
            PG8_BAR; PG8_WAIT_L(0); PG8_MMA(1, 0, At, B0); PG8_BAR; PG8_SCHED;
            PG8_STAGE(PG8_SB(1, 1), b3 + hstep, voffB);
            PG8_WAIT_V(6); PG8_BAR; PG8_MMA(1, 1, At, B1); PG8_BAR;
            }
        }
        if constexpr (ALIGN_EPI) { if (wr == 0) PG8_BAR; }
        if constexpr (!Epi::AFTER_DRAIN) { E(acc, cur, wr, wc, fr, fq); S.done(cur); }
        if (!has_next) break;
#pragma unroll
        for (int a = 0; a < 2; ++a)
#pragma unroll
            for (int b = 0; b < 2; ++b)
#pragma unroll
                for (int m = 0; m < 4; ++m)
#pragma unroll
                    for (int n = 0; n < 2; ++n) acc[a][b][m][n] = (f32x4){0.f, 0.f, 0.f, 0.f};
        cur = nxt; cA = nA; cB = nB; ++ui;
        if constexpr (ALIGN_EPI) { if (wr == 1) PG8_BAR; }
    }
    PG8_WAIT_V(0);
    if constexpr (!ALIGN_EPI) { if (wr == 0) PG8_BAR; }
    PG8_BAR;
    if constexpr (Epi::AFTER_DRAIN) { E.fused(acc, cur, wr, wc, fr, fq, lds, wid, lane); S.done(cur); }
#undef PG8_SA
#undef PG8_SB
#undef PG8_STAGE
#undef PG8_LDA
#undef PG8_LDB
#undef PG8_MMA
#undef PG8_WAIT_V
#undef PG8_WAIT_L
#undef PG8_BAR
#undef PG8_SCHED
}
}

template <class Fn> struct EpiFn {
    static constexpr bool PERM = false, AFTER_DRAIN = false;
    Fn f;
    __device__ __forceinline__ void operator()(const f32x4 (&acc)[2][2][4][2], const pg8::Unit& u, int wr, int wc, int fr, int fq) const {
#pragma unroll
        for (int ai = 0; ai < 2; ++ai)
#pragma unroll
            for (int m = 0; m < 4; ++m) { const int row = u.pm * 256 + ai * 128 + wr * 64 + m * 16 + fr;
#pragma unroll
                for (int bj = 0; bj < 2; ++bj) f(row, u.pn * 256 + bj * 128 + wc * 32 + 4 * fq, acc[ai][bj][m][0], acc[ai][bj][m][1]); }
    }
};
template <class Fn> __device__ __forceinline__ void run_gemm(const Frame& F, const act_t* A, const act_t* Bt, int M, int N, int K, Fn fn) {
    const pg8::Gemm g{A, Bt, M, N, K}; pg8::StaticOrder S; S.init(M, N, F.G, F.bid);
    const EpiFn<Fn> E{fn};
    pg8::gemm_phase<EpiFn<Fn>, pg8::StaticOrder, true, true>((PG8_LAS unsigned char*)F.lds, g, S, E);
}
__device__ __forceinline__ float fsig(float x) { return __builtin_amdgcn_rcpf(1.0f + __builtin_amdgcn_exp2f(-LOG2E * x)); }
#else
__device__ __forceinline__ float fsig(float x) { return 1.0f / (1.0f + expf(-x)); }
#endif

__device__ __forceinline__ void p0_adaln_item(const Frame& F, int item) {
    float* sc = (float*)F.lds;
    float* part = sc + 9 * 1024;
    __syncthreads();
    for (int e = F.tid; e < 9 * 1024; e += 512) { const int r = e >> 10, kk = e & 1023; const float v = (r < 8) ? F.c[r * DM + kk] : F.c_ctx[kk]; sc[e] = v / (1.0f + expf(-v)); }
    __syncthreads();
    const int col = item * 64 + F.lane, kg = F.wid;
    float a[9];
#pragma unroll
    for (int r = 0; r < 9; ++r) a[r] = 0.f;
    for (int kk = kg * 128; kk < kg * 128 + 128; ++kk) {
        const float w = F.w_ada[(size_t)kk * 6144 + col];
#pragma unroll
        for (int r = 0; r < 9; ++r) a[r] += sc[r * 1024 + kk] * w;
    }
#pragma unroll
    for (int r = 0; r < 9; ++r) part[(kg * 9 + r) * 64 + F.lane] = a[r];
    __syncthreads();
    for (int e = F.tid; e < 9 * 64; e += 512) { const int r = e >> 6, cl = e & 63; float s = F.b_ada[item * 64 + cl];
#pragma unroll
        for (int g = 0; g < 8; ++g) s += part[(g * 9 + r) * 64 + cl];
        F.mod[r * 6144 + item * 64 + cl] = s; }
}
template <class CM> __device__ __forceinline__ void p0_transpose_item(const Frame& F, const float* W, int K, int Nsrc, act_t* dst, int item, int ntn, CM cmap) {
    float* tl = (float*)F.lds;
    const int kb = item / ntn, nb = item % ntn, k0 = kb * 64, n0 = nb * 64;
    __syncthreads();
    { const int j = F.tid & 63, i0 = F.tid >> 6; const int sc = cmap(n0 + j);
#pragma unroll
      for (int i = 0; i < 8; ++i) { const int kk = i0 + 8 * i; tl[kk * 65 + j] = W[(size_t)(k0 + kk) * Nsrc + sc]; } }
    __syncthreads();
    { const int kk = F.tid & 63, nn0 = F.tid >> 6;
#pragma unroll
      for (int i = 0; i < 8; ++i) { const int n = nn0 + 8 * i; st_act(dst + (size_t)(n0 + n) * K + k0 + kk, tl[kk * 65 + n]); } }
}
__device__ __forceinline__ int cmap_in(int n) {
    if (n < 1536 || n >= 2560) return n;
    const int g = (n - 1536) >> 5, e = n & 31;
    return (e < 16) ? (1536 + 16 * g + e) : (2048 + 16 * g + (e - 16));
}
__device__ __forceinline__ void p0_prep(const Frame& F) {
    for (int it = F.bid; it < 96; it += F.G) p0_adaln_item(F, it);
    constexpr int I_IN = 16 * 72, I_OA = 16 * 16, I_OC = 8 * 16, I_OUT = 16 * 16, I_WQ = 16 * 32;
    constexpr int NIT = I_IN + I_OA + I_OC + I_OUT + I_WQ;
    auto ident = [](int n) { return n; };
    for (int it = F.bid; it < NIT; it += F.G) {
        int r = it;
        if (r < I_IN) { p0_transpose_item(F, F.w_in, 1024, INW, F.win_t, r, 72, [](int n) { return cmap_in(n); }); continue; } r -= I_IN;
        if (r < I_OA) { p0_transpose_item(F, F.w_o_attn, 1024, 1024, F.woa_t, r, 16, ident); continue; } r -= I_OA;
        if (r < I_OC) { p0_transpose_item(F, F.w_o_conv, 512, 1024, F.woc_t, r, 16, ident); continue; } r -= I_OC;
        if (r < I_OUT) { p0_transpose_item(F, F.w_out, 1024, 1024, F.wout_t, r, 16, ident); continue; } r -= I_OUT;
        p0_transpose_item(F, F.peer_wq, 1024, PQW, F.wq_t, r, 32, ident);
    }
    for (int e = F.bid * 512 + F.tid; e < 16 * 128 * 128; e += F.G * 512) st_act(F.keys_t + e, F.peer_keys[e]);
    for (int e = F.bid * 512 + F.tid; e < 64 * 16; e += F.G * 512) {
        const int pos = e >> 4, f = e & 15;
        const float freq = powf(10000.0f, -(float)(2 * f) / 32.0f);
        const float ang = (float)pos * freq;
        const double TWO_PI = 6.283185307179586476925286766559;
        double r = (double)ang; r -= TWO_PI * rint(r / TWO_PI);
        const double r2 = r * r;
        double sn = 0.0, cs = 0.0;
        double ts = r, tc = 1.0;
#pragma unroll 1
        for (int n = 0; n < 14; ++n) { sn += ts; cs += tc; ts *= -r2 / (double)((2 * n + 2) * (2 * n + 3)); tc *= -r2 / (double)((2 * n + 1) * (2 * n + 2)); }
        F.rope[e * 2] = (float)cs; F.rope[e * 2 + 1] = (float)sn;
    }
}

__device__ __forceinline__ void p1_norm(const Frame& F) {
    const int gw = F.bid * 8 + F.wid, NGW = F.G * 8;
    for (int r = gw; r < T_ + CT_; r += NGW) {
        const bool isx = r < T_;
        const int rr = isx ? r : r - T_;
        const float* src = isx ? F.x + ((size_t)F.b0 * SEQ + rr) * DM : F.ctx + ((size_t)F.b0 * CTXL + rr) * DM;
        act_t* dst = isx ? F.hx + (size_t)rr * DM : F.hc + (size_t)rr * DM;
        const float* mrow = isx ? F.mod + (size_t)(F.b0 + rr / SEQ) * 6144 : F.mod + (size_t)8 * 6144;
        f32x4 v[4]; float ss = 0.f;
#pragma unroll
        for (int j = 0; j < 4; ++j) { v[j] = *(const f32x4*)(src + j * 256 + F.lane * 4); ss += v[j][0] * v[j][0] + v[j][1] * v[j][1] + v[j][2] * v[j][2] + v[j][3] * v[j][3]; }
        ss = wave_sum(ss);
        const float rstd = 1.0f / sqrtf(ss * (1.0f / DM) + EPS);
#pragma unroll
        for (int j = 0; j < 4; ++j) { const int d = j * 256 + F.lane * 4;
            const f32x4 g = *(const f32x4*)(F.g_pre_mix + d), sh = *(const f32x4*)(mrow + d), sc = *(const f32x4*)(mrow + 1024 + d);
            f32x4 o;
#pragma unroll
            for (int i = 0; i < 4; ++i) o[i] = (v[j][i] * rstd) * g[i] * (1.0f + sc[i]) + sh[i];
            st4(dst + d, o); }
    }
}

__device__ __forceinline__ void epi_in(const Frame& F, int r, int c, f32x4 v0, f32x4 v1) {
    const int s = r & (SEQ - 1);
    if (c < 1280) {
        const int axis = (c >> 5) & 1, pos = axis ? (s & 63) : (s >> 6);
        const float* rp = F.rope + (pos * 16 + (c & 15)) * 2;
        const f32x4 cs0 = *(const f32x4*)rp, cs1 = *(const f32x4*)(rp + 4);
        f32x4 o1, o2;
        o1[0] = v0[0] * cs0[0] - v1[0] * cs0[1]; o2[0] = v1[0] * cs0[0] + v0[0] * cs0[1];
        o1[1] = v0[1] * cs0[2] - v1[1] * cs0[3]; o2[1] = v1[1] * cs0[2] + v0[1] * cs0[3];
        o1[2] = v0[2] * cs1[0] - v1[2] * cs1[1]; o2[2] = v1[2] * cs1[0] + v0[2] * cs1[1];
        o1[3] = v0[3] * cs1[2] - v1[3] * cs1[3]; o2[3] = v1[3] * cs1[2] + v0[3] * cs1[3];
        if (c < 1024) { o1 *= QS; o2 *= QS; st4(F.q + (size_t)r * 1024 + c, o1); st4(F.q + (size_t)r * 1024 + c + 16, o2); }
        else { st4(F.k + (size_t)r * 256 + (c - 1024), o1); st4(F.k + (size_t)r * 256 + (c - 1024) + 16, o2); }
    } else if (c < 1536) {
        const int cc = c - 1280, hk = cc >> 6, d = cc & 63, bl = r / SEQ;
        act_t* base = F.vT + ((size_t)(bl * 4 + hk) * 64 + d) * SEQ + s;
#pragma unroll
        for (int i = 0; i < 4; ++i) { st_act(base + (size_t)i * SEQ, v0[i]); st_act(base + (size_t)(16 + i) * SEQ, v1[i]); }
    } else if (c < 2560) {
        const int ch = ((c - 1536) >> 5) * 16 + (c & 15);
        f32x4 o;
#pragma unroll
        for (int i = 0; i < 4; ++i) o[i] = v0[i] * fsig(v1[i]);
        st4(F.u + (size_t)r * 512 + ch, o);
    } else {
        const int g = c - 2560; f32x4 o0, o1;
#pragma unroll
        for (int i = 0; i < 4; ++i) { o0[i] = fsig(v0[i]); o1[i] = fsig(v1[i]); }
        st4(F.sg + (size_t)r * 2048 + g, o0); st4(F.sg + (size_t)r * 2048 + g + 16, o1);
    }
}
__device__ __forceinline__ void epi_ctx(const Frame& F, int r, int c, f32x4 v0, f32x4 v1) {
    if (c < 256) { st4(F.kc + (size_t)r * 256 + c, v0); st4(F.kc + (size_t)r * 256 + c + 16, v1); }
    else { const int cc = c - 256, hk = cc >> 6, d = cc & 63, bl = r / CTXL, sx = r % CTXL;
        act_t* base = F.vTc + ((size_t)(bl * 4 + hk) * 64 + d) * CTXL + sx;
#pragma unroll
        for (int i = 0; i < 4; ++i) { st_act(base + (size_t)i * CTXL, v0[i]); st_act(base + (size_t)(16 + i) * CTXL, v1[i]); } }
}
#if GOLD
__device__ __forceinline__ void p2_inproj(const Frame& F) {
    constexpr int nM = T_ / 128, nN = INW / 128, nMc = CT_ / 128, nNc = 4;
    const int ntile = nM * nN + nMc * nNc;
    for (int t = F.bid; t < ntile; t += F.G) {
        f32x4 acc[2][4]; acc_zero(acc);
        if (t < nM * nN) {
            const int pm = t / nN, pn = t % nN;
            mma_tile(acc, F.lds, F.hx, DM, F.win_t, DM, DM, pm * 128, pn * 128);
            epi_foreach(acc, pm * 128, pn * 128, [&](int r, int c, f32x4 v0, f32x4 v1) { epi_in(F, r, c, v0, v1); });
        } else {
            const int tt = t - nM * nN, pm = tt / nNc, pn = tt % nNc;
            mma_tile(acc, F.lds, F.hc, DM, F.win_t + (size_t)1024 * DM, DM, DM, pm * 128, pn * 128);
            epi_foreach(acc, pm * 128, pn * 128, [&](int r, int c, f32x4 v0, f32x4 v1) { epi_ctx(F, r, c, v0, v1); });
        }
    }
}
#else
__device__ __forceinline__ void p2_inproj(const Frame& F) {
    run_gemm(F, F.hx, F.win_t, T_, INW, DM, [&](int r, int c, f32x4 v0, f32x4 v1) { epi_in(F, r, c, v0, v1); });
    run_gemm(F, F.hc, F.win_t + (size_t)1024 * DM, CT_, 512, DM, [&](int r, int c, f32x4 v0, f32x4 v1) { epi_ctx(F, r, c, v0, v1); });
}
#endif

#if GOLD
__device__ __forceinline__ void p3_attn(const Frame& F) {
    float* qs = (float*)F.lds + F.wid * 64;
    float* ps = (float*)F.lds + 512 + F.wid * 640;
    const int gw = F.bid * 8 + F.wid, NGW = F.G * 8;
    for (int it = gw; it < T_ * NH; it += NGW) {
        const int r = it / NH, head = it % NH, hk = head >> 2, bl = r / SEQ, s = r % SEQ;
        qs[F.lane] = F.q[(size_t)r * 1024 + head * 64 + F.lane];
        const int lo = (s - 128 < 0) ? 0 : s - 128, hi = (s + 128 > SEQ - 1) ? SEQ - 1 : s + 128, nwin = hi - lo + 1, ntot = nwin + CTXL;
        float mx = -1e30f;
        for (int jj = F.lane; jj < ntot; jj += 64) {
            const float* kr = (jj < nwin) ? F.k + ((size_t)(bl * SEQ + lo + jj)) * 256 + hk * 64 : F.kc + ((size_t)(bl * CTXL + jj - nwin)) * 256 + hk * 64;
            float d = 0.f;
            for (int e = 0; e < 64; e += 4) { const f32x4 kv = *(const f32x4*)(kr + e); d += qs[e] * kv[0] + qs[e + 1] * kv[1] + qs[e + 2] * kv[2] + qs[e + 3] * kv[3]; }
            ps[jj] = d; mx = fmaxf(mx, d);
        }
        mx = wave_max(mx);
        float l = 0.f;
        for (int jj = F.lane; jj < ntot; jj += 64) { const float p = exp2f(ps[jj] - mx); ps[jj] = p; l += p; }
        l = wave_sum(l) + exp2f(F.sink[head] * LOG2E - mx);
        const float* vr = F.vT + ((size_t)(bl * 4 + hk) * 64 + F.lane) * SEQ + lo;
        const float* vc = F.vTc + ((size_t)(bl * 4 + hk) * 64 + F.lane) * CTXL;
        float o = 0.f;
        for (int jj = 0; jj < nwin; ++jj) o += ps[jj] * vr[jj];
        for (int jj = 0; jj < CTXL; ++jj) o += ps[nwin + jj] * vc[jj];
        F.att[(size_t)r * 1024 + head * 64 + F.lane] = o / l;
    }
}
#else
__device__ __forceinline__ void p3_attn(const Frame& F) {
    constexpr int KLD = 72;
    bf16_t* Kt = (bf16_t*)F.lds;
    bf16_t* Vt = (bf16_t*)(F.lds + 64 * KLD * 2);
    const int lane = F.lane, l31 = lane & 31, hi = lane >> 5;
    const int g = F.wid >> 1, half = F.wid & 1;
    constexpr int NUNIT = CH_B * NKV * (SEQ / 128);
    for (int un = F.bid; un < NUNIT; un += F.G) {
        const int nb = un & 15, hk = (un >> 4) & 3, bl = un >> 6;
        const int head = hk * 4 + g;
        const int r0 = bl * SEQ + nb * 128 + half * 64;
        bf16x8 qf[2][4];
#pragma unroll
        for (int qt = 0; qt < 2; ++qt)
#pragma unroll
            for (int s = 0; s < 4; ++s) qf[qt][s] = *(const bf16x8*)(F.q + (size_t)(r0 + qt * 32 + l31) * 1024 + head * 64 + s * 16 + 8 * hi);
        float mrun[2] = {-1e30f, -1e30f}, lrun[2] = {0.f, 0.f};
        f32x16 O[2][2];
#pragma unroll
        for (int a = 0; a < 2; ++a)
#pragma unroll
            for (int b = 0; b < 2; ++b)
#pragma unroll
                for (int r = 0; r < 16; ++r) O[a][b][r] = 0.f;
        for (int tile = 0; tile < 10; ++tile) {
            const bool isctx = tile < 4;
            const int ks = isctx ? tile * 64 : nb * 128 - 128 + 64 * (tile - 4);
            if (!isctx && (ks < 0 || ks >= SEQ)) continue;
            __syncthreads();
            { const int row = F.tid >> 3, ch = F.tid & 7;
              const act_t* ksrc = isctx ? F.kc + ((size_t)(bl * CTXL + ks + row)) * 256 + hk * 64 + ch * 8
                                        : F.k + ((size_t)(bl * SEQ + ks + row)) * 256 + hk * 64 + ch * 8;
              const act_t* vsrc = isctx ? F.vTc + ((size_t)(bl * 4 + hk) * 64 + row) * CTXL + ks + ch * 8
                                        : F.vT + ((size_t)(bl * 4 + hk) * 64 + row) * SEQ + ks + ch * 8;
              *(u32x4*)(Kt + row * KLD + ch * 8) = *(const u32x4*)ksrc;
              *(u32x4*)(Vt + row * KLD + ch * 8) = *(const u32x4*)vsrc; }
            __syncthreads();
            const int j = tile - 4;
            const bool need = isctx || (half == 0 ? (j <= 4) : (j >= 1));
            if (need) {
                f32x16 st[2][2];
#pragma unroll
                for (int a = 0; a < 2; ++a)
#pragma unroll
                    for (int b = 0; b < 2; ++b)
#pragma unroll
                        for (int r = 0; r < 16; ++r) st[a][b][r] = 0.f;
#pragma unroll
                for (int s = 0; s < 4; ++s)
#pragma unroll
                    for (int kt = 0; kt < 2; ++kt) {
                        const bf16x8 a = *(const bf16x8*)(Kt + (kt * 32 + l31) * KLD + s * 16 + 8 * hi);
#pragma unroll
                        for (int qt = 0; qt < 2; ++qt) st[kt][qt] = __builtin_amdgcn_mfma_f32_32x32x16_bf16(a, qf[qt][s], st[kt][qt], 0, 0, 0);
                    }
                if (!isctx) {
#pragma unroll
                    for (int kt = 0; kt < 2; ++kt)
#pragma unroll
                        for (int qt = 0; qt < 2; ++qt) {
                            const int qp = nb * 128 + half * 64 + qt * 32 + l31;
#pragma unroll
                            for (int r = 0; r < 16; ++r) { const int kp = ks + kt * 32 + crow(r, hi); const int dd = qp - kp; if (dd > 128 || dd < -128) st[kt][qt][r] = -1e30f; }
                        }
                }
                bf16x8 pf[2][2][2];
#pragma unroll
                for (int qt = 0; qt < 2; ++qt) {
                    float mx = -1e30f;
#pragma unroll
                    for (int kt = 0; kt < 2; ++kt)
#pragma unroll
                        for (int r = 0; r < 16; ++r) mx = fmaxf(mx, st[kt][qt][r]);
                    mx = fmaxf(mx, __shfl_xor(mx, 32));
                    const float mn = fmaxf(mrun[qt], mx);
                    const float alpha = __builtin_amdgcn_exp2f(mrun[qt] - mn);
                    mrun[qt] = mn; lrun[qt] *= alpha;
#pragma unroll
                    for (int dt = 0; dt < 2; ++dt)
#pragma unroll
                        for (int r = 0; r < 16; ++r) O[dt][qt][r] *= alpha;
                    float ls = 0.f;
#pragma unroll
                    for (int kt = 0; kt < 2; ++kt) {
                        float p[16];
#pragma unroll
                        for (int r = 0; r < 16; ++r) { p[r] = __builtin_amdgcn_exp2f(st[kt][qt][r] - mn); ls += p[r]; }
#pragma unroll
                        for (int s2 = 0; s2 < 2; ++s2) {
                            u32x4 w;
                            w[0] = pk2(p[8 * s2 + 0], p[8 * s2 + 1]); w[1] = pk2(p[8 * s2 + 2], p[8 * s2 + 3]);
                            w[2] = pk2(p[8 * s2 + 4], p[8 * s2 + 5]); w[3] = pk2(p[8 * s2 + 6], p[8 * s2 + 7]);
                            pf[kt][s2][qt] = __builtin_bit_cast(bf16x8, w);
                        }
                    }
                    lrun[qt] += ls;
                }
#pragma unroll
                for (int kt = 0; kt < 2; ++kt)
#pragma unroll
                    for (int s2 = 0; s2 < 2; ++s2)
#pragma unroll
                        for (int dt = 0; dt < 2; ++dt) {
                            const bf16_t* vp = Vt + (dt * 32 + l31) * KLD + kt * 32 + s2 * 16 + 4 * hi;
                            const s16x4 lo = *(const s16x4*)vp, hh = *(const s16x4*)(vp + 8);
                            const bf16x8 a = (bf16x8){lo[0], lo[1], lo[2], lo[3], hh[0], hh[1], hh[2], hh[3]};
#pragma unroll
                            for (int qt = 0; qt < 2; ++qt) O[dt][qt] = __builtin_amdgcn_mfma_f32_32x32x16_bf16(a, pf[kt][s2][qt], O[dt][qt], 0, 0, 0);
                        }
            }
        }
        const float sk = F.sink[head] * LOG2E;
#pragma unroll
        for (int qt = 0; qt < 2; ++qt) {
            float lt = lrun[qt] + __shfl_xor(lrun[qt], 32);
            lt += __builtin_amdgcn_exp2f(sk - mrun[qt]);
            const float inv = 1.0f / lt;
            act_t* orow = F.att + (size_t)(r0 + qt * 32 + l31) * 1024 + head * 64;
#pragma unroll
            for (int dt = 0; dt < 2; ++dt)
#pragma unroll
                for (int g4 = 0; g4 < 4; ++g4) {
                    f32x4 o; o[0] = O[dt][qt][4 * g4] * inv; o[1] = O[dt][qt][4 * g4 + 1] * inv; o[2] = O[dt][qt][4 * g4 + 2] * inv; o[3] = O[dt][qt][4 * g4 + 3] * inv;
                    st4(orow + dt * 32 + 8 * g4 + 4 * hi, o);
                }
        }
    }
}
#endif

#if GOLD
constexpr int CTK = 32;
#else
constexpr int CTK = 64;
#endif
__device__ __forceinline__ void p3_conv(const Frame& F) {
    act_t* ub = (act_t*)F.lds;
    float* yb = (float*)(F.lds + (size_t)(CTK + 30) * 512 * AS);
    static_assert((CTK + 30) * 512 * AS + 8 * 512 * 4 <= LDS_MISC, "conv LDS");
    const int c = F.tid;
    float w[CONV_W];
#pragma unroll
    for (int i = 0; i < CONV_W; ++i) w[i] = F.conv_dw[i * CONV_CH + c];
    const float bias = F.conv_dw_b[c];
    constexpr int NT = T_ / CTK;
    for (int t = F.bid; t < NT; t += F.G) {
        const int r0 = t * CTK, bl = r0 / SEQ, s0 = r0 % SEQ;
        __syncthreads();
        constexpr int CPRW = 512 * AS / 16;
        for (int e = F.tid; e < (CTK + 30) * CPRW; e += 512) {
            const int rr = e / CPRW, ch = e % CPRW, sp = s0 + rr - 15;
            u32x4 v = (u32x4){0u, 0u, 0u, 0u};
            if (sp >= 0 && sp < SEQ) v = *(const u32x4*)((const unsigned char*)(F.u + (size_t)(bl * SEQ + sp) * 512) + ch * 16);
            *(u32x4*)((unsigned char*)ub + (size_t)rr * 512 * AS + ch * 16) = v;
        }
        __syncthreads();
        for (int chunk = 0; chunk < CTK / 8; ++chunk) {
#pragma unroll 1
            for (int tt = 0; tt < 8; ++tt) {
                const int tk = chunk * 8 + tt;
                float a = 0.f;
#pragma unroll
                for (int i = 0; i < CONV_W; ++i) a += ld_act(ub + (size_t)(tk + i) * 512 + c) * w[i];
                yb[tt * 512 + c] = a + bias;
            }
            __syncthreads();
            {
                const int tk = chunk * 8 + F.wid;
                float y[8];
                const f32x4 y0 = *(const f32x4*)(yb + F.wid * 512 + F.lane * 8), y1 = *(const f32x4*)(yb + F.wid * 512 + F.lane * 8 + 4);
                y[0] = y0[0]; y[1] = y0[1]; y[2] = y0[2]; y[3] = y0[3]; y[4] = y1[0]; y[5] = y1[1]; y[6] = y1[2]; y[7] = y1[3];
                float s = 0.f;
#pragma unroll
                for (int i = 0; i < 8; ++i) s += y[i];
                const float mean = wave_sum(s) * (1.0f / CONV_CH);
                float q = 0.f;
#pragma unroll
                for (int i = 0; i < 8; ++i) { y[i] -= mean; q += y[i] * y[i]; }
                const float rstd = 1.0f / sqrtf(wave_sum(q) * (1.0f / CONV_CH) + EPS);
                f32x4 o0, o1;
#pragma unroll
                for (int i = 0; i < 8; ++i) { const int ch = F.lane * 8 + i; const float z = y[i] * rstd * F.conv_ln_g[ch] + F.conv_ln_b[ch]; const float o = z * fsig(z); if (i < 4) o0[i] = o; else o1[i - 4] = o; }
                act_t* dst = F.cact + (size_t)(r0 + tk) * 512 + F.lane * 8;
                st4(dst, o0); st4(dst + 4, o1);
            }
            __syncthreads();
        }
    }
}

#if GOLD
__device__ __forceinline__ void p4_merge(const Frame& F) {
    constexpr int nM = T_ / 128, nN = 8;
    for (int t = F.bid; t < nM * nN; t += F.G) {
        const int pm = t / nN, pn = t % nN;
        f32x4 accA[2][4], accC[2][4]; acc_zero(accA); acc_zero(accC);
        mma_tile(accA, F.lds, F.att, 1024, F.woa_t, 1024, 1024, pm * 128, pn * 128);
        mma_tile(accC, F.lds, F.cact, 512, F.woc_t, 512, 512, pm * 128, pn * 128);
        const int lane = F.lane, wm = F.wid >> 1, wn = F.wid & 1, fr = lane & 15, fq = lane >> 4;
#pragma unroll
        for (int mi = 0; mi < 2; ++mi)
#pragma unroll
            for (int ni = 0; ni < 4; ++ni) {
                const int r = pm * 128 + wm * 32 + mi * 16 + fr, c = pn * 128 + wn * 64 + ni * 16 + 4 * fq;
                const f32x4 ga = ld4(F.sg + (size_t)r * 2048 + c), gc = ld4(F.sg + (size_t)r * 2048 + 1024 + c);
                st4(F.m + (size_t)r * 1024 + c, ga * accA[mi][ni] + gc * accC[mi][ni]);
            }
    }
}
__device__ __forceinline__ void p5_out(const Frame& F) {
    constexpr int nM = T_ / 128, nN = 8;
    for (int t = F.bid; t < nM * nN; t += F.G) {
        const int pm = t / nN, pn = t % nN;
        f32x4 acc[2][4]; acc_zero(acc);
        mma_tile(acc, F.lds, F.m, 1024, F.wout_t, 1024, 1024, pm * 128, pn * 128);
        const int lane = F.lane, wm = F.wid >> 1, wn = F.wid & 1, fr = lane & 15, fq = lane >> 4;
#pragma unroll
        for (int mi = 0; mi < 2; ++mi)
#pragma unroll
            for (int ni = 0; ni < 4; ++ni) {
                const int r = pm * 128 + wm * 32 + mi * 16 + fr, c = pn * 128 + wn * 64 + ni * 16 + 4 * fq;
                *(f32x4*)(F.mixed + (size_t)r * 1024 + c) = acc[mi][ni];
            }
    }
}
#else
__device__ __forceinline__ void p4_merge(const Frame& F) {
    run_gemm(F, F.att, F.woa_t, T_, 1024, 1024, [&](int r, int c, f32x4 v0, f32x4 v1) {
        const act_t* gp = F.sg + (size_t)r * 2048 + c; act_t* mp = F.m + (size_t)r * 1024 + c;
        st4(mp, ld4(gp) * v0); st4(mp + 16, ld4(gp + 16) * v1); });
    run_gemm(F, F.cact, F.woc_t, T_, 1024, 512, [&](int r, int c, f32x4 v0, f32x4 v1) {
        const act_t* gp = F.sg + (size_t)r * 2048 + 1024 + c; act_t* mp = F.m + (size_t)r * 1024 + c;
        st4(mp, ld4(mp) + ld4(gp) * v0); st4(mp + 16, ld4(mp + 16) + ld4(gp + 16) * v1); });
}
__device__ __forceinline__ void p5_out(const Frame& F) {
    run_gemm(F, F.m, F.wout_t, T_, 1024, 1024, [&](int r, int c, f32x4 v0, f32x4 v1) {
        float* p = F.mixed + (size_t)r * 1024 + c; *(f32x4*)p = v0; *(f32x4*)(p + 16) = v1; });
}
#endif
__device__ __forceinline__ void p6_rows(const Frame& F) {
    const int gw = F.bid * 8 + F.wid, NGW = F.G * 8;
    for (int r = gw; r < T_; r += NGW) {
        const float* mrow = F.mod + (size_t)(F.b0 + r / SEQ) * 6144;
        const float* xr = F.x + ((size_t)F.b0 * SEQ + r) * DM;
        float* outr = F.out + ((size_t)F.b0 * SEQ + r) * DM;
        f32x4 mv[4], x1[4]; float ss = 0.f;
#pragma unroll
        for (int j = 0; j < 4; ++j) { mv[j] = *(const f32x4*)(F.mixed + (size_t)r * 1024 + j * 256 + F.lane * 4); ss += mv[j][0] * mv[j][0] + mv[j][1] * mv[j][1] + mv[j][2] * mv[j][2] + mv[j][3] * mv[j][3]; }
        const float rstd = 1.0f / sqrtf(wave_sum(ss) * (1.0f / DM) + EPS);
        float s1 = 0.f;
#pragma unroll
        for (int j = 0; j < 4; ++j) { const int d = j * 256 + F.lane * 4;
            const f32x4 xv = *(const f32x4*)(xr + d), g = *(const f32x4*)(F.g_post_mix + d), gt = *(const f32x4*)(mrow + 2048 + d);
#pragma unroll
            for (int i = 0; i < 4; ++i) { x1[j][i] = xv[i] + gt[i] * ((mv[j][i] * rstd) * g[i]); s1 += x1[j][i] * x1[j][i]; }
            *(f32x4*)(outr + d) = x1[j]; }
        const float rstd1 = 1.0f / sqrtf(wave_sum(s1) * (1.0f / DM) + EPS);
#pragma unroll
        for (int j = 0; j < 4; ++j) { const int d = j * 256 + F.lane * 4;
            const f32x4 g = *(const f32x4*)(F.g_pre_ffn + d), sh = *(const f32x4*)(mrow + 3072 + d), sc = *(const f32x4*)(mrow + 4096 + d);
            f32x4 o;
#pragma unroll
            for (int i = 0; i < 4; ++i) o[i] = (x1[j][i] * rstd1) * g[i] * (1.0f + sc[i]) + sh[i];
            st4(F.h2 + (size_t)r * 1024 + d, o); }
    }
}
__device__ __forceinline__ void p7_wq(const Frame& F) {
#if GOLD
    constexpr int nM = T_ / 128, nN = PQW / 128;
    for (int t = F.bid; t < nM * nN; t += F.G) {
        const int pm = t / nN, pn = t % nN;
        f32x4 acc[2][4]; acc_zero(acc);
        mma_tile(acc, F.lds, F.h2, 1024, F.wq_t, 1024, 1024, pm * 128, pn * 128);
        const int lane = F.lane, wm = F.wid >> 1, wn = F.wid & 1, fr = lane & 15, fq = lane >> 4;
#pragma unroll
        for (int mi = 0; mi < 2; ++mi)
#pragma unroll
            for (int ni = 0; ni < 4; ++ni) {
                const int r = pm * 128 + wm * 32 + mi * 16 + fr, c = pn * 128 + wn * 64 + ni * 16 + 4 * fq;
                st4(F.pq + (size_t)r * PQW + c, acc[mi][ni]);
            }
    }
#else
    run_gemm(F, F.h2, F.wq_t, T_, PQW, 1024, [&](int r, int c, f32x4 v0, f32x4 v1) {
        act_t* p = F.pq + (size_t)r * PQW + c; st4(p, v0); st4(p + 16, v1); });
#endif
#if !GOLD
    for (size_t e = (size_t)F.bid * 512 + F.tid; e < (size_t)NEXP * 1024 / 16; e += (size_t)F.G * 512) {
        u32x4 wa, wb;
#pragma unroll
        for (int j = 0; j < 4; ++j) { const f32x4 a = *(const f32x4*)(F.peer_u + e * 16 + 4 * j), b = *(const f32x4*)(F.peer_v + e * 16 + 4 * j);
            int pa = 0, pb = 0;
            pa = __builtin_amdgcn_cvt_pk_fp8_f32(a[0] * 256.0f, a[1] * 256.0f, pa, false); pa = __builtin_amdgcn_cvt_pk_fp8_f32(a[2] * 256.0f, a[3] * 256.0f, pa, true);
            pb = __builtin_amdgcn_cvt_pk_fp8_f32(b[0] * 256.0f, b[1] * 256.0f, pb, false); pb = __builtin_amdgcn_cvt_pk_fp8_f32(b[2] * 256.0f, b[3] * 256.0f, pb, true);
            wa[j] = (unsigned)pa; wb[j] = (unsigned)pb; }
        *(u32x4*)(F.pu8 + e * 16) = wa; *(u32x4*)(F.pv8 + e * 16) = wb;
    }
#endif
}
__device__ __forceinline__ int f2sort(float f) { const int b = __float_as_int(f); return b ^ ((b >> 31) & 0x7fffffff); }
__device__ __forceinline__ float sort2f(int k) { return __int_as_float(k ^ ((k >> 31) & 0x7fffffff)); }
__device__ __forceinline__ void p8_partial(const Frame& F, int (&L)[16], int t, int hp, int l31, int hi) {
#pragma unroll
    for (int i = 0; i < 16; ++i) L[i] = (int)0x80000000;
    const act_t* qrow = F.pq + (size_t)t * PQW + hp * 128;
#pragma unroll 1
    for (int kt = 0; kt < 4; ++kt) {
        const act_t* krow = F.keys_t + ((size_t)hp * 128 + kt * 32 + l31) * 128;
        f32x16 sc;
#pragma unroll
        for (int r = 0; r < 16; ++r) sc[r] = 0.f;
#if GOLD
        for (int s = 0; s < 64; ++s) sc = __builtin_amdgcn_mfma_f32_32x32x2f32(krow[2 * s + hi], qrow[2 * s + hi], sc, 0, 0, 0);
#else
#pragma unroll
        for (int s = 0; s < 8; ++s) { const bf16x8 a = *(const bf16x8*)(krow + 16 * s + 8 * hi), b = *(const bf16x8*)(qrow + 16 * s + 8 * hi);
            sc = __builtin_amdgcn_mfma_f32_32x32x16_bf16(a, b, sc, 0, 0, 0); }
#endif
#pragma unroll
        for (int r = 0; r < 16; ++r) {
            int v = (f2sort(sc[r]) & ~127) | (127 - (kt * 32 + crow(r, hi)));
#pragma unroll
            for (int i = 0; i < 16; ++i) { const int h_ = max(L[i], v); v = min(L[i], v); L[i] = h_; }
        }
    }
}
__device__ __forceinline__ void p8_topk(const Frame& F) {
    const int gw = F.bid * 8 + F.wid, NGW = F.G * 8, lane = F.lane, l31 = lane & 31, hi = lane >> 5;
    for (int task = gw; task < (T_ / 32) * 4; task += NGW) {
        const int tb = task >> 2, h0 = (task & 3) * 2, t = tb * 32 + l31;
        int a[16], b[16];
        {
            int P0[16], P1[16];
            p8_partial(F, P0, t, 2 * h0, l31, hi); p8_partial(F, P1, t, 2 * h0 + 2, l31, hi);
#pragma unroll
            for (int i = 0; i < 16; ++i) { const auto rr = __builtin_amdgcn_permlane32_swap((unsigned)P0[i], (unsigned)P1[i], false, false); a[i] = (int)rr[0]; P1[i] = (int)rr[1]; }
#pragma unroll
            for (int e = 0; e < 16; ++e) { int v = P1[e];
#pragma unroll
                for (int i = 0; i < 16; ++i) { const int h_ = max(a[i], v); v = min(a[i], v); a[i] = h_; } }
        }
        {
            int P0[16], P1[16];
            p8_partial(F, P0, t, 2 * h0 + 1, l31, hi); p8_partial(F, P1, t, 2 * h0 + 3, l31, hi);
#pragma unroll
            for (int i = 0; i < 16; ++i) { const auto rr = __builtin_amdgcn_permlane32_swap((unsigned)P0[i], (unsigned)P1[i], false, false); b[i] = (int)rr[0]; P1[i] = (int)rr[1]; }
#pragma unroll
            for (int e = 0; e < 16; ++e) { int v = P1[e];
#pragma unroll
                for (int i = 0; i < 16; ++i) { const int h_ = max(b[i], v); v = min(b[i], v); b[i] = h_; } }
        }
        float fa[16], fb[16]; int ia[16], ib[16];
#pragma unroll
        for (int i = 0; i < 16; ++i) { fa[i] = sort2f(a[i]); fb[i] = sort2f(b[i]); ia[i] = (127 - (a[i] & 127)) * 128; ib[i] = 127 - (b[i] & 127); }
        int c[16], cp[16];
#pragma unroll
        for (int j = 0; j < 16; ++j) { c[j] = f2sort(fa[0] + fb[j]); cp[j] = ia[0] + ib[j]; }
#pragma unroll
        for (int i = 1; i < 16; ++i)
#pragma unroll
            for (int j = 0; j < 16 / (i + 1); ++j) {
                int v = f2sort(fa[i] + fb[j]), pv = ia[i] + ib[j];
#pragma unroll
                for (int s = (i + 1) * (j + 1) - 1; s < 16; ++s) { const bool gt = v > c[s]; const int nk = gt ? v : c[s], lo = gt ? c[s] : v, np = gt ? pv : cp[s], lp = gt ? cp[s] : pv; c[s] = nk; cp[s] = np; v = lo; pv = lp; }
            }
        float e[16], sum = 0.f; const float c0 = sort2f(c[0]);
#pragma unroll
        for (int i = 0; i < 16; ++i) { e[i] = exp2f((sort2f(c[i]) - c0) * LOG2E); sum += e[i]; }
        const float inv = 1.0f / sum;
        const size_t ob = (size_t)t * 128 + (h0 + hi) * 16;
#pragma unroll
        for (int i4 = 0; i4 < 16; i4 += 4) {
            *(u32x4*)(F.pei + ob + i4) = (u32x4){(unsigned)cp[i4], (unsigned)cp[i4 + 1], (unsigned)cp[i4 + 2], (unsigned)cp[i4 + 3]};
            *(f32x4*)(F.peg + ob + i4) = (f32x4){e[i4] * inv, e[i4 + 1] * inv, e[i4 + 2] * inv, e[i4 + 3] * inv};
        }
    }
}
#if GOLD
__device__ __forceinline__ void p10_experts(const Frame& F) {
    const int gw = F.bid * 8 + F.wid, NGW = F.G * 8, lane = F.lane;
    constexpr int EPL = 4, NLD = 4;
    const float* TU = F.peer_u; const float* TV = F.peer_v;
    for (int r = gw; r < T_; r += NGW) {
        float hv[NLD][EPL], acc[NLD][EPL];
#pragma unroll
        for (int j = 0; j < NLD; ++j)
#pragma unroll
            for (int i = 0; i < EPL; ++i) { hv[j][i] = ld_act(F.h2 + (size_t)r * 1024 + j * 64 * EPL + lane * EPL + i); acc[j][i] = 0.f; }
        const int id0 = F.pei[(size_t)r * 128 + lane], id1 = F.pei[(size_t)r * 128 + 64 + lane];
        const float g0 = F.peg[(size_t)r * 128 + lane], g1 = F.peg[(size_t)r * 128 + 64 + lane];
        for (int e = 0; e < 128; ++e) {
            const int idx = __shfl((e < 64) ? id0 : id1, e & 63);
            const float gt = __shfl((e < 64) ? g0 : g1, e & 63);
            float uv[NLD][EPL], vv[NLD][EPL];
#pragma unroll
            for (int j = 0; j < NLD; ++j) {
                const f32x4 a = *(const f32x4*)(TU + (size_t)idx * 1024 + j * 256 + lane * 4), b = *(const f32x4*)(TV + (size_t)idx * 1024 + j * 256 + lane * 4);
#pragma unroll
                for (int i = 0; i < 4; ++i) { uv[j][i] = a[i]; vv[j][i] = b[i]; }
            }
            float d = 0.f;
#pragma unroll
            for (int j = 0; j < NLD; ++j)
#pragma unroll
                for (int i = 0; i < EPL; ++i) d += uv[j][i] * hv[j][i];
            d = wave_sum(d);
            const float act = 0.5f * d * (1.0f + erff(d * 0.70710678118654752f));
            const float wgt = gt * act;
#pragma unroll
            for (int j = 0; j < NLD; ++j)
#pragma unroll
                for (int i = 0; i < EPL; ++i) acc[j][i] += wgt * vv[j][i];
        }
        float ss = 0.f;
#pragma unroll
        for (int j = 0; j < NLD; ++j)
#pragma unroll
            for (int i = 0; i < EPL; ++i) ss += acc[j][i] * acc[j][i];
        const float rstd = 1.0f / sqrtf(wave_sum(ss) * (1.0f / DM) + EPS);
        const float* mrow = F.mod + (size_t)(F.b0 + r / SEQ) * 6144 + 5120;
        float* outr = F.out + ((size_t)F.b0 * SEQ + r) * DM;
#pragma unroll
        for (int j = 0; j < NLD; ++j)
#pragma unroll
            for (int i4 = 0; i4 < EPL; i4 += 4) { const int d0 = j * 64 * EPL + lane * EPL + i4;
                const f32x4 x1 = *(const f32x4*)(outr + d0), g = *(const f32x4*)(F.g_post_ffn + d0), gt2 = *(const f32x4*)(mrow + d0);
                f32x4 o;
#pragma unroll
                for (int i = 0; i < 4; ++i) o[i] = x1[i] + gt2[i] * ((acc[j][i4 + i] * rstd) * g[i]);
                *(f32x4*)(outr + d0) = o; }
    }
}
#else
#define P10_LOAD(U, V, b) do { _Pragma("unroll") for (int e_ = 0; e_ < 4; ++e_) { const int ent_ = 4 * (b) + e_; \
        const int idx_ = __builtin_amdgcn_readlane(((b) < 16) ? id0 : id1, ent_ & 63); \
        U[e_] = *(const u32x4*)(TU + (size_t)idx_ * 1024 + lane * 16); V[e_] = *(const u32x4*)(TV + (size_t)idx_ * 1024 + lane * 16); } } while (0)
#define P10_COMPUTE(U, V, b) do { float d_[4]; \
        _Pragma("unroll") for (int e_ = 0; e_ < 4; ++e_) { float s_ = 0.f; \
            _Pragma("unroll") for (int w_ = 0; w_ < 4; ++w_) { const f32x2 lo_ = __builtin_amdgcn_cvt_pk_f32_fp8((int)U[e_][w_], false), hi_ = __builtin_amdgcn_cvt_pk_f32_fp8((int)U[e_][w_], true); \
                s_ += lo_[0] * hv[4 * w_] + lo_[1] * hv[4 * w_ + 1] + hi_[0] * hv[4 * w_ + 2] + hi_[1] * hv[4 * w_ + 3]; } d_[e_] = s_; } \
        float d2_[2], d1_; \
        _Pragma("unroll") for (int e_ = 0; e_ < 2; ++e_) { const float k_ = b5 ? d_[e_ + 2] : d_[e_], s_ = b5 ? d_[e_] : d_[e_ + 2]; d2_[e_] = k_ + __shfl_xor(s_, 32); } \
        { const float k_ = b4 ? d2_[1] : d2_[0], s_ = b4 ? d2_[0] : d2_[1]; d1_ = k_ + __shfl_xor(s_, 16); } \
        d1_ += __shfl_xor(d1_, 8); d1_ += __shfl_xor(d1_, 4); d1_ += __shfl_xor(d1_, 2); d1_ += __shfl_xor(d1_, 1); \
        const float dot_ = d1_ * (1.0f / 256.0f); \
        const float act_ = 0.5f * dot_ * (1.0f + erff(dot_ * 0.70710678118654752f)); \
        const float gate_ = __shfl(((b) < 16) ? g0 : g1, (4 * (b) + eid) & 63); \
        const float wl_ = gate_ * act_ * (1.0f / 256.0f); \
        _Pragma("unroll") for (int e_ = 0; e_ < 4; ++e_) { \
            const float we_ = __uint_as_float(__builtin_amdgcn_readlane(__float_as_uint(wl_), (e_ & 1) * 16 + ((e_ >> 1) & 1) * 32)); \
            _Pragma("unroll") for (int w_ = 0; w_ < 4; ++w_) { const f32x2 lo_ = __builtin_amdgcn_cvt_pk_f32_fp8((int)V[e_][w_], false), hi_ = __builtin_amdgcn_cvt_pk_f32_fp8((int)V[e_][w_], true); \
                acc[4 * w_] += we_ * lo_[0]; acc[4 * w_ + 1] += we_ * lo_[1]; acc[4 * w_ + 2] += we_ * hi_[0]; acc[4 * w_ + 3] += we_ * hi_[1]; } } } while (0)
__device__ __forceinline__ void p10_experts(const Frame& F) {
    const int gw = F.bid * 8 + F.wid, NGW = F.G * 8, lane = F.lane;
    const unsigned char* TU = F.pu8; const unsigned char* TV = F.pv8;
    const bool b5 = (lane & 32) != 0, b4 = (lane & 16) != 0;
    const int eid = ((lane >> 4) & 1) | (((lane >> 5) & 1) << 1);
    for (int r = gw; r < T_; r += NGW) {
        float hv[16], acc[16];
        { const act_t* hp = F.h2 + (size_t)r * 1024 + lane * 16;
#pragma unroll
          for (int j = 0; j < 4; ++j) { const f32x4 t = ld4(hp + 4 * j); hv[4 * j] = t[0]; hv[4 * j + 1] = t[1]; hv[4 * j + 2] = t[2]; hv[4 * j + 3] = t[3]; } }
#pragma unroll
        for (int i = 0; i < 16; ++i) acc[i] = 0.f;
        const int id0 = F.pei[(size_t)r * 128 + lane], id1 = F.pei[(size_t)r * 128 + 64 + lane];
        const float g0 = F.peg[(size_t)r * 128 + lane], g1 = F.peg[(size_t)r * 128 + 64 + lane];
        u32x4 ua[4], va[4], ub[4], vb[4];
        for (int rep_ = 0; rep_ < ((PROBE_PH == 9) ? PROBE_N : 1); ++rep_) {
#pragma unroll
        for (int i = 0; i < 16; ++i) acc[i] = 0.f;
        P10_LOAD(ua, va, 0);
        for (int bb = 0; bb < 32; bb += 2) {
            P10_LOAD(ub, vb, bb + 1);
            P10_COMPUTE(ua, va, bb);
            if (bb + 2 < 32) P10_LOAD(ua, va, bb + 2);
            P10_COMPUTE(ub, vb, bb + 1);
        }
        }
        float ss = 0.f;
#pragma unroll
        for (int i = 0; i < 16; ++i) ss += acc[i] * acc[i];
        const float rstd = 1.0f / sqrtf(wave_sum(ss) * (1.0f / DM) + EPS);
        const float* mrow = F.mod + (size_t)(F.b0 + r / SEQ) * 6144 + 5120;
        float* outr = F.out + ((size_t)F.b0 * SEQ + r) * DM;
#pragma unroll
        for (int j = 0; j < 4; ++j) { const int d0 = lane * 16 + 4 * j;
            const f32x4 x1 = *(const f32x4*)(outr + d0), g = *(const f32x4*)(F.g_post_ffn + d0), gt2 = *(const f32x4*)(mrow + d0);
            f32x4 o;
#pragma unroll
            for (int i = 0; i < 4; ++i) o[i] = x1[i] + gt2[i] * ((acc[4 * j + i] * rstd) * g[i]);
            *(f32x4*)(outr + d0) = o; }
    }
}
#endif

__global__ void __launch_bounds__(512, 2) fwd_kernel(Args a) {
    extern __shared__ __attribute__((aligned(16))) unsigned char lds[];
    Frame F;
    F.lds = lds; F.tid = threadIdx.x; F.lane = F.tid & 63; F.wid = __builtin_amdgcn_readfirstlane(F.tid >> 6); F.G = gridDim.x; F.bid = blockIdx.x; F.b0 = a.b0;
    F.x = a.in[0]; F.c = a.in[1]; F.ctx = a.in[2]; F.c_ctx = a.in[3]; F.w_ada = a.in[4]; F.b_ada = a.in[5]; F.g_pre_mix = a.in[6]; F.g_post_mix = a.in[7];
    F.g_pre_ffn = a.in[8]; F.g_post_ffn = a.in[9]; F.w_in = a.in[10]; F.sink = a.in[11]; F.w_o_attn = a.in[12]; F.conv_dw = a.in[13]; F.conv_dw_b = a.in[14];
    F.conv_ln_g = a.in[15]; F.conv_ln_b = a.in[16]; F.w_o_conv = a.in[17]; F.w_out = a.in[18]; F.peer_wq = a.in[19]; F.peer_keys = a.in[20]; F.peer_u = a.in[21]; F.peer_v = a.in[22];
    F.out = a.out;
    unsigned char* ws = a.ws;
    F.mod = (float*)(ws + WS_MOD); F.rope = (float*)(ws + WS_ROPE);
    F.win_t = (act_t*)(ws + WS_WIN); F.woa_t = (act_t*)(ws + WS_WOA); F.woc_t = (act_t*)(ws + WS_WOC); F.wout_t = (act_t*)(ws + WS_WOUT); F.wq_t = (act_t*)(ws + WS_WQ); F.keys_t = (act_t*)(ws + WS_KEYS);
    F.q = (act_t*)(ws + O_Q); F.k = (act_t*)(ws + O_K); F.vT = (act_t*)(ws + O_VT); F.u = (act_t*)(ws + O_U); F.sg = (act_t*)(ws + O_SG); F.kc = (act_t*)(ws + O_KC); F.vTc = (act_t*)(ws + O_VTC);
    F.att = (act_t*)(ws + O_ATT); F.cact = (act_t*)(ws + O_CACT); F.hx = (act_t*)(ws + O_HX); F.hc = (act_t*)(ws + O_HC); F.m = (act_t*)(ws + O_M); F.h2 = (act_t*)(ws + O_H2); F.pq = (act_t*)(ws + O_PQ);
    F.mixed = (float*)(ws + O_MIXED); F.topv = (float*)(ws + O_TOPV); F.topi = (int*)(ws + O_TOPI); F.pei = (int*)(ws + O_PEI); F.peg = (float*)(ws + O_PEG);
    F.pu8 = ws + O_PU; F.pv8 = ws + O_PV;

    volatile LAS unsigned* misc = (volatile LAS unsigned*)(LAS unsigned char*)(lds + LDS_MISC);
    if (F.tid < 64) misc[F.tid] = 0u;
    __syncthreads();
    const int lo = a.ph_lo, hi = a.ph_hi;
    XcdBarrier bar; bar.bar = (unsigned*)(ws + WS_CTL); bar.x = 0; bar.st = misc;
    if (hi - lo > 1) bar = xcd_barrier_post((unsigned*)(ws + WS_CTL), misc);
#define IN(k) (lo <= (k) && (k) < hi)
#define SEAM(k) do { if (IN(k) && IN((k) + 1)) xcd_barrier(bar); } while (0)
#define REP(k) for (int rep_ = 0; rep_ < ((PROBE_PH == (k)) ? PROBE_N : 1); ++rep_)
    if (IN(0)) { REP(0) { p0_prep(F); __syncthreads(); } } SEAM(0);
    if (IN(1)) { REP(1) { p1_norm(F); } } SEAM(1);
    if (IN(2)) { REP(2) { p2_inproj(F); } } SEAM(2);
    if (IN(3)) { REP(3) { p3_attn(F); __syncthreads(); } REP(11) { p3_conv(F); __syncthreads(); } } SEAM(3);
    if (IN(4)) { REP(4) { p4_merge(F); } } SEAM(4);
    if (IN(5)) { REP(5) { p5_out(F); } } SEAM(5);
    if (IN(6)) { REP(6) { p6_rows(F); } } SEAM(6);
    if (IN(7)) { REP(7) { p7_wq(F); } } SEAM(7);
    if (IN(8)) { REP(8) { p8_topk(F); } } SEAM(8);
    if (IN(9)) { p10_experts(F); }
#undef REP
#undef IN
#undef SEAM
}

extern "C" void kernel_launch(void* const* d_in, const int* in_sizes, int n_in, void* d_out, int out_size, void* d_ws, size_t ws_size, hipStream_t stream) {
    static int grid = 0;
    if (grid == 0) {
        if (n_in != 23 || ws_size < WS_END) { fprintf(stderr, "kernel_launch: need 23 inputs and %zu B of workspace (got %d, %zu)\n", (size_t)WS_END, n_in, ws_size); grid = -1; return; }
        int dev = 0, cus = 0;
        if (hipGetDevice(&dev) != hipSuccess || hipDeviceGetAttribute(&cus, hipDeviceAttributeMultiprocessorCount, dev) != hipSuccess) { grid = -1; return; }
        if (hipFuncSetAttribute((const void*)fwd_kernel, hipFuncAttributeMaxDynamicSharedMemorySize, LDS_BYTES) != hipSuccess) { fprintf(stderr, "kernel_launch: hipFuncSetAttribute failed\n"); grid = -1; return; }
        grid = cus;
    }
    if (grid < 0) return;
    (void)hipMemsetAsync((char*)d_ws + WS_CTL, 0, CTL_BYTES, stream);
    Args a{};
    for (int i = 0; i < 23; ++i) a.in[i] = (const float*)d_in[i];
    a.out = (float*)d_out; a.ws = (unsigned char*)d_ws;
#if ONE_LAUNCH
    a.ph_lo = 0; a.ph_hi = NPHASE; a.b0 = 0;
    hipLaunchKernelGGL(fwd_kernel, dim3(grid), dim3(512), LDS_BYTES, stream, a);
#else
    a.ph_lo = 0; a.ph_hi = 1; a.b0 = 0;
    hipLaunchKernelGGL(fwd_kernel, dim3(grid), dim3(512), LDS_BYTES, stream, a);
    for (int b0 = 0; b0 < BATCH; b0 += CH_B)
        for (int ph = 1; ph < NPHASE; ++ph) { a.ph_lo = ph; a.ph_hi = ph + 1; a.b0 = b0; hipLaunchKernelGGL(fwd_kernel, dim3(grid), dim3(512), LDS_BYTES, stream, a); }
#endif
}
```

```cpp
#include <hip/hip_runtime.h>
#include <cstdint>
#include <cstdio>

#ifndef GOLD
#define GOLD 0
#endif
#ifndef PROBE_PH
#define PROBE_PH -1
#endif
#ifndef PROBE_N
#define PROBE_N 2
#endif
#ifndef ONE_LAUNCH
#define ONE_LAUNCH 1
#endif

typedef unsigned short bf16_t;
typedef short bf16x8 __attribute__((ext_vector_type(8)));
typedef short s16x4 __attribute__((ext_vector_type(4)));
typedef float f32x4 __attribute__((ext_vector_type(4)));
typedef float f32x16 __attribute__((ext_vector_type(16)));
typedef unsigned u32x2 __attribute__((ext_vector_type(2)));
typedef unsigned u32x4 __attribute__((ext_vector_type(4)));
typedef float f32x2 __attribute__((ext_vector_type(2)));

#if GOLD
typedef float act_t;
#else
typedef bf16_t act_t;
#endif
constexpr int AS = sizeof(act_t);

constexpr int DM = 1024, BATCH = 8, SEQ = 2048, CTXL = 256, NH = 16, NKV = 4, HD = 64;
constexpr int INW = 4608, PQW = 2048, NEXP = 16384;
constexpr int CONV_CH = 512, CONV_W = 31;
constexpr float EPS = 1e-6f;
constexpr float LOG2E = 1.4426950408889634f;
constexpr float QS = 0.125f * LOG2E;
#if GOLD
constexpr int CH_B = 1;
#else
constexpr int CH_B = 8;
#endif
constexpr int T_ = CH_B * SEQ;
constexpr int CT_ = CH_B * CTXL;
constexpr int NPHASE = 10;

constexpr size_t MiB = 1u << 20;
constexpr size_t WS_CTL = 0, CTL_BYTES = 1 * MiB;
constexpr size_t WS_MOD = 512 * 1024;
constexpr size_t WS_ROPE = 1 * MiB;
constexpr size_t WS_WIN = 2 * MiB;
constexpr size_t WS_WOA = 22 * MiB;
constexpr size_t WS_WOC = 26 * MiB;
constexpr size_t WS_WOUT = 28 * MiB;
constexpr size_t WS_WQ = 32 * MiB;
constexpr size_t WS_KEYS = 40 * MiB;
constexpr size_t AR = 42 * MiB;
constexpr size_t A0 = AR;
constexpr size_t O_Q = A0;
constexpr size_t O_K = O_Q + (size_t)T_ * 1024 * AS;
constexpr size_t O_VT = O_K + (size_t)T_ * 256 * AS;
constexpr size_t O_U = O_VT + (size_t)T_ * 256 * AS;
constexpr size_t O_SG = O_U + (size_t)T_ * 512 * AS;
constexpr size_t O_KC = O_SG + (size_t)T_ * 2048 * AS;
constexpr size_t O_VTC = O_KC + (size_t)CT_ * 256 * AS;
constexpr size_t A0_END = O_VTC + (size_t)CT_ * 256 * AS;
constexpr size_t O_MIXED = A0;
constexpr size_t O_PQ = A0 + (size_t)T_ * 4096;
constexpr size_t O_TOPV = A0;
constexpr size_t O_TOPI = A0 + (size_t)T_ * 1024;
constexpr size_t O_PV = A0 + 32 * MiB;
constexpr size_t A1 = A0_END;
constexpr size_t O_ATT = A1;
constexpr size_t O_CACT = O_ATT + (size_t)T_ * 1024 * AS;
constexpr size_t A1_END = O_CACT + (size_t)T_ * 512 * AS;
constexpr size_t O_HX = A1;
constexpr size_t O_HC = A1 + (size_t)T_ * 1024 * AS;
constexpr size_t O_PU = A1;
constexpr size_t O_PEI = O_CACT;
constexpr size_t O_PEG = O_CACT + (size_t)T_ * 512;
constexpr size_t A2 = A1_END;
constexpr size_t O_M = A2;
constexpr size_t O_H2 = A2;
constexpr size_t WS_END = A2 + (size_t)T_ * 1024 * AS;
static_assert(O_PQ + (size_t)T_ * 2048 * AS <= A0_END, "pq overlay");
static_assert(O_TOPI + (size_t)T_ * 1024 <= O_PQ, "topk overlay");
static_assert(GOLD || (O_PV >= O_TOPI + (size_t)T_ * 1024 && O_PV + 32 * MiB <= O_PQ), "pv overlay");
static_assert(GOLD || (O_PU + 32 * MiB <= O_PEI), "pu overlay");
static_assert(O_PEG + (size_t)T_ * 512 <= A1_END, "pe overlay");
static_assert(O_HC + (size_t)CT_ * 1024 * AS <= A1_END, "hc overlay");

constexpr int LDS_BYTES = 147456;
constexpr int LDS_MISC = LDS_BYTES - 256;

__device__ __forceinline__ float bf2f(bf16_t h) { return __uint_as_float((unsigned)h << 16); }
__device__ __forceinline__ unsigned f2bf(float f) { unsigned u = __float_as_uint(f); return (u + 0x7fffu + ((u >> 16) & 1u)) >> 16; }
__device__ __forceinline__ unsigned pk2(float lo, float hi) { return f2bf(lo) | (f2bf(hi) << 16); }
#if GOLD
__device__ __forceinline__ float ld_act(const act_t* p) { return *p; }
__device__ __forceinline__ void st_act(act_t* p, float v) { *p = v; }
__device__ __forceinline__ f32x4 ld4(const act_t* p) { return *(const f32x4*)p; }
__device__ __forceinline__ void st4(act_t* p, f32x4 v) { *(f32x4*)p = v; }
#else
__device__ __forceinline__ float ld_act(const act_t* p) { return bf2f(*p); }
__device__ __forceinline__ void st_act(act_t* p, float v) { *p = (bf16_t)f2bf(v); }
__device__ __forceinline__ f32x4 ld4(const act_t* p) { u32x2 w = *(const u32x2*)p; f32x4 r; r[0] = __uint_as_float(w[0] << 16); r[1] = __uint_as_float(w[0] & 0xffff0000u); r[2] = __uint_as_float(w[1] << 16); r[3] = __uint_as_float(w[1] & 0xffff0000u); return r; }
__device__ __forceinline__ void st4(act_t* p, f32x4 v) { u32x2 w; w[0] = pk2(v[0], v[1]); w[1] = pk2(v[2], v[3]); *(u32x2*)p = w; }
#endif
__device__ __forceinline__ float wave_sum(float v) {
#pragma unroll
    for (int o = 1; o < 64; o <<= 1) v += __shfl_xor(v, o);
    return v;
}
__device__ __forceinline__ float wave_max(float v) {
#pragma unroll
    for (int o = 1; o < 64; o <<= 1) v = fmaxf(v, __shfl_xor(v, o));
    return v;
}
__device__ __forceinline__ float sigmoidf_(float x) { return 1.0f / (1.0f + expf(-x)); }
__device__ __forceinline__ int crow(int r, int hi) { return (r & 3) + 8 * (r >> 2) + 4 * hi; }

#define LAS __attribute__((address_space(3)))
#define XB_TMO      128
#define XB_XCNT(j)  (256  + 64 * (j))
#define XB_XSUB(j)  (1280 + 64 * (j))
#define XB_XGEN(j)  (2304 + 64 * (j))
#define XB_TOP      3328
#define XB_TOPGEN   3392
#define XCD_BAR_WORDS 3456
#define XB_SPIN_CAP (1u << 18)
__device__ __forceinline__ unsigned xb_ld(unsigned* p)              { return __hip_atomic_load(p, __ATOMIC_RELAXED, __HIP_MEMORY_SCOPE_AGENT); }
__device__ __forceinline__ unsigned xb_add(unsigned* p, unsigned v) { return __hip_atomic_fetch_add(p, v, __ATOMIC_RELAXED, __HIP_MEMORY_SCOPE_AGENT); }
__device__ __forceinline__ unsigned xb_xcc_id() { return (unsigned)__builtin_amdgcn_s_getreg((3 << 11) | 20) & 0xFu; }
#define XB_SPIN(cond, bar) do { unsigned _sp = 0; while (cond) { __builtin_amdgcn_s_sleep(1); \
    if ((++_sp & 255u) == 0u) { if (xb_ld(&(bar)[XB_TMO])) break; if (_sp > XB_SPIN_CAP) { atomicAdd(&(bar)[XB_TMO], 1u); break; } } } } while (0)
struct XcdBarrier { unsigned* bar; unsigned x; volatile LAS unsigned* st; };
__device__ __forceinline__ XcdBarrier xcd_barrier_post(unsigned* bar, volatile LAS unsigned* st) {
    XcdBarrier b; b.bar = bar; b.x = xb_xcc_id(); b.st = st;
    if (threadIdx.x == 0) (void)xb_add(&bar[XB_XCNT(b.x)], 1u);
    return b;
}
__device__ __forceinline__ void xcd_barrier_complete(unsigned* bar, unsigned x, unsigned& nloc, unsigned& nx) {
    const unsigned G = gridDim.x * gridDim.y * gridDim.z;
    unsigned sum, cnt, mine, sp = 0u;
    for (;;) {
        sum = 0u; cnt = 0u; mine = 0u;
#pragma unroll
        for (unsigned j = 0; j < 16; ++j) { const unsigned c = xb_ld(&bar[XB_XCNT(j)]); sum += c; cnt += (c > 0u) ? 1u : 0u; mine = (j == x) ? c : mine; }
        if (sum == G) break;
        __builtin_amdgcn_s_sleep(1);
        if ((++sp & 255u) == 0u) { if (xb_ld(&bar[XB_TMO])) break; if (sp > XB_SPIN_CAP) { atomicAdd(&bar[XB_TMO], 1u); break; } }
    }
    nloc = mine > 0u ? mine : 1u; nx = cnt > 0u ? cnt : 1u;
}
__device__ __forceinline__ void xcd_barrier(const XcdBarrier& b) {
    asm volatile("s_waitcnt vmcnt(0)" ::: "memory");
    __syncthreads();
    if (threadIdx.x == 0) {
        unsigned* bar = b.bar;
        __builtin_amdgcn_s_waitcnt(0);
        unsigned nloc = b.st[0], nx = b.st[1];
        if (nloc == 0u) { xcd_barrier_complete(bar, b.x, nloc, nx); b.st[0] = nloc; b.st[1] = nx; }
        const unsigned old = xb_add(&bar[XB_XSUB(b.x)], 1u);
        const unsigned gen = old / nloc;
        if (old + 1u == (gen + 1u) * nloc) {
            __builtin_amdgcn_fence(__ATOMIC_RELEASE, "agent");
            asm volatile("s_waitcnt vmcnt(0)" ::: "memory");
            const unsigned og = xb_add(&bar[XB_TOP], 1u);
            const unsigned tg = og / nx;
            if (og + 1u == (tg + 1u) * nx) xb_add(&bar[XB_TOPGEN], 1u);
            else XB_SPIN(xb_ld(&bar[XB_TOPGEN]) == tg, bar);
            __builtin_amdgcn_fence(__ATOMIC_ACQUIRE, "agent");
            xb_add(&bar[XB_XGEN(b.x)], 1u);
            asm volatile("s_waitcnt vmcnt(0)" ::: "memory");
        } else {
            XB_SPIN(xb_ld(&bar[XB_XGEN(b.x)]) == gen, bar);
            __builtin_amdgcn_fence(__ATOMIC_ACQUIRE, "agent");
            asm volatile("s_waitcnt vmcnt(0)" ::: "memory");
        }
    }
    __syncthreads();
}

struct Args { const float* in[23]; float* out; unsigned char* ws; int ph_lo, ph_hi, b0, pad; };

struct Frame {
    unsigned char* lds;
    int tid, lane, wid, G, bid;
    int b0;
    const float *x, *c, *ctx, *c_ctx, *w_ada, *b_ada, *g_pre_mix, *g_post_mix, *g_pre_ffn, *g_post_ffn, *w_in, *sink, *w_o_attn,
        *conv_dw, *conv_dw_b, *conv_ln_g, *conv_ln_b, *w_o_conv, *w_out, *peer_wq, *peer_keys, *peer_u, *peer_v;
    float* out;
    float* mod; float* rope;
    act_t *win_t, *woa_t, *woc_t, *wout_t, *wq_t, *keys_t;
    act_t *q, *k, *vT, *u, *sg, *kc, *vTc, *att, *cact, *hx, *hc, *m, *h2, *pq;
    float *mixed, *topv, *peg; int *topi, *pei;
    unsigned char *pu8, *pv8;
};

constexpr int BK = 32;
#if GOLD
constexpr int LDT = 36;
#else
constexpr int LDT = 40;
#endif
constexpr int TILE_LDS = 128 * LDT * AS;
constexpr int GEMM_LDS = 2 * TILE_LDS;

__device__ __forceinline__ void acc_zero(f32x4 (&acc)[2][4]) {
#pragma unroll
    for (int i = 0; i < 2; ++i)
#pragma unroll
        for (int j = 0; j < 4; ++j) acc[i][j] = (f32x4){0.f, 0.f, 0.f, 0.f};
}

__device__ __forceinline__ void mma_tile(f32x4 (&acc)[2][4], unsigned char* lds, const act_t* __restrict__ A, int lda,
                                         const act_t* __restrict__ Bt, int ldb, int K, int m0, int n0) {
    const int tid = threadIdx.x, lane = tid & 63, wid = tid >> 6, wm = wid >> 1, wn = wid & 1, fr = lane & 15, fq = lane >> 4;
    act_t* As = (act_t*)lds; act_t* Bs = (act_t*)(lds + TILE_LDS);
    constexpr int EPC = 16 / AS, CPR = BK / EPC, NCH = 128 * CPR / 512;
    u32x4 ra[NCH], rb[NCH];
#pragma unroll
    for (int i = 0; i < NCH; ++i) { const int cidx = tid + 512 * i, row = cidx / CPR, ch = cidx % CPR;
        ra[i] = *(const u32x4*)(A + (size_t)(m0 + row) * lda + ch * EPC);
        rb[i] = *(const u32x4*)(Bt + (size_t)(n0 + row) * ldb + ch * EPC); }
    const int nk = K / BK;
    for (int kt = 0; kt < nk; ++kt) {
        __syncthreads();
#pragma unroll
        for (int i = 0; i < NCH; ++i) { const int cidx = tid + 512 * i, row = cidx / CPR, ch = cidx % CPR;
            *(u32x4*)(As + row * LDT + ch * EPC) = ra[i];
            *(u32x4*)(Bs + row * LDT + ch * EPC) = rb[i]; }
        __syncthreads();
        if (kt + 1 < nk) {
            const int k1 = (kt + 1) * BK;
#pragma unroll
            for (int i = 0; i < NCH; ++i) { const int cidx = tid + 512 * i, row = cidx / CPR, ch = cidx % CPR;
                ra[i] = *(const u32x4*)(A + (size_t)(m0 + row) * lda + k1 + ch * EPC);
                rb[i] = *(const u32x4*)(Bt + (size_t)(n0 + row) * ldb + k1 + ch * EPC); }
        }
#if GOLD
        f32x4 a4[2][2], b4[4][2];
#pragma unroll
        for (int mi = 0; mi < 2; ++mi)
#pragma unroll
            for (int g = 0; g < 2; ++g) a4[mi][g] = *(const f32x4*)(As + (wm * 32 + mi * 16 + fr) * LDT + 16 * g + 4 * fq);
#pragma unroll
        for (int ni = 0; ni < 4; ++ni)
#pragma unroll
            for (int g = 0; g < 2; ++g) b4[ni][g] = *(const f32x4*)(Bs + (wn * 64 + ni * 16 + fr) * LDT + 16 * g + 4 * fq);
#pragma unroll
        for (int mi = 0; mi < 2; ++mi)
#pragma unroll
            for (int ni = 0; ni < 4; ++ni)
#pragma unroll
                for (int g = 0; g < 2; ++g)
#pragma unroll
                    for (int j = 0; j < 4; ++j) acc[mi][ni] = __builtin_amdgcn_mfma_f32_16x16x4f32(b4[ni][g][j], a4[mi][g][j], acc[mi][ni], 0, 0, 0);
#else
        bf16x8 af[2], bfr[4];
#pragma unroll
        for (int mi = 0; mi < 2; ++mi) af[mi] = *(const bf16x8*)(As + (wm * 32 + mi * 16 + fr) * LDT + fq * 8);
#pragma unroll
        for (int ni = 0; ni < 4; ++ni) bfr[ni] = *(const bf16x8*)(Bs + (wn * 64 + ni * 16 + fr) * LDT + fq * 8);
#pragma unroll
        for (int mi = 0; mi < 2; ++mi)
#pragma unroll
            for (int ni = 0; ni < 4; ++ni) acc[mi][ni] = __builtin_amdgcn_mfma_f32_16x16x32_bf16(bfr[ni], af[mi], acc[mi][ni], 0, 0, 0);
#endif
    }
}
template <class F> __device__ __forceinline__ void epi_foreach(const f32x4 (&acc)[2][4], int m0, int n0, F f) {
    const int tid = threadIdx.x, lane = tid & 63, wid = tid >> 6, wm = wid >> 1, wn = wid & 1, fr = lane & 15, fq = lane >> 4;
#pragma unroll
    for (int mi = 0; mi < 2; ++mi)
#pragma unroll
        for (int gp = 0; gp < 2; ++gp) f(m0 + wm * 32 + mi * 16 + fr, n0 + wn * 64 + gp * 32 + 4 * fq, acc[mi][2 * gp], acc[mi][2 * gp + 1]);
}


#if !GOLD
namespace pg8 {
#define PG8_LAS __attribute__((address_space(3)))
typedef unsigned short bf16_t;
typedef short bf16x8 __attribute__((ext_vector_type(8)));
typedef float f32x4 __attribute__((ext_vector_type(4)));
typedef unsigned u32x4 __attribute__((ext_vector_type(4)));
constexpr int BM = 256, BK = 64, HALF = 128, HTB = HALF * BK * 2  , STAGE_BYTES = 8 * HTB, NXCD = 8, WGM = 8;

__host__ __device__ __forceinline__ int lds_byte(int r, int c) { const int st = (r >> 4) * 2 + (c >> 5), rr = r & 15, cc = c & 31, ob = rr * 64 + cc * 2; return st * 1024 + (ob ^ (((ob >> 9) & 1) << 5)); }
__host__ __device__ __forceinline__ void stage_rc(int b, int& R, int& C) { const int st = b / 1024, sb = b % 1024, swz = sb ^ (((sb >> 9) & 1) << 5); R = (st >> 1) * 16 + swz / 64; C = (st & 1) * 32 + (swz % 64) / 2; }
__host__ __device__ __forceinline__ int perm32(int rho) { const int n = rho >> 4, i = rho & 15; return 8 * (i >> 2) + 4 * n + (i & 3); }

struct Unit { int pm, pn; };
struct Gemm { const bf16_t* A; const bf16_t* Bt; int M, N, K; };

struct StaticOrder {
    int nM, nN, nwg, G, c;
    __host__ __device__ void init(int M, int N, int G_, int c_) { nM = M / BM; nN = N / BM; nwg = nM * nN; G = G_; c = c_; }
    __host__ __device__ bool next(int i, Unit& u) const {
        const long L = (long)i * G + c; if (L >= nwg) return false;
        int wgid = (int)L; { const int q = nwg / NXCD, r = nwg % NXCD, xcd = wgid % NXCD, off = wgid / NXCD; wgid = (xcd < r ? xcd * (q + 1) : r * (q + 1) + (xcd - r) * q) + off; }
        const int nig = WGM * nN, gid = wgid / nig, fm = gid * WGM, gsz = (nM - fm) < WGM ? (nM - fm) : WGM;
        u.pm = fm + ((wgid % nig) % gsz); u.pn = (wgid % nig) / gsz; return true;
    }
    __device__ __forceinline__ void a_ready(const Unit&) const {}
    __device__ __forceinline__ void done(const Unit&) const {}
};
template <class Epi, class Sched, bool ALIGN_EPI = false, bool SP2 = false>
__device__ __forceinline__ void gemm_phase(PG8_LAS unsigned char* lds, const Gemm g, const Sched& S, const Epi& E) {
    const int tid = threadIdx.x, wid = __builtin_amdgcn_readfirstlane(tid >> 6), lane = tid & 63, wr = wid >> 2, wc = wid & 3, fr = lane & 15, fq = lane >> 4;
    const int K = g.K, nt = K / BK;
    unsigned voffA[2], voffB[2];
#pragma unroll
    for (int i = 0; i < 2; ++i) { int R, C; stage_rc(tid * 16 + i * 8192, R, C); const int Rb = Epi::PERM ? ((R & ~31) + perm32(R & 31)) : R;
        voffA[i] = (unsigned)(R * K + C) * 2u; voffB[i] = (unsigned)(Rb * K + C) * 2u; }
    const size_t kstep = (size_t)(BK * 2);
    const size_t hstep = (size_t)HALF * K * 2;
    const size_t tstep = 2 * hstep;
    const unsigned ldsw = (unsigned)wid * 1024u;
    const int aoff = lds_byte(wr * 64 + fr, fq * 8), boff = lds_byte(wc * 32 + fr, fq * 8);
#define PG8_SA(b, h) (((b) * 2 + (h)) * HTB)
#define PG8_SB(b, h) ((4 + (b) * 2 + (h)) * HTB)
#define PG8_STAGE(bufoff, gbase, voff) do { _Pragma("unroll") for (int _i = 0; _i < 2; ++_i) \
        __builtin_amdgcn_global_load_lds((const unsigned*)((const char*)(gbase) + (voff)[_i]), (PG8_LAS unsigned*)(lds + (bufoff) + ldsw + _i * 8192), 16, 0, 0); } while (0)
#define PG8_LDA(dst, b, h) do { _Pragma("unroll") for (int m = 0; m < 4; ++m) _Pragma("unroll") for (int k = 0; k < 2; ++k) dst[m][k] = *(const PG8_LAS bf16x8*)(lds + PG8_SA(b, h) + aoff + m * 2048 + k * 1024); } while (0)
#define PG8_LDB(dst, b, h) do { _Pragma("unroll") for (int n = 0; n < 2; ++n) _Pragma("unroll") for (int k = 0; k < 2; ++k) dst[n][k] = *(const PG8_LAS bf16x8*)(lds + PG8_SB(b, h) + boff + n * 2048 + k * 1024); } while (0)
#define PG8_MMA(ai, bj, At, Bt) do { __builtin_amdgcn_s_setprio(1); _Pragma("unroll") for (int m = 0; m < 4; ++m) _Pragma("unroll") for (int n = 0; n < 2; ++n) _Pragma("unroll") for (int k = 0; k < 2; ++k) \
        acc[ai][bj][m][n] = __builtin_amdgcn_mfma_f32_16x16x32_bf16(Bt[n][k], At[m][k], acc[ai][bj][m][n], 0, 0, 0); __builtin_amdgcn_s_setprio(0); } while (0)
#define PG8_WAIT_V(n) asm volatile("s_waitcnt vmcnt(" #n ")" ::: "memory")
#define PG8_WAIT_L(n) asm volatile("s_waitcnt lgkmcnt(" #n ")" ::: "memory")
#define PG8_BAR __builtin_amdgcn_s_barrier()
#define PG8_SCHED __builtin_amdgcn_sched_barrier(0)
    Unit cur, nxt; int ui = 0;
    if (!S.next(0, cur)) return;
    f32x4 acc[2][2][4][2];
#pragma unroll
    for (int a = 0; a < 2; ++a)
#pragma unroll
        for (int b = 0; b < 2; ++b)
#pragma unroll
            for (int m = 0; m < 4; ++m)
#pragma unroll
                for (int n = 0; n < 2; ++n) acc[a][b][m][n] = (f32x4){0.f, 0.f, 0.f, 0.f};
    bf16x8 At[4][2], B0[2][2], B1[2][2];
    const char* cA = (const char*)g.A + (size_t)cur.pm * tstep; const char* cB = (const char*)g.Bt + (size_t)cur.pn * tstep;
    S.a_ready(cur);
    if constexpr (SP2) {
        PG8_STAGE(PG8_SB(0, 0), cB, voffB); PG8_STAGE(PG8_SB(0, 1), cB + hstep, voffB); PG8_STAGE(PG8_SA(0, 0), cA, voffA); PG8_STAGE(PG8_SA(0, 1), cA + hstep, voffA);
        if (wr == 1) PG8_BAR;
        PG8_WAIT_V(2); PG8_BAR;
        PG8_STAGE(PG8_SB(1, 0), cB + kstep, voffB); PG8_STAGE(PG8_SA(1, 0), cA + kstep, voffA); PG8_STAGE(PG8_SB(1, 1), cB + hstep + kstep, voffB);
        PG8_WAIT_V(6); PG8_BAR;
    } else {
        PG8_STAGE(PG8_SB(0, 0), cB, voffB); PG8_STAGE(PG8_SA(0, 0), cA, voffA); PG8_STAGE(PG8_SB(0, 1), cB + hstep, voffB); PG8_STAGE(PG8_SA(0, 1), cA + hstep, voffA);
        if (wr == 1) PG8_BAR;
        PG8_WAIT_V(4); PG8_BAR;
        PG8_STAGE(PG8_SB(1, 0), cB + kstep, voffB); PG8_STAGE(PG8_SA(1, 0), cA + kstep, voffA); PG8_STAGE(PG8_SB(1, 1), cB + hstep + kstep, voffB);
        PG8_WAIT_V(6); PG8_BAR;
    }
    for (;;) {
        const bool has_next = S.next(ui + 1, nxt);
        const char* nA = has_next ? (const char*)g.A + (size_t)nxt.pm * tstep : cA; const char* nB = has_next ? (const char*)g.Bt + (size_t)nxt.pn * tstep : cB;
        for (int t = 0; t < nt; t += 2) {
            const bool last = (t == nt - 2);
            const char* a1 = cA + (size_t)(t + 1) * kstep;
            const char* a2 = last ? nA : cA + (size_t)(t + 2) * kstep; const char* b2 = last ? nB : cB + (size_t)(t + 2) * kstep;
            const char* a3 = a2 + kstep; const char* b3 = b2 + kstep;
            if (last && has_next) S.a_ready(nxt);
            if constexpr (SP2) {
            PG8_LDB(B0, 0, 0); PG8_LDB(B1, 0, 1); PG8_SCHED; PG8_LDA(At, 0, 0); PG8_STAGE(PG8_SA(1, 1), a1 + hstep, voffA);
            PG8_WAIT_V(8); PG8_WAIT_L(0); PG8_BAR; PG8_MMA(0, 0, At, B0); PG8_MMA(0, 1, At, B1); PG8_BAR; PG8_SCHED;
            PG8_LDA(At, 0, 1); PG8_STAGE(PG8_SB(0, 0), b2, voffB); PG8_STAGE(PG8_SB(0, 1), b2 + hstep, voffB); PG8_STAGE(PG8_SA(0, 0), a2, voffA);
            PG8_WAIT_V(8); PG8_WAIT_L(0); PG8_BAR; PG8_MMA(1, 0, At, B0); PG8_MMA(1, 1, At, B1); PG8_BAR; PG8_SCHED;
            PG8_LDB(B0, 1, 0); PG8_LDB(B1, 1, 1); PG8_SCHED; PG8_LDA(At, 1, 0); PG8_STAGE(PG8_SA(0, 1), a2 + hstep, voffA);
            PG8_WAIT_V(8); PG8_WAIT_L(0); PG8_BAR; PG8_MMA(0, 0, At, B0); PG8_MMA(0, 1, At, B1); PG8_BAR; PG8_SCHED;
            PG8_LDA(At, 1, 1); PG8_STAGE(PG8_SB(1, 0), b3, voffB); PG8_STAGE(PG8_SB(1, 1), b3 + hstep, voffB); PG8_STAGE(PG8_SA(1, 0), a3, voffA);
            PG8_WAIT_V(8); PG8_WAIT_L(0); PG8_BAR; PG8_MMA(1, 0, At, B0); PG8_MMA(1, 1, At, B1); PG8_BAR; PG8_SCHED;
            } else {
            PG8_LDB(B0, 0, 0); PG8_SCHED; PG8_LDA(At, 0, 0); PG8_STAGE(PG8_SA(1, 1), a1 + hstep, voffA);
            PG8_WAIT_L(8); PG8_BAR; PG8_WAIT_L(0); PG8_MMA(0, 0, At, B0); PG8_BAR; PG8_SCHED;
            PG8_LDB(B1, 0, 1); PG8_STAGE(PG8_SB(0, 0), b2, voffB);
            PG8_BAR; PG8_WAIT_L(0); PG8_MMA(0, 1, At, B1); PG8_BAR;
            PG8_LDA(At, 0, 1); PG8_STAGE(PG8_SA(0, 0), a2, voffA);
            PG8_BAR; PG8_WAIT_L(0); PG8_MMA(1, 0, At, B0); PG8_BAR; PG8_SCHED;
            PG8_STAGE(PG8_SB(0, 1), b2 + hstep, voffB);
            PG8_WAIT_V(6); PG8_BAR; PG8_MMA(1, 1, At, B1); PG8_BAR;
            PG8_LDB(B0, 1, 0); PG8_SCHED; PG8_LDA(At, 1, 0); PG8_STAGE(PG8_SA(0, 1), a2 + hstep, voffA);
            PG8_WAIT_L(8); PG8_BAR; PG8_WAIT_L(0); PG8_MMA(0, 0, At, B0); PG8_BAR; PG8_SCHED;
            PG8_LDB(B1, 1, 1); PG8_STAGE(PG8_SB(1, 0), b3, voffB);
            PG8_BAR; PG8_WAIT_L(0); PG8_MMA(0, 1, At, B1); PG8_BAR;
            PG8_LDA(At, 1, 1); PG8_STAGE(PG8_SA(1, 0), a3, voffA);
            PG8_BAR; PG8_WAIT_L(0); PG8_MMA(1, 0, At, B0); PG8_BAR; PG8_SCHED;
            PG8_STAGE(PG8_SB(1, 1), b3 + hstep, voffB);
            PG8_WAIT_V(6); PG8_BAR; PG8_MMA(1, 1, At, B1); PG8_BAR;
            }
        }
        if constexpr (ALIGN_EPI) { if (wr == 0) PG8_BAR; }
        if constexpr (!Epi::AFTER_DRAIN) { E(acc, cur, wr, wc, fr, fq); S.done(cur); }
        if (!has_next) break;
#pragma unroll
        for (int a = 0; a < 2; ++a)
#pragma unroll
            for (int b = 0; b < 2; ++b)
#pragma unroll
                for (int m = 0; m < 4; ++m)
#pragma unroll
                    for (int n = 0; n < 2; ++n) acc[a][b][m][n] = (f32x4){0.f, 0.f, 0.f, 0.f};
        cur = nxt; cA = nA; cB = nB; ++ui;
        if constexpr (ALIGN_EPI) { if (wr == 1) PG8_BAR; }
    }
    PG8_WAIT_V(0);
    if constexpr (!ALIGN_EPI) { if (wr == 0) PG8_BAR; }
    PG8_BAR;
    if constexpr (Epi::AFTER_DRAIN) { E.fused(acc, cur, wr, wc, fr, fq, lds, wid, lane); S.done(cur); }
#undef PG8_SA
#undef PG8_SB
#undef PG8_STAGE
#undef PG8_LDA
#undef PG8_LDB
#undef PG8_MMA
#undef PG8_WAIT_V
#undef PG8_WAIT_L
#undef PG8_BAR
#undef PG8_SCHED
}
}

template <class Fn> struct EpiFn {
    static constexpr bool PERM = false, AFTER_DRAIN = false;
    Fn f;
    __device__ __forceinline__ void operator()(const f32x4 (&acc)[2][2][4][2], const pg8::Unit& u, int wr, int wc, int fr, int fq) const {
#pragma unroll
        for (int ai = 0; ai < 2; ++ai)
#pragma unroll
            for (int m = 0; m < 4; ++m) { const int row = u.pm * 256 + ai * 128 + wr * 64 + m * 16 + fr;
#pragma unroll
                for (int bj = 0; bj < 2; ++bj) f(row, u.pn * 256 + bj * 128 + wc * 32 + 4 * fq, acc[ai][bj][m][0], acc[ai][bj][m][1]); }
    }
};
struct InOrder : pg8::StaticOrder {
    int repn;
    __device__ bool next(int i, pg8::Unit& u) const {
        const int ii = i / repn; const long L = (long)ii * G + c;
        if (L < nwg) return pg8::StaticOrder::next(ii, u);
        const int x = (int)(L - nwg); if (x >= (CT_ / 256) * 2) return false;
        u.pm = T_ / 256 + (x >> 1); u.pn = 4 + (x & 1); return true;
    }
};
struct RepOrder : pg8::StaticOrder {
    int repn;
    __device__ bool next(int i, pg8::Unit& u) const { return pg8::StaticOrder::next(i / repn, u); }
};
template <int PH, class Fn> __device__ __forceinline__ void run_gemm(const Frame& F, const act_t* A, const act_t* Bt, int M, int N, int K, Fn fn) {
    const pg8::Gemm g{A, Bt, M, N, K}; RepOrder S; S.init(M, N, F.G, F.bid); S.repn = (PROBE_PH == PH) ? PROBE_N : 1;
    const EpiFn<Fn> E{fn};
    pg8::gemm_phase<EpiFn<Fn>, RepOrder, true, true>((PG8_LAS unsigned char*)F.lds, g, S, E);
}
__device__ __forceinline__ float fsig(float x) { return __builtin_amdgcn_rcpf(1.0f + __builtin_amdgcn_exp2f(-LOG2E * x)); }
#else
__device__ __forceinline__ float fsig(float x) { return 1.0f / (1.0f + expf(-x)); }
#endif

__device__ __forceinline__ void p0_adaln_item(const Frame& F, int item) {
    float* sc = (float*)F.lds;
    float* part = sc + 9 * 1024;
    __syncthreads();
    for (int e = F.tid; e < 9 * 1024; e += 512) { const int r = e >> 10, kk = e & 1023; const float v = (r < 8) ? F.c[r * DM + kk] : F.c_ctx[kk]; sc[e] = v / (1.0f + expf(-v)); }
    __syncthreads();
    const int col = item * 64 + F.lane, kg = F.wid;
    float a[9];
#pragma unroll
    for (int r = 0; r < 9; ++r) a[r] = 0.f;
    for (int kk = kg * 128; kk < kg * 128 + 128; ++kk) {
        const float w = F.w_ada[(size_t)kk * 6144 + col];
#pragma unroll
        for (int r = 0; r < 9; ++r) a[r] += sc[r * 1024 + kk] * w;
    }
#pragma unroll
    for (int r = 0; r < 9; ++r) part[(kg * 9 + r) * 64 + F.lane] = a[r];
    __syncthreads();
    for (int e = F.tid; e < 9 * 64; e += 512) { const int r = e >> 6, cl = e & 63; float s = F.b_ada[item * 64 + cl];
#pragma unroll
        for (int g = 0; g < 8; ++g) s += part[(g * 9 + r) * 64 + cl];
        F.mod[r * 6144 + item * 64 + cl] = s; }
}
template <class CM> __device__ __forceinline__ void p0_transpose_item(const Frame& F, const float* W, int K, int Nsrc, act_t* dst, int item, int ntn, CM cmap) {
    float* tl = (float*)F.lds;
    const int kb = item / ntn, nb = item % ntn, k0 = kb * 64, n0 = nb * 64;
    __syncthreads();
    { const int n4 = F.tid & 15, kk0 = F.tid >> 4; const int sc = cmap(n0 + 4 * n4);
#pragma unroll
      for (int i = 0; i < 2; ++i) { const int kk = kk0 + 32 * i; const f32x4 v = *(const f32x4*)(W + (size_t)(k0 + kk) * Nsrc + sc);
          tl[kk * 65 + 4 * n4] = v[0]; tl[kk * 65 + 4 * n4 + 1] = v[1]; tl[kk * 65 + 4 * n4 + 2] = v[2]; tl[kk * 65 + 4 * n4 + 3] = v[3]; } }
    __syncthreads();
    { const int k8 = F.tid & 7, n = F.tid >> 3;
      act_t* d = dst + (size_t)(n0 + n) * K + k0 + 8 * k8;
      f32x4 a, b;
#pragma unroll
      for (int i = 0; i < 4; ++i) { a[i] = tl[(8 * k8 + i) * 65 + n]; b[i] = tl[(8 * k8 + 4 + i) * 65 + n]; }
      st4(d, a); st4(d + 4, b); }
}
__device__ __forceinline__ int cmap_in(int n) {
    if (n < 1536 || n >= 2560) return n;
    const int g = (n - 1536) >> 5, e = n & 31;
    return (e < 16) ? (1536 + 16 * g + e) : (2048 + 16 * g + (e - 16));
}
__device__ __forceinline__ void p0_prep(const Frame& F) {
    for (int it = F.bid; it < 96; it += F.G) p0_adaln_item(F, it);
    constexpr int I_IN = 16 * 72, I_OA = 16 * 16, I_OC = 8 * 16, I_OUT = 16 * 16, I_WQ = 16 * 32;
    constexpr int NIT = I_IN + I_OA + I_OC + I_OUT + I_WQ;
    auto ident = [](int n) { return n; };
    for (int it = F.bid; it < NIT; it += F.G) {
        int r = it;
        if (r < I_IN) { p0_transpose_item(F, F.w_in, 1024, INW, F.win_t, r, 72, [](int n) { return cmap_in(n); }); continue; } r -= I_IN;
        if (r < I_OA) { p0_transpose_item(F, F.w_o_attn, 1024, 1024, F.woa_t, r, 16, ident); continue; } r -= I_OA;
        if (r < I_OC) { p0_transpose_item(F, F.w_o_conv, 512, 1024, F.woc_t, r, 16, ident); continue; } r -= I_OC;
        if (r < I_OUT) { p0_transpose_item(F, F.w_out, 1024, 1024, F.wout_t, r, 16, ident); continue; } r -= I_OUT;
        p0_transpose_item(F, F.peer_wq, 1024, PQW, F.wq_t, r, 32, ident);
    }
    for (int e = F.bid * 512 + F.tid; e < 16 * 128 * 128; e += F.G * 512) st_act(F.keys_t + e, F.peer_keys[e]);
    for (int e = F.bid * 512 + F.tid; e < 64 * 16; e += F.G * 512) {
        const int pos = e >> 4, f = e & 15;
        const float freq = powf(10000.0f, -(float)(2 * f) / 32.0f);
        const float ang = (float)pos * freq;
        const double TWO_PI = 6.283185307179586476925286766559;
        double r = (double)ang; r -= TWO_PI * rint(r / TWO_PI);
        const double r2 = r * r;
        double sn = 0.0, cs = 0.0;
        double ts = r, tc = 1.0;
#pragma unroll 1
        for (int n = 0; n < 14; ++n) { sn += ts; cs += tc; ts *= -r2 / (double)((2 * n + 2) * (2 * n + 3)); tc *= -r2 / (double)((2 * n + 1) * (2 * n + 2)); }
        F.rope[e * 2] = (float)cs; F.rope[e * 2 + 1] = (float)sn;
    }
}

__device__ __forceinline__ void p1_norm(const Frame& F) {
    const int gw = F.bid * 8 + F.wid, NGW = F.G * 8;
    for (int r0 = gw * 4; r0 < T_ + CT_; r0 += NGW * 4) {
        const bool isx = r0 < T_;
        const int rr0 = isx ? r0 : r0 - T_;
        const float* src = isx ? F.x + ((size_t)F.b0 * SEQ + rr0) * DM : F.ctx + ((size_t)F.b0 * CTXL + rr0) * DM;
        act_t* dst = isx ? F.hx + (size_t)rr0 * DM : F.hc + (size_t)rr0 * DM;
        const float* mrow = isx ? F.mod + (size_t)(F.b0 + rr0 / SEQ) * 6144 : F.mod + (size_t)8 * 6144;
        f32x4 v[4][4]; float ss[4];
#pragma unroll
        for (int q = 0; q < 4; ++q)
#pragma unroll
            for (int j = 0; j < 4; ++j) v[q][j] = *(const f32x4*)(src + (size_t)q * DM + j * 256 + F.lane * 4);
#pragma unroll
        for (int q = 0; q < 4; ++q) { float s = 0.f;
#pragma unroll
            for (int j = 0; j < 4; ++j) s += v[q][j][0] * v[q][j][0] + v[q][j][1] * v[q][j][1] + v[q][j][2] * v[q][j][2] + v[q][j][3] * v[q][j][3];
            ss[q] = s; }
#pragma unroll
        for (int o = 1; o < 64; o <<= 1) {
#pragma unroll
            for (int q = 0; q < 4; ++q) ss[q] += __shfl_xor(ss[q], o); }
#pragma unroll
        for (int j = 0; j < 4; ++j) { const int d = j * 256 + F.lane * 4;
            const f32x4 g = *(const f32x4*)(F.g_pre_mix + d), sh = *(const f32x4*)(mrow + d), sc = *(const f32x4*)(mrow + 1024 + d);
#pragma unroll
            for (int q = 0; q < 4; ++q) { const float rstd = 1.0f / sqrtf(ss[q] * (1.0f / DM) + EPS);
                f32x4 o;
#pragma unroll
                for (int i = 0; i < 4; ++i) o[i] = (v[q][j][i] * rstd) * g[i] * (1.0f + sc[i]) + sh[i];
                st4(dst + (size_t)q * DM + d, o); } }
    }
}

__device__ __forceinline__ void epi_in(const Frame& F, int r, int c, f32x4 v0, f32x4 v1) {
    const int s = r & (SEQ - 1);
    if (c < 1280) {
        const int axis = (c >> 5) & 1, pos = axis ? (s & 63) : (s >> 6);
        const float* rp = F.rope + (pos * 16 + (c & 15)) * 2;
        const f32x4 cs0 = *(const f32x4*)rp, cs1 = *(const f32x4*)(rp + 4);
        f32x4 o1, o2;
        o1[0] = v0[0] * cs0[0] - v1[0] * cs0[1]; o2[0] = v1[0] * cs0[0] + v0[0] * cs0[1];
        o1[1] = v0[1] * cs0[2] - v1[1] * cs0[3]; o2[1] = v1[1] * cs0[2] + v0[1] * cs0[3];
        o1[2] = v0[2] * cs1[0] - v1[2] * cs1[1]; o2[2] = v1[2] * cs1[0] + v0[2] * cs1[1];
        o1[3] = v0[3] * cs1[2] - v1[3] * cs1[3]; o2[3] = v1[3] * cs1[2] + v0[3] * cs1[3];
        if (c < 1024) { o1 *= QS; o2 *= QS; st4(F.q + (size_t)r * 1024 + c, o1); st4(F.q + (size_t)r * 1024 + c + 16, o2); }
        else { st4(F.k + (size_t)r * 256 + (c - 1024), o1); st4(F.k + (size_t)r * 256 + (c - 1024) + 16, o2); }
    } else if (c < 1536) {
        const int cc = c - 1280, hk = cc >> 6, d = cc & 63, bl = r / SEQ;
        act_t* base = F.vT + ((size_t)(bl * 4 + hk) * 64 + d) * SEQ + s;
#pragma unroll
        for (int i = 0; i < 4; ++i) { st_act(base + (size_t)i * SEQ, v0[i]); st_act(base + (size_t)(16 + i) * SEQ, v1[i]); }
    } else if (c < 2560) {
        const int ch = ((c - 1536) >> 5) * 16 + (c & 15);
        f32x4 o;
#pragma unroll
        for (int i = 0; i < 4; ++i) o[i] = v0[i] * fsig(v1[i]);
        st4(F.u + (size_t)r * 512 + ch, o);
    } else {
        const int g = c - 2560; f32x4 o0, o1;
#pragma unroll
        for (int i = 0; i < 4; ++i) { o0[i] = fsig(v0[i]); o1[i] = fsig(v1[i]); }
        st4(F.sg + (size_t)r * 2048 + g, o0); st4(F.sg + (size_t)r * 2048 + g + 16, o1);
    }
}
__device__ __forceinline__ void epi_ctx(const Frame& F, int r, int c, f32x4 v0, f32x4 v1) {
    if (c < 256) { st4(F.kc + (size_t)r * 256 + c, v0); st4(F.kc + (size_t)r * 256 + c + 16, v1); }
    else { const int cc = c - 256, hk = cc >> 6, d = cc & 63, bl = r / CTXL, sx = r % CTXL;
        act_t* base = F.vTc + ((size_t)(bl * 4 + hk) * 64 + d) * CTXL + sx;
#pragma unroll
        for (int i = 0; i < 4; ++i) { st_act(base + (size_t)i * CTXL, v0[i]); st_act(base + (size_t)(16 + i) * CTXL, v1[i]); } }
}
#if GOLD
__device__ __forceinline__ void p2_inproj(const Frame& F) {
    constexpr int nM = T_ / 128, nN = INW / 128, nMc = CT_ / 128, nNc = 4;
    const int ntile = nM * nN + nMc * nNc;
    for (int t = F.bid; t < ntile; t += F.G) {
        f32x4 acc[2][4]; acc_zero(acc);
        if (t < nM * nN) {
            const int pm = t / nN, pn = t % nN;
            mma_tile(acc, F.lds, F.hx, DM, F.win_t, DM, DM, pm * 128, pn * 128);
            epi_foreach(acc, pm * 128, pn * 128, [&](int r, int c, f32x4 v0, f32x4 v1) { epi_in(F, r, c, v0, v1); });
        } else {
            const int tt = t - nM * nN, pm = tt / nNc, pn = tt % nNc;
            mma_tile(acc, F.lds, F.hc, DM, F.win_t + (size_t)1024 * DM, DM, DM, pm * 128, pn * 128);
            epi_foreach(acc, pm * 128, pn * 128, [&](int r, int c, f32x4 v0, f32x4 v1) { epi_ctx(F, r, c, v0, v1); });
        }
    }
}
#else
__device__ __forceinline__ void p2_inproj(const Frame& F) {
    auto fn = [&](int r, int c, f32x4 v0, f32x4 v1) { if (r < T_) epi_in(F, r, c, v0, v1); else epi_ctx(F, r - T_, c - 1024, v0, v1); };
    const pg8::Gemm g{F.hx, F.win_t, T_ + CT_, INW, DM}; InOrder S; S.init(T_, INW, F.G, F.bid); S.repn = (PROBE_PH == 20) ? PROBE_N : 1;
    const EpiFn<decltype(fn)> E{fn};
    pg8::gemm_phase<EpiFn<decltype(fn)>, InOrder, true, true>((PG8_LAS unsigned char*)F.lds, g, S, E);
}
#endif

#if GOLD
__device__ __forceinline__ void p3_attn(const Frame& F) {
    float* qs = (float*)F.lds + F.wid * 64;
    float* ps = (float*)F.lds + 512 + F.wid * 640;
    const int gw = F.bid * 8 + F.wid, NGW = F.G * 8;
    for (int it = gw; it < T_ * NH; it += NGW) {
        const int r = it / NH, head = it % NH, hk = head >> 2, bl = r / SEQ, s = r % SEQ;
        qs[F.lane] = F.q[(size_t)r * 1024 + head * 64 + F.lane];
        const int lo = (s - 128 < 0) ? 0 : s - 128, hi = (s + 128 > SEQ - 1) ? SEQ - 1 : s + 128, nwin = hi - lo + 1, ntot = nwin + CTXL;
        float mx = -1e30f;
        for (int jj = F.lane; jj < ntot; jj += 64) {
            const float* kr = (jj < nwin) ? F.k + ((size_t)(bl * SEQ + lo + jj)) * 256 + hk * 64 : F.kc + ((size_t)(bl * CTXL + jj - nwin)) * 256 + hk * 64;
            float d = 0.f;
            for (int e = 0; e < 64; e += 4) { const f32x4 kv = *(const f32x4*)(kr + e); d += qs[e] * kv[0] + qs[e + 1] * kv[1] + qs[e + 2] * kv[2] + qs[e + 3] * kv[3]; }
            ps[jj] = d; mx = fmaxf(mx, d);
        }
        mx = wave_max(mx);
        float l = 0.f;
        for (int jj = F.lane; jj < ntot; jj += 64) { const float p = exp2f(ps[jj] - mx); ps[jj] = p; l += p; }
        l = wave_sum(l) + exp2f(F.sink[head] * LOG2E - mx);
        const float* vr = F.vT + ((size_t)(bl * 4 + hk) * 64 + F.lane) * SEQ + lo;
        const float* vc = F.vTc + ((size_t)(bl * 4 + hk) * 64 + F.lane) * CTXL;
        float o = 0.f;
        for (int jj = 0; jj < nwin; ++jj) o += ps[jj] * vr[jj];
        for (int jj = 0; jj < CTXL; ++jj) o += ps[nwin + jj] * vc[jj];
        F.att[(size_t)r * 1024 + head * 64 + F.lane] = o / l;
    }
}
#else
__device__ __forceinline__ void p3_attn(const Frame& F) {
    constexpr int KLD = 72;
    bf16_t* Kt = (bf16_t*)F.lds;
    bf16_t* Vt = (bf16_t*)(F.lds + 64 * KLD * 2);
    const int lane = F.lane, l31 = lane & 31, hi = lane >> 5;
    const int g = F.wid >> 1, half = F.wid & 1;
    constexpr int NUNIT = CH_B * NKV * (SEQ / 128);
    for (int un = F.bid; un < NUNIT; un += F.G) {
        const int nb = un & 15, hk = (un >> 4) & 3, bl = un >> 6;
        const int head = hk * 4 + g;
        const int r0 = bl * SEQ + nb * 128 + half * 64;
        bf16x8 qf[2][4];
#pragma unroll
        for (int qt = 0; qt < 2; ++qt)
#pragma unroll
            for (int s = 0; s < 4; ++s) qf[qt][s] = *(const bf16x8*)(F.q + (size_t)(r0 + qt * 32 + l31) * 1024 + head * 64 + s * 16 + 8 * hi);
        float mrun[2] = {-1e30f, -1e30f}, lrun[2] = {0.f, 0.f};
        f32x16 O[2][2];
#pragma unroll
        for (int a = 0; a < 2; ++a)
#pragma unroll
            for (int b = 0; b < 2; ++b)
#pragma unroll
                for (int r = 0; r < 16; ++r) O[a][b][r] = 0.f;
        for (int tile = 0; tile < 10; ++tile) {
            const bool isctx = tile < 4;
            const int ks = isctx ? tile * 64 : nb * 128 - 128 + 64 * (tile - 4);
            if (!isctx && (ks < 0 || ks >= SEQ)) continue;
            __syncthreads();
            { const int row = F.tid >> 3, ch = F.tid & 7;
              const act_t* ksrc = isctx ? F.kc + ((size_t)(bl * CTXL + ks + row)) * 256 + hk * 64 + ch * 8
                                        : F.k + ((size_t)(bl * SEQ + ks + row)) * 256 + hk * 64 + ch * 8;
              const act_t* vsrc = isctx ? F.vTc + ((size_t)(bl * 4 + hk) * 64 + row) * CTXL + ks + ch * 8
                                        : F.vT + ((size_t)(bl * 4 + hk) * 64 + row) * SEQ + ks + ch * 8;
              *(u32x4*)(Kt + row * KLD + ch * 8) = *(const u32x4*)ksrc;
              *(u32x4*)(Vt + row * KLD + ch * 8) = *(const u32x4*)vsrc; }
            __syncthreads();
            const int j = tile - 4;
            const bool need = isctx || (half == 0 ? (j <= 4) : (j >= 1));
            if (need) {
                f32x16 st[2][2];
#pragma unroll
                for (int a = 0; a < 2; ++a)
#pragma unroll
                    for (int b = 0; b < 2; ++b)
#pragma unroll
                        for (int r = 0; r < 16; ++r) st[a][b][r] = 0.f;
#pragma unroll
                for (int s = 0; s < 4; ++s)
#pragma unroll
                    for (int kt = 0; kt < 2; ++kt) {
                        const bf16x8 a = *(const bf16x8*)(Kt + (kt * 32 + l31) * KLD + s * 16 + 8 * hi);
#pragma unroll
                        for (int qt = 0; qt < 2; ++qt) st[kt][qt] = __builtin_amdgcn_mfma_f32_32x32x16_bf16(a, qf[qt][s], st[kt][qt], 0, 0, 0);
                    }
                if (!isctx) {
#pragma unroll
                    for (int kt = 0; kt < 2; ++kt)
#pragma unroll
                        for (int qt = 0; qt < 2; ++qt) {
                            const int qp = nb * 128 + half * 64 + qt * 32 + l31;
#pragma unroll
                            for (int r = 0; r < 16; ++r) { const int kp = ks + kt * 32 + crow(r, hi); const int dd = qp - kp; if (dd > 128 || dd < -128) st[kt][qt][r] = -1e30f; }
                        }
                }
                bf16x8 pf[2][2][2];
#pragma unroll
                for (int qt = 0; qt < 2; ++qt) {
                    float mx = -1e30f;
#pragma unroll
                    for (int kt = 0; kt < 2; ++kt)
#pragma unroll
                        for (int r = 0; r < 16; ++r) mx = fmaxf(mx, st[kt][qt][r]);
                    mx = fmaxf(mx, __shfl_xor(mx, 32));
                    const float mn = fmaxf(mrun[qt], mx);
                    const float alpha = __builtin_amdgcn_exp2f(mrun[qt] - mn);
                    mrun[qt] = mn; lrun[qt] *= alpha;
#pragma unroll
                    for (int dt = 0; dt < 2; ++dt)
#pragma unroll
                        for (int r = 0; r < 16; ++r) O[dt][qt][r] *= alpha;
                    float ls = 0.f;
#pragma unroll
                    for (int kt = 0; kt < 2; ++kt) {
                        float p[16];
#pragma unroll
                        for (int r = 0; r < 16; ++r) { p[r] = __builtin_amdgcn_exp2f(st[kt][qt][r] - mn); ls += p[r]; }
#pragma unroll
                        for (int s2 = 0; s2 < 2; ++s2) {
                            u32x4 w;
                            w[0] = pk2(p[8 * s2 + 0], p[8 * s2 + 1]); w[1] = pk2(p[8 * s2 + 2], p[8 * s2 + 3]);
                            w[2] = pk2(p[8 * s2 + 4], p[8 * s2 + 5]); w[3] = pk2(p[8 * s2 + 6], p[8 * s2 + 7]);
                            pf[kt][s2][qt] = __builtin_bit_cast(bf16x8, w);
                        }
                    }
                    lrun[qt] += ls;
                }
#pragma unroll
                for (int kt = 0; kt < 2; ++kt)
#pragma unroll
                    for (int s2 = 0; s2 < 2; ++s2)
#pragma unroll
                        for (int dt = 0; dt < 2; ++dt) {
                            const bf16_t* vp = Vt + (dt * 32 + l31) * KLD + kt * 32 + s2 * 16 + 4 * hi;
                            const s16x4 lo = *(const s16x4*)vp, hh = *(const s16x4*)(vp + 8);
                            const bf16x8 a = (bf16x8){lo[0], lo[1], lo[2], lo[3], hh[0], hh[1], hh[2], hh[3]};
#pragma unroll
                            for (int qt = 0; qt < 2; ++qt) O[dt][qt] = __builtin_amdgcn_mfma_f32_32x32x16_bf16(a, pf[kt][s2][qt], O[dt][qt], 0, 0, 0);
                        }
            }
        }
        const float sk = F.sink[head] * LOG2E;
#pragma unroll
        for (int qt = 0; qt < 2; ++qt) {
            float lt = lrun[qt] + __shfl_xor(lrun[qt], 32);
            lt += __builtin_amdgcn_exp2f(sk - mrun[qt]);
            const float inv = 1.0f / lt;
            act_t* orow = F.att + (size_t)(r0 + qt * 32 + l31) * 1024 + head * 64;
#pragma unroll
            for (int dt = 0; dt < 2; ++dt)
#pragma unroll
                for (int g4 = 0; g4 < 4; ++g4) {
                    f32x4 o; o[0] = O[dt][qt][4 * g4] * inv; o[1] = O[dt][qt][4 * g4 + 1] * inv; o[2] = O[dt][qt][4 * g4 + 2] * inv; o[3] = O[dt][qt][4 * g4 + 3] * inv;
                    st4(orow + dt * 32 + 8 * g4 + 4 * hi, o);
                }
        }
    }
}
#endif

#if GOLD
constexpr int CTK = 32;
#else
constexpr int CTK = 64;
#endif
__device__ __forceinline__ void p3_conv(const Frame& F) {
    act_t* ub = (act_t*)F.lds;
    float* yb = (float*)(F.lds + (size_t)(CTK + 30) * 512 * AS);
    static_assert((CTK + 30) * 512 * AS + 8 * 512 * 4 <= LDS_MISC, "conv LDS");
    const int c = F.tid;
    float w[CONV_W];
#pragma unroll
    for (int i = 0; i < CONV_W; ++i) w[i] = F.conv_dw[i * CONV_CH + c];
    const float bias = F.conv_dw_b[c];
    constexpr int NT = T_ / CTK;
    for (int t = F.bid; t < NT; t += F.G) {
        const int r0 = t * CTK, bl = r0 / SEQ, s0 = r0 % SEQ;
        __syncthreads();
        constexpr int CPRW = 512 * AS / 16;
        for (int e = F.tid; e < (CTK + 30) * CPRW; e += 512) {
            const int rr = e / CPRW, ch = e % CPRW, sp = s0 + rr - 15;
            u32x4 v = (u32x4){0u, 0u, 0u, 0u};
            if (sp >= 0 && sp < SEQ) v = *(const u32x4*)((const unsigned char*)(F.u + (size_t)(bl * SEQ + sp) * 512) + ch * 16);
            *(u32x4*)((unsigned char*)ub + (size_t)rr * 512 * AS + ch * 16) = v;
        }
        __syncthreads();
        for (int chunk = 0; chunk < CTK / 8; ++chunk) {
#pragma unroll 1
            for (int tt = 0; tt < 8; ++tt) {
                const int tk = chunk * 8 + tt;
                float a = 0.f;
#pragma unroll
                for (int i = 0; i < CONV_W; ++i) a += ld_act(ub + (size_t)(tk + i) * 512 + c) * w[i];
                yb[tt * 512 + c] = a + bias;
            }
            __syncthreads();
            {
                const int tk = chunk * 8 + F.wid;
                float y[8];
                const f32x4 y0 = *(const f32x4*)(yb + F.wid * 512 + F.lane * 8), y1 = *(const f32x4*)(yb + F.wid * 512 + F.lane * 8 + 4);
                y[0] = y0[0]; y[1] = y0[1]; y[2] = y0[2]; y[3] = y0[3]; y[4] = y1[0]; y[5] = y1[1]; y[6] = y1[2]; y[7] = y1[3];
                float s = 0.f;
#pragma unroll
                for (int i = 0; i < 8; ++i) s += y[i];
                const float mean = wave_sum(s) * (1.0f / CONV_CH);
                float q = 0.f;
#pragma unroll
                for (int i = 0; i < 8; ++i) { y[i] -= mean; q += y[i] * y[i]; }
                const float rstd = 1.0f / sqrtf(wave_sum(q) * (1.0f / CONV_CH) + EPS);
                f32x4 o0, o1;
#pragma unroll
                for (int i = 0; i < 8; ++i) { const int ch = F.lane * 8 + i; const float z = y[i] * rstd * F.conv_ln_g[ch] + F.conv_ln_b[ch]; const float o = z * fsig(z); if (i < 4) o0[i] = o; else o1[i - 4] = o; }
                act_t* dst = F.cact + (size_t)(r0 + tk) * 512 + F.lane * 8;
                st4(dst, o0); st4(dst + 4, o1);
            }
            __syncthreads();
        }
    }
}

#if GOLD
__device__ __forceinline__ void p4_merge(const Frame& F) {
    constexpr int nM = T_ / 128, nN = 8;
    for (int t = F.bid; t < nM * nN; t += F.G) {
        const int pm = t / nN, pn = t % nN;
        f32x4 accA[2][4], accC[2][4]; acc_zero(accA); acc_zero(accC);
        mma_tile(accA, F.lds, F.att, 1024, F.woa_t, 1024, 1024, pm * 128, pn * 128);
        mma_tile(accC, F.lds, F.cact, 512, F.woc_t, 512, 512, pm * 128, pn * 128);
        const int lane = F.lane, wm = F.wid >> 1, wn = F.wid & 1, fr = lane & 15, fq = lane >> 4;
#pragma unroll
        for (int mi = 0; mi < 2; ++mi)
#pragma unroll
            for (int ni = 0; ni < 4; ++ni) {
                const int r = pm * 128 + wm * 32 + mi * 16 + fr, c = pn * 128 + wn * 64 + ni * 16 + 4 * fq;
                const f32x4 ga = ld4(F.sg + (size_t)r * 2048 + c), gc = ld4(F.sg + (size_t)r * 2048 + 1024 + c);
                st4(F.m + (size_t)r * 1024 + c, ga * accA[mi][ni] + gc * accC[mi][ni]);
            }
    }
}
__device__ __forceinline__ void p5_out(const Frame& F) {
    constexpr int nM = T_ / 128, nN = 8;
    for (int t = F.bid; t < nM * nN; t += F.G) {
        const int pm = t / nN, pn = t % nN;
        f32x4 acc[2][4]; acc_zero(acc);
        mma_tile(acc, F.lds, F.m, 1024, F.wout_t, 1024, 1024, pm * 128, pn * 128);
        const int lane = F.lane, wm = F.wid >> 1, wn = F.wid & 1, fr = lane & 15, fq = lane >> 4;
#pragma unroll
        for (int mi = 0; mi < 2; ++mi)
#pragma unroll
            for (int ni = 0; ni < 4; ++ni) {
                const int r = pm * 128 + wm * 32 + mi * 16 + fr, c = pn * 128 + wn * 64 + ni * 16 + 4 * fq;
                *(f32x4*)(F.mixed + (size_t)r * 1024 + c) = acc[mi][ni];
            }
    }
}
#else
__device__ __forceinline__ void p4_merge(const Frame& F) {
    run_gemm<22>(F, F.att, F.woa_t, T_, 1024, 1024, [&](int r, int c, f32x4 v0, f32x4 v1) {
        const act_t* gp = F.sg + (size_t)r * 2048 + c; act_t* mp = F.m + (size_t)r * 1024 + c;
        st4(mp, ld4(gp) * v0); st4(mp + 16, ld4(gp + 16) * v1); });
    run_gemm<-2>(F, F.cact, F.woc_t, T_, 1024, 512, [&](int r, int c, f32x4 v0, f32x4 v1) {
        const act_t* gp = F.sg + (size_t)r * 2048 + 1024 + c; act_t* mp = F.m + (size_t)r * 1024 + c;
        st4(mp, ld4(mp) + ld4(gp) * v0); st4(mp + 16, ld4(mp + 16) + ld4(gp + 16) * v1); });
}
__device__ __forceinline__ void p5_out(const Frame& F) {
    run_gemm<23>(F, F.m, F.wout_t, T_, 1024, 1024, [&](int r, int c, f32x4 v0, f32x4 v1) {
        float* p = F.mixed + (size_t)r * 1024 + c; *(f32x4*)p = v0; *(f32x4*)(p + 16) = v1; });
}
#endif
__device__ __forceinline__ void p6_rows(const Frame& F) {
    const int gw = F.bid * 8 + F.wid, NGW = F.G * 8;
    for (int r0 = gw * 2; r0 < T_; r0 += NGW * 2) {
        const float* mrow = F.mod + (size_t)(F.b0 + r0 / SEQ) * 6144;
        const float* xr = F.x + ((size_t)F.b0 * SEQ + r0) * DM;
        float* outr = F.out + ((size_t)F.b0 * SEQ + r0) * DM;
        f32x4 mv[2][4], xv[2][4]; float ss[2], s1[2];
#pragma unroll
        for (int q = 0; q < 2; ++q)
#pragma unroll
            for (int j = 0; j < 4; ++j) { mv[q][j] = *(const f32x4*)(F.mixed + (size_t)(r0 + q) * 1024 + j * 256 + F.lane * 4); xv[q][j] = *(const f32x4*)(xr + (size_t)q * DM + j * 256 + F.lane * 4); }
#pragma unroll
        for (int q = 0; q < 2; ++q) { float s = 0.f;
#pragma unroll
            for (int j = 0; j < 4; ++j) s += mv[q][j][0] * mv[q][j][0] + mv[q][j][1] * mv[q][j][1] + mv[q][j][2] * mv[q][j][2] + mv[q][j][3] * mv[q][j][3];
            ss[q] = s; }
#pragma unroll
        for (int o = 1; o < 64; o <<= 1) { ss[0] += __shfl_xor(ss[0], o); ss[1] += __shfl_xor(ss[1], o); }
        s1[0] = 0.f; s1[1] = 0.f;
#pragma unroll
        for (int j = 0; j < 4; ++j) { const int d = j * 256 + F.lane * 4;
            const f32x4 g = *(const f32x4*)(F.g_post_mix + d), gt = *(const f32x4*)(mrow + 2048 + d);
#pragma unroll
            for (int q = 0; q < 2; ++q) { const float rstd = 1.0f / sqrtf(ss[q] * (1.0f / DM) + EPS);
#pragma unroll
                for (int i = 0; i < 4; ++i) { xv[q][j][i] = xv[q][j][i] + gt[i] * ((mv[q][j][i] * rstd) * g[i]); s1[q] += xv[q][j][i] * xv[q][j][i]; }
                *(f32x4*)(outr + (size_t)q * DM + d) = xv[q][j]; } }
#pragma unroll
        for (int o = 1; o < 64; o <<= 1) { s1[0] += __shfl_xor(s1[0], o); s1[1] += __shfl_xor(s1[1], o); }
#pragma unroll
        for (int j = 0; j < 4; ++j) { const int d = j * 256 + F.lane * 4;
            const f32x4 g = *(const f32x4*)(F.g_pre_ffn + d), sh = *(const f32x4*)(mrow + 3072 + d), sc = *(const f32x4*)(mrow + 4096 + d);
#pragma unroll
            for (int q = 0; q < 2; ++q) { const float rstd1 = 1.0f / sqrtf(s1[q] * (1.0f / DM) + EPS);
                f32x4 o;
#pragma unroll
                for (int i = 0; i < 4; ++i) o[i] = (xv[q][j][i] * rstd1) * g[i] * (1.0f + sc[i]) + sh[i];
                st4(F.h2 + (size_t)(r0 + q) * 1024 + d, o); } }
    }
}
__device__ __forceinline__ void p7_wq(const Frame& F) {
#if GOLD
    constexpr int nM = T_ / 128, nN = PQW / 128;
    for (int t = F.bid; t < nM * nN; t += F.G) {
        const int pm = t / nN, pn = t % nN;
        f32x4 acc[2][4]; acc_zero(acc);
        mma_tile(acc, F.lds, F.h2, 1024, F.wq_t, 1024, 1024, pm * 128, pn * 128);
        const int lane = F.lane, wm = F.wid >> 1, wn = F.wid & 1, fr = lane & 15, fq = lane >> 4;
#pragma unroll
        for (int mi = 0; mi < 2; ++mi)
#pragma unroll
            for (int ni = 0; ni < 4; ++ni) {
                const int r = pm * 128 + wm * 32 + mi * 16 + fr, c = pn * 128 + wn * 64 + ni * 16 + 4 * fq;
                st4(F.pq + (size_t)r * PQW + c, acc[mi][ni]);
            }
    }
#else
    run_gemm<24>(F, F.h2, F.wq_t, T_, PQW, 1024, [&](int r, int c, f32x4 v0, f32x4 v1) {
        act_t* p = F.pq + (size_t)r * PQW + c; st4(p, v0); st4(p + 16, v1); });
#endif
}
__device__ __forceinline__ int f2sort(float f) { const int b = __float_as_int(f); return b ^ ((b >> 31) & 0x7fffffff); }
__device__ __forceinline__ float sort2f(int k) { return __int_as_float(k ^ ((k >> 31) & 0x7fffffff)); }
__device__ __forceinline__ void p8_partial(const Frame& F, int (&L)[16], int t, int hp, int l31, int hi) {
#pragma unroll
    for (int i = 0; i < 16; ++i) L[i] = (int)0x80000000;
    const act_t* qrow = F.pq + (size_t)t * PQW + hp * 128;
#pragma unroll 1
    for (int kt = 0; kt < 4; ++kt) {
        const act_t* krow = F.keys_t + ((size_t)hp * 128 + kt * 32 + l31) * 128;
        f32x16 sc;
#pragma unroll
        for (int r = 0; r < 16; ++r) sc[r] = 0.f;
#if GOLD
        for (int s = 0; s < 64; ++s) sc = __builtin_amdgcn_mfma_f32_32x32x2f32(krow[2 * s + hi], qrow[2 * s + hi], sc, 0, 0, 0);
#else
#pragma unroll
        for (int s = 0; s < 8; ++s) { const bf16x8 a = *(const bf16x8*)(krow + 16 * s + 8 * hi), b = *(const bf16x8*)(qrow + 16 * s + 8 * hi);
            sc = __builtin_amdgcn_mfma_f32_32x32x16_bf16(a, b, sc, 0, 0, 0); }
#endif
#pragma unroll
        for (int r = 0; r < 16; ++r) {
            int v = (f2sort(sc[r]) & ~127) | (127 - (kt * 32 + crow(r, hi)));
#pragma unroll
            for (int i = 0; i < 16; ++i) { const int h_ = max(L[i], v); v = min(L[i], v); L[i] = h_; }
        }
    }
}
#if !GOLD
__device__ __forceinline__ void p8_convert_tables(const Frame& F) {
    const int gw = F.bid * 8 + F.wid, NGW = F.G * 8;
    for (size_t e = (size_t)gw * 64 + F.lane; e < (size_t)NEXP * 1024 / 16; e += (size_t)NGW * 64) {
        u32x4 wa, wb;
#pragma unroll
        for (int j = 0; j < 4; ++j) { const f32x4 a = *(const f32x4*)(F.peer_u + e * 16 + 4 * j), b = *(const f32x4*)(F.peer_v + e * 16 + 4 * j);
            int pa = 0, pb = 0;
            pa = __builtin_amdgcn_cvt_pk_fp8_f32(a[0] * 256.0f, a[1] * 256.0f, pa, false); pa = __builtin_amdgcn_cvt_pk_fp8_f32(a[2] * 256.0f, a[3] * 256.0f, pa, true);
            pb = __builtin_amdgcn_cvt_pk_fp8_f32(b[0] * 256.0f, b[1] * 256.0f, pb, false); pb = __builtin_amdgcn_cvt_pk_fp8_f32(b[2] * 256.0f, b[3] * 256.0f, pb, true);
            wa[j] = (unsigned)pa; wb[j] = (unsigned)pb; }
        *(u32x4*)(F.pu8 + e * 16) = wa; *(u32x4*)(F.pv8 + e * 16) = wb;
    }
}
#endif
__device__ __forceinline__ void p8_topk(const Frame& F) {
    const int gw = F.bid * 8 + F.wid, NGW = F.G * 8, lane = F.lane, l31 = lane & 31, hi = lane >> 5;
#if !GOLD
    if (F.wid >= 4) p8_convert_tables(F);
#endif
    for (int task = gw; task < (T_ / 32) * 4; task += NGW) {
        const int tb = task >> 2, h0 = (task & 3) * 2, t = tb * 32 + l31;
        int a[16], b[16];
        {
            int P0[16], P1[16];
            p8_partial(F, P0, t, 2 * h0, l31, hi); p8_partial(F, P1, t, 2 * h0 + 2, l31, hi);
#pragma unroll
            for (int i = 0; i < 16; ++i) { const auto rr = __builtin_amdgcn_permlane32_swap((unsigned)P0[i], (unsigned)P1[i], false, false); a[i] = (int)rr[0]; P1[i] = (int)rr[1]; }
#pragma unroll
            for (int e = 0; e < 16; ++e) { int v = P1[e];
#pragma unroll
                for (int i = 0; i < 16; ++i) { const int h_ = max(a[i], v); v = min(a[i], v); a[i] = h_; } }
        }
        {
            int P0[16], P1[16];
            p8_partial(F, P0, t, 2 * h0 + 1, l31, hi); p8_partial(F, P1, t, 2 * h0 + 3, l31, hi);
#pragma unroll
            for (int i = 0; i < 16; ++i) { const auto rr = __builtin_amdgcn_permlane32_swap((unsigned)P0[i], (unsigned)P1[i], false, false); b[i] = (int)rr[0]; P1[i] = (int)rr[1]; }
#pragma unroll
            for (int e = 0; e < 16; ++e) { int v = P1[e];
#pragma unroll
                for (int i = 0; i < 16; ++i) { const int h_ = max(b[i], v); v = min(b[i], v); b[i] = h_; } }
        }
        float fa[16], fb[16]; int ia[16], ib[16];
#pragma unroll
        for (int i = 0; i < 16; ++i) { fa[i] = sort2f(a[i]); fb[i] = sort2f(b[i]); ia[i] = (127 - (a[i] & 127)) * 128; ib[i] = 127 - (b[i] & 127); }
        int c[16], cp[16];
#pragma unroll
        for (int j = 0; j < 16; ++j) { c[j] = f2sort(fa[0] + fb[j]); cp[j] = ia[0] + ib[j]; }
#pragma unroll
        for (int i = 1; i < 16; ++i)
#pragma unroll
            for (int j = 0; j < 16 / (i + 1); ++j) {
                int v = f2sort(fa[i] + fb[j]), pv = ia[i] + ib[j];
#pragma unroll
                for (int s = (i + 1) * (j + 1) - 1; s < 16; ++s) { const bool gt = v > c[s]; const int nk = gt ? v : c[s], lo = gt ? c[s] : v, np = gt ? pv : cp[s], lp = gt ? cp[s] : pv; c[s] = nk; cp[s] = np; v = lo; pv = lp; }
            }
        float e[16], sum = 0.f; const float c0 = sort2f(c[0]);
#pragma unroll
        for (int i = 0; i < 16; ++i) { e[i] = exp2f((sort2f(c[i]) - c0) * LOG2E); sum += e[i]; }
        const float inv = 1.0f / sum;
        const size_t ob = (size_t)t * 128 + (h0 + hi) * 16;
#pragma unroll
        for (int i4 = 0; i4 < 16; i4 += 4) {
            *(u32x4*)(F.pei + ob + i4) = (u32x4){(unsigned)cp[i4], (unsigned)cp[i4 + 1], (unsigned)cp[i4 + 2], (unsigned)cp[i4 + 3]};
            *(f32x4*)(F.peg + ob + i4) = (f32x4){e[i4] * inv, e[i4 + 1] * inv, e[i4 + 2] * inv, e[i4 + 3] * inv};
        }
    }
#if !GOLD
    if (F.wid < 4) p8_convert_tables(F);
#endif
}
#if GOLD
__device__ __forceinline__ void p10_experts(const Frame& F) {
    const int gw = F.bid * 8 + F.wid, NGW = F.G * 8, lane = F.lane;
    constexpr int EPL = 4, NLD = 4;
    const float* TU = F.peer_u; const float* TV = F.peer_v;
    for (int r = gw; r < T_; r += NGW) {
        float hv[NLD][EPL], acc[NLD][EPL];
#pragma unroll
        for (int j = 0; j < NLD; ++j)
#pragma unroll
            for (int i = 0; i < EPL; ++i) { hv[j][i] = ld_act(F.h2 + (size_t)r * 1024 + j * 64 * EPL + lane * EPL + i); acc[j][i] = 0.f; }
        const int id0 = F.pei[(size_t)r * 128 + lane], id1 = F.pei[(size_t)r * 128 + 64 + lane];
        const float g0 = F.peg[(size_t)r * 128 + lane], g1 = F.peg[(size_t)r * 128 + 64 + lane];
        for (int e = 0; e < 128; ++e) {
            const int idx = __shfl((e < 64) ? id0 : id1, e & 63);
            const float gt = __shfl((e < 64) ? g0 : g1, e & 63);
            float uv[NLD][EPL], vv[NLD][EPL];
#pragma unroll
            for (int j = 0; j < NLD; ++j) {
                const f32x4 a = *(const f32x4*)(TU + (size_t)idx * 1024 + j * 256 + lane * 4), b = *(const f32x4*)(TV + (size_t)idx * 1024 + j * 256 + lane * 4);
#pragma unroll
                for (int i = 0; i < 4; ++i) { uv[j][i] = a[i]; vv[j][i] = b[i]; }
            }
            float d = 0.f;
#pragma unroll
            for (int j = 0; j < NLD; ++j)
#pragma unroll
                for (int i = 0; i < EPL; ++i) d += uv[j][i] * hv[j][i];
            d = wave_sum(d);
            const float act = 0.5f * d * (1.0f + erff(d * 0.70710678118654752f));
            const float wgt = gt * act;
#pragma unroll
            for (int j = 0; j < NLD; ++j)
#pragma unroll
                for (int i = 0; i < EPL; ++i) acc[j][i] += wgt * vv[j][i];
        }
        float ss = 0.f;
#pragma unroll
        for (int j = 0; j < NLD; ++j)
#pragma unroll
            for (int i = 0; i < EPL; ++i) ss += acc[j][i] * acc[j][i];
        const float rstd = 1.0f / sqrtf(wave_sum(ss) * (1.0f / DM) + EPS);
        const float* mrow = F.mod + (size_t)(F.b0 + r / SEQ) * 6144 + 5120;
        float* outr = F.out + ((size_t)F.b0 * SEQ + r) * DM;
#pragma unroll
        for (int j = 0; j < NLD; ++j)
#pragma unroll
            for (int i4 = 0; i4 < EPL; i4 += 4) { const int d0 = j * 64 * EPL + lane * EPL + i4;
                const f32x4 x1 = *(const f32x4*)(outr + d0), g = *(const f32x4*)(F.g_post_ffn + d0), gt2 = *(const f32x4*)(mrow + d0);
                f32x4 o;
#pragma unroll
                for (int i = 0; i < 4; ++i) o[i] = x1[i] + gt2[i] * ((acc[j][i4 + i] * rstd) * g[i]);
                *(f32x4*)(outr + d0) = o; }
    }
}
#else
#define P10_LOAD(U, V, b) do { _Pragma("unroll") for (int e_ = 0; e_ < 4; ++e_) { const int ent_ = 4 * (b) + e_; \
        const int idx_ = __builtin_amdgcn_readlane(((b) < 16) ? id0 : id1, ent_ & 63); \
        U[e_] = *(const u32x4*)(TU + (size_t)idx_ * 1024 + lane * 16); V[e_] = *(const u32x4*)(TV + (size_t)idx_ * 1024 + lane * 16); } } while (0)
#define P10_COMPUTE(U, V, b) do { float d_[4]; \
        _Pragma("unroll") for (int e_ = 0; e_ < 4; ++e_) { float s_ = 0.f; \
            _Pragma("unroll") for (int w_ = 0; w_ < 4; ++w_) { const f32x2 lo_ = __builtin_amdgcn_cvt_pk_f32_fp8((int)U[e_][w_], false), hi_ = __builtin_amdgcn_cvt_pk_f32_fp8((int)U[e_][w_], true); \
                s_ += lo_[0] * hv[4 * w_] + lo_[1] * hv[4 * w_ + 1] + hi_[0] * hv[4 * w_ + 2] + hi_[1] * hv[4 * w_ + 3]; } d_[e_] = s_; } \
        float d2_[2], d1_; \
        _Pragma("unroll") for (int e_ = 0; e_ < 2; ++e_) { const float k_ = b5 ? d_[e_ + 2] : d_[e_], s_ = b5 ? d_[e_] : d_[e_ + 2]; d2_[e_] = k_ + __shfl_xor(s_, 32); } \
        { const float k_ = b4 ? d2_[1] : d2_[0], s_ = b4 ? d2_[0] : d2_[1]; d1_ = k_ + __shfl_xor(s_, 16); } \
        d1_ += __shfl_xor(d1_, 8); d1_ += __shfl_xor(d1_, 4); d1_ += __shfl_xor(d1_, 2); d1_ += __shfl_xor(d1_, 1); \
        const float dot_ = d1_ * (1.0f / 256.0f); \
        const float act_ = 0.5f * dot_ * (1.0f + erff(dot_ * 0.70710678118654752f)); \
        const float gate_ = __shfl(((b) < 16) ? g0 : g1, (4 * (b) + eid) & 63); \
        const float wl_ = gate_ * act_ * (1.0f / 256.0f); \
        _Pragma("unroll") for (int e_ = 0; e_ < 4; ++e_) { \
            const float we_ = __uint_as_float(__builtin_amdgcn_readlane(__float_as_uint(wl_), (e_ & 1) * 16 + ((e_ >> 1) & 1) * 32)); \
            _Pragma("unroll") for (int w_ = 0; w_ < 4; ++w_) { const f32x2 lo_ = __builtin_amdgcn_cvt_pk_f32_fp8((int)V[e_][w_], false), hi_ = __builtin_amdgcn_cvt_pk_f32_fp8((int)V[e_][w_], true); \
                acc[4 * w_] += we_ * lo_[0]; acc[4 * w_ + 1] += we_ * lo_[1]; acc[4 * w_ + 2] += we_ * hi_[0]; acc[4 * w_ + 3] += we_ * hi_[1]; } } } while (0)
__device__ __forceinline__ void p10_experts(const Frame& F) {
    const int gw = F.bid * 8 + F.wid, NGW = F.G * 8, lane = F.lane;
    const unsigned char* TU = F.pu8; const unsigned char* TV = F.pv8;
    const bool b5 = (lane & 32) != 0, b4 = (lane & 16) != 0;
    const int eid = ((lane >> 4) & 1) | (((lane >> 5) & 1) << 1);
    for (int r = gw; r < T_; r += NGW) {
        float hv[16], acc[16];
        { const act_t* hp = F.h2 + (size_t)r * 1024 + lane * 16;
#pragma unroll
          for (int j = 0; j < 4; ++j) { const f32x4 t = ld4(hp + 4 * j); hv[4 * j] = t[0]; hv[4 * j + 1] = t[1]; hv[4 * j + 2] = t[2]; hv[4 * j + 3] = t[3]; } }
#pragma unroll
        for (int i = 0; i < 16; ++i) acc[i] = 0.f;
        const int id0 = F.pei[(size_t)r * 128 + lane], id1 = F.pei[(size_t)r * 128 + 64 + lane];
        const float g0 = F.peg[(size_t)r * 128 + lane], g1 = F.peg[(size_t)r * 128 + 64 + lane];
        u32x4 ua[4], va[4], ub[4], vb[4];
        for (int rep_ = 0; rep_ < ((PROBE_PH == 9) ? PROBE_N : 1); ++rep_) {
#pragma unroll
        for (int i = 0; i < 16; ++i) acc[i] = 0.f;
        P10_LOAD(ua, va, 0);
        for (int bb = 0; bb < 32; bb += 2) {
            P10_LOAD(ub, vb, bb + 1);
            P10_COMPUTE(ua, va, bb);
            if (bb + 2 < 32) P10_LOAD(ua, va, bb + 2);
            P10_COMPUTE(ub, vb, bb + 1);
        }
        }
        float ss = 0.f;
#pragma unroll
        for (int i = 0; i < 16; ++i) ss += acc[i] * acc[i];
        const float rstd = 1.0f / sqrtf(wave_sum(ss) * (1.0f / DM) + EPS);
        const float* mrow = F.mod + (size_t)(F.b0 + r / SEQ) * 6144 + 5120;
        float* outr = F.out + ((size_t)F.b0 * SEQ + r) * DM;
#pragma unroll
        for (int j = 0; j < 4; ++j) { const int d0 = lane * 16 + 4 * j;
            const f32x4 x1 = *(const f32x4*)(outr + d0), g = *(const f32x4*)(F.g_post_ffn + d0), gt2 = *(const f32x4*)(mrow + d0);
            f32x4 o;
#pragma unroll
            for (int i = 0; i < 4; ++i) o[i] = x1[i] + gt2[i] * ((acc[4 * j + i] * rstd) * g[i]);
            *(f32x4*)(outr + d0) = o; }
    }
}
#endif

__global__ void __launch_bounds__(512, 2) fwd_kernel(Args a) {
    extern __shared__ __attribute__((aligned(16))) unsigned char lds[];
    Frame F;
    F.lds = lds; F.tid = threadIdx.x; F.lane = F.tid & 63; F.wid = __builtin_amdgcn_readfirstlane(F.tid >> 6); F.G = gridDim.x; F.bid = blockIdx.x; F.b0 = a.b0;
    F.x = a.in[0]; F.c = a.in[1]; F.ctx = a.in[2]; F.c_ctx = a.in[3]; F.w_ada = a.in[4]; F.b_ada = a.in[5]; F.g_pre_mix = a.in[6]; F.g_post_mix = a.in[7];
    F.g_pre_ffn = a.in[8]; F.g_post_ffn = a.in[9]; F.w_in = a.in[10]; F.sink = a.in[11]; F.w_o_attn = a.in[12]; F.conv_dw = a.in[13]; F.conv_dw_b = a.in[14];
    F.conv_ln_g = a.in[15]; F.conv_ln_b = a.in[16]; F.w_o_conv = a.in[17]; F.w_out = a.in[18]; F.peer_wq = a.in[19]; F.peer_keys = a.in[20]; F.peer_u = a.in[21]; F.peer_v = a.in[22];
    F.out = a.out;
    unsigned char* ws = a.ws;
    F.mod = (float*)(ws + WS_MOD); F.rope = (float*)(ws + WS_ROPE);
    F.win_t = (act_t*)(ws + WS_WIN); F.woa_t = (act_t*)(ws + WS_WOA); F.woc_t = (act_t*)(ws + WS_WOC); F.wout_t = (act_t*)(ws + WS_WOUT); F.wq_t = (act_t*)(ws + WS_WQ); F.keys_t = (act_t*)(ws + WS_KEYS);
    F.q = (act_t*)(ws + O_Q); F.k = (act_t*)(ws + O_K); F.vT = (act_t*)(ws + O_VT); F.u = (act_t*)(ws + O_U); F.sg = (act_t*)(ws + O_SG); F.kc = (act_t*)(ws + O_KC); F.vTc = (act_t*)(ws + O_VTC);
    F.att = (act_t*)(ws + O_ATT); F.cact = (act_t*)(ws + O_CACT); F.hx = (act_t*)(ws + O_HX); F.hc = (act_t*)(ws + O_HC); F.m = (act_t*)(ws + O_M); F.h2 = (act_t*)(ws + O_H2); F.pq = (act_t*)(ws + O_PQ);
    F.mixed = (float*)(ws + O_MIXED); F.topv = (float*)(ws + O_TOPV); F.topi = (int*)(ws + O_TOPI); F.pei = (int*)(ws + O_PEI); F.peg = (float*)(ws + O_PEG);
    F.pu8 = ws + O_PU; F.pv8 = ws + O_PV;

    volatile LAS unsigned* misc = (volatile LAS unsigned*)(LAS unsigned char*)(lds + LDS_MISC);
    if (F.tid < 64) misc[F.tid] = 0u;
    __syncthreads();
    const int lo = a.ph_lo, hi = a.ph_hi;
    XcdBarrier bar; bar.bar = (unsigned*)(ws + WS_CTL); bar.x = 0; bar.st = misc;
    if (hi - lo > 1) bar = xcd_barrier_post((unsigned*)(ws + WS_CTL), misc);
#define IN(k) (lo <= (k) && (k) < hi)
#define SEAM(k) do { if (IN(k) && IN((k) + 1)) xcd_barrier(bar); } while (0)
#define REP(k) for (int rep_ = 0; rep_ < ((PROBE_PH == (k)) ? PROBE_N : 1); ++rep_)
    if (IN(0)) { REP(0) { p0_prep(F); __syncthreads(); } } SEAM(0);
    if (IN(1)) { REP(1) { p1_norm(F); } } SEAM(1);
    if (IN(2)) { REP(2) { p2_inproj(F); } } SEAM(2);
    if (IN(3)) { REP(3) { p3_attn(F); __syncthreads(); } REP(11) { p3_conv(F); __syncthreads(); } } SEAM(3);
    if (IN(4)) { REP(4) { p4_merge(F); } } SEAM(4);
    if (IN(5)) { REP(5) { p5_out(F); } } SEAM(5);
    if (IN(6)) { REP(6) { p6_rows(F); } } SEAM(6);
    if (IN(7)) { REP(7) { p7_wq(F); } } SEAM(7);
    if (IN(8)) { REP(8) { p8_topk(F); } } SEAM(8);
#if PROBE_PH == 30
    for (int i_ = 0; i_ < 10; ++i_) xcd_barrier(bar);
#endif
    if (IN(9)) { p10_experts(F); }
#undef REP
#undef IN
#undef SEAM
}

extern "C" void kernel_launch(void* const* d_in, const int* in_sizes, int n_in, void* d_out, int out_size, void* d_ws, size_t ws_size, hipStream_t stream) {
    static int grid = 0;
    if (grid == 0) {
        if (n_in != 23 || ws_size < WS_END) { fprintf(stderr, "kernel_launch: need 23 inputs and %zu B of workspace (got %d, %zu)\n", (size_t)WS_END, n_in, ws_size); grid = -1; return; }
        int dev = 0, cus = 0;
        if (hipGetDevice(&dev) != hipSuccess || hipDeviceGetAttribute(&cus, hipDeviceAttributeMultiprocessorCount, dev) != hipSuccess) { grid = -1; return; }
        if (hipFuncSetAttribute((const void*)fwd_kernel, hipFuncAttributeMaxDynamicSharedMemorySize, LDS_BYTES) != hipSuccess) { fprintf(stderr, "kernel_launch: hipFuncSetAttribute failed\n"); grid = -1; return; }
        grid = cus;
    }
    if (grid < 0) return;
    (void)hipMemsetAsync((char*)d_ws + WS_CTL, 0, CTL_BYTES, stream);
    Args a{};
    for (int i = 0; i < 23; ++i) a.in[i] = (const float*)d_in[i];
    a.out = (float*)d_out; a.ws = (unsigned char*)d_ws;
#if ONE_LAUNCH
    a.ph_lo = 0; a.ph_hi = NPHASE; a.b0 = 0;
    hipLaunchKernelGGL(fwd_kernel, dim3(grid), dim3(512), LDS_BYTES, stream, a);
#else
    a.ph_lo = 0; a.ph_hi = 1; a.b0 = 0;
    hipLaunchKernelGGL(fwd_kernel, dim3(grid), dim3(512), LDS_BYTES, stream, a);
    for (int b0 = 0; b0 < BATCH; b0 += CH_B)
        for (int ph = 1; ph < NPHASE; ++ph) { a.ph_lo = ph; a.ph_hi = ph + 1; a.b0 = b0; hipLaunchKernelGGL(fwd_kernel, dim3(grid), dim3(512), LDS_BYTES, stream, a); }
#endif
}
```

```cpp
#include <hip/hip_runtime.h>
#include <cstdint>
#include <cstdio>

#ifndef GOLD
#define GOLD 0
#endif
#ifndef PROBE_PH
#define PROBE_PH -1
#endif
#ifndef PROBE_N
#define PROBE_N 2
#endif
#ifndef ONE_LAUNCH
#define ONE_LAUNCH 1
#endif

typedef unsigned short bf16_t;
typedef short bf16x8 __attribute__((ext_vector_type(8)));
typedef short s16x4 __attribute__((ext_vector_type(4)));
typedef float f32x4 __attribute__((ext_vector_type(4)));
typedef float f32x16 __attribute__((ext_vector_type(16)));
typedef unsigned u32x2 __attribute__((ext_vector_type(2)));
typedef unsigned u32x4 __attribute__((ext_vector_type(4)));
typedef float f32x2 __attribute__((ext_vector_type(2)));

#if GOLD
typedef float act_t;
#else
typedef bf16_t act_t;
#endif
constexpr int AS = sizeof(act_t);

constexpr int DM = 1024, BATCH = 8, SEQ = 2048, CTXL = 256, NH = 16, NKV = 4, HD = 64;
constexpr int INW = 4608, PQW = 2048, NEXP = 16384;
constexpr int CONV_CH = 512, CONV_W = 31;
constexpr float EPS = 1e-6f;
constexpr float LOG2E = 1.4426950408889634f;
constexpr float QS = 0.125f * LOG2E;
#if GOLD
constexpr int CH_B = 1;
#else
constexpr int CH_B = 8;
#endif
constexpr int T_ = CH_B * SEQ;
constexpr int CT_ = CH_B * CTXL;
constexpr int NPHASE = 10;

constexpr size_t MiB = 1u << 20;
constexpr size_t WS_CTL = 0, CTL_BYTES = 1 * MiB;
constexpr size_t WS_MOD = 512 * 1024;
constexpr size_t WS_ROPE = 1 * MiB;
constexpr size_t WS_WIN = 2 * MiB;
constexpr size_t WS_WOA = 22 * MiB;
constexpr size_t WS_WOC = 26 * MiB;
constexpr size_t WS_WOUT = 28 * MiB;
constexpr size_t WS_WQ = 32 * MiB;
constexpr size_t WS_KEYS = 40 * MiB;
constexpr size_t AR = 42 * MiB;
constexpr size_t A0 = AR;
constexpr size_t O_Q = A0;
constexpr size_t O_K = O_Q + (size_t)T_ * 1024 * AS;
constexpr size_t O_VT = O_K + (size_t)T_ * 256 * AS;
constexpr size_t O_U = O_VT + (size_t)T_ * 256 * AS;
constexpr size_t O_SG = O_U + (size_t)T_ * 512 * AS;
constexpr size_t O_KC = O_SG + (size_t)T_ * 2048 * AS;
constexpr size_t O_VTC = O_KC + (size_t)CT_ * 256 * AS;
constexpr size_t A0_END = O_VTC + (size_t)CT_ * 256 * AS;
constexpr size_t O_MIXED = A0;
constexpr size_t O_PQ = A0 + (size_t)T_ * 4096;
constexpr size_t O_TOPV = A0;
constexpr size_t O_TOPI = A0 + (size_t)T_ * 1024;
constexpr size_t O_PV = A0 + 32 * MiB;
constexpr size_t A1 = A0_END;
constexpr size_t O_ATT = A1;
constexpr size_t O_CACT = O_ATT + (size_t)T_ * 1024 * AS;
constexpr size_t A1_END = O_CACT + (size_t)T_ * 512 * AS;
constexpr size_t O_HX = A1;
constexpr size_t O_HC = A1 + (size_t)T_ * 1024 * AS;
constexpr size_t O_PU = A1;
constexpr size_t O_PEI = O_CACT;
constexpr size_t O_PEG = O_CACT + (size_t)T_ * 512;
constexpr size_t A2 = A1_END;
constexpr size_t O_M = A2;
constexpr size_t O_H2 = A2;
constexpr size_t WS_END = A2 + (size_t)T_ * 1024 * AS;
static_assert(O_PQ + (size_t)T_ * 2048 * AS <= A0_END, "pq overlay");
static_assert(O_TOPI + (size_t)T_ * 1024 <= O_PQ, "topk overlay");
static_assert(GOLD || (O_PV >= O_TOPI + (size_t)T_ * 1024 && O_PV + 32 * MiB <= O_PQ), "pv overlay");
static_assert(GOLD || (O_PU + 32 * MiB <= O_PEI), "pu overlay");
static_assert(O_PEG + (size_t)T_ * 512 <= A1_END, "pe overlay");
static_assert(O_HC + (size_t)CT_ * 1024 * AS <= A1_END, "hc overlay");

constexpr int LDS_BYTES = 147456;
constexpr int LDS_MISC = LDS_BYTES - 256;

__device__ __forceinline__ float bf2f(bf16_t h) { return __uint_as_float((unsigned)h << 16); }
__device__ __forceinline__ unsigned f2bf(float f) { unsigned u = __float_as_uint(f); return (u + 0x7fffu + ((u >> 16) & 1u)) >> 16; }
__device__ __forceinline__ unsigned pk2(float lo, float hi) { return f2bf(lo) | (f2bf(hi) << 16); }
#if GOLD
__device__ __forceinline__ float ld_act(const act_t* p) { return *p; }
__device__ __forceinline__ void st_act(act_t* p, float v) { *p = v; }
__device__ __forceinline__ f32x4 ld4(const act_t* p) { return *(const f32x4*)p; }
__device__ __forceinline__ void st4(act_t* p, f32x4 v) { *(f32x4*)p = v; }
#else
__device__ __forceinline__ float ld_act(const act_t* p) { return bf2f(*p); }
__device__ __forceinline__ void st_act(act_t* p, float v) { *p = (bf16_t)f2bf(v); }
__device__ __forceinline__ f32x4 ld4(const act_t* p) { u32x2 w = *(const u32x2*)p; f32x4 r; r[0] = __uint_as_float(w[0] << 16); r[1] = __uint_as_float(w[0] & 0xffff0000u); r[2] = __uint_as_float(w[1] << 16); r[3] = __uint_as_float(w[1] & 0xffff0000u); return r; }
__device__ __forceinline__ void st4(act_t* p, f32x4 v) { u32x2 w; w[0] = pk2(v[0], v[1]); w[1] = pk2(v[2], v[3]); *(u32x2*)p = w; }
#endif
__device__ __forceinline__ float wave_sum(float v) {
#pragma unroll
    for (int o = 1; o < 64; o <<= 1) v += __shfl_xor(v, o);
    return v;
}
__device__ __forceinline__ float wave_max(float v) {
#pragma unroll
    for (int o = 1; o < 64; o <<= 1) v = fmaxf(v, __shfl_xor(v, o));
    return v;
}
__device__ __forceinline__ float sigmoidf_(float x) { return 1.0f / (1.0f + expf(-x)); }
__device__ __forceinline__ int crow(int r, int hi) { return (r & 3) + 8 * (r >> 2) + 4 * hi; }

#define LAS __attribute__((address_space(3)))
#define XB_TMO      128
#define XB_XCNT(j)  (256  + 64 * (j))
#define XB_XSUB(j)  (1280 + 64 * (j))
#define XB_XGEN(j)  (2304 + 64 * (j))
#define XB_TOP      3328
#define XB_TOPGEN   3392
#define XCD_BAR_WORDS 3456
#define XB_SPIN_CAP (1u << 18)
__device__ __forceinline__ unsigned xb_ld(unsigned* p)              { return __hip_atomic_load(p, __ATOMIC_RELAXED, __HIP_MEMORY_SCOPE_AGENT); }
__device__ __forceinline__ unsigned xb_add(unsigned* p, unsigned v) { return __hip_atomic_fetch_add(p, v, __ATOMIC_RELAXED, __HIP_MEMORY_SCOPE_AGENT); }
__device__ __forceinline__ unsigned xb_xcc_id() { return (unsigned)__builtin_amdgcn_s_getreg((3 << 11) | 20) & 0xFu; }
#define XB_SPIN(cond, bar) do { unsigned _sp = 0; while (cond) { __builtin_amdgcn_s_sleep(1); \
    if ((++_sp & 255u) == 0u) { if (xb_ld(&(bar)[XB_TMO])) break; if (_sp > XB_SPIN_CAP) { atomicAdd(&(bar)[XB_TMO], 1u); break; } } } } while (0)
struct XcdBarrier { unsigned* bar; unsigned x; volatile LAS unsigned* st; };
__device__ __forceinline__ XcdBarrier xcd_barrier_post(unsigned* bar, volatile LAS unsigned* st) {
    XcdBarrier b; b.bar = bar; b.x = xb_xcc_id(); b.st = st;
    if (threadIdx.x == 0) (void)xb_add(&bar[XB_XCNT(b.x)], 1u);
    return b;
}
__device__ __forceinline__ void xcd_barrier_complete(unsigned* bar, unsigned x, unsigned& nloc, unsigned& nx) {
    const unsigned G = gridDim.x * gridDim.y * gridDim.z;
    unsigned sum, cnt, mine, sp = 0u;
    for (;;) {
        sum = 0u; cnt = 0u; mine = 0u;
#pragma unroll
        for (unsigned j = 0; j < 16; ++j) { const unsigned c = xb_ld(&bar[XB_XCNT(j)]); sum += c; cnt += (c > 0u) ? 1u : 0u; mine = (j == x) ? c : mine; }
        if (sum == G) break;
        __builtin_amdgcn_s_sleep(1);
        if ((++sp & 255u) == 0u) { if (xb_ld(&bar[XB_TMO])) break; if (sp > XB_SPIN_CAP) { atomicAdd(&bar[XB_TMO], 1u); break; } }
    }
    nloc = mine > 0u ? mine : 1u; nx = cnt > 0u ? cnt : 1u;
}
__device__ __forceinline__ void xcd_barrier(const XcdBarrier& b) {
    asm volatile("s_waitcnt vmcnt(0)" ::: "memory");
    __syncthreads();
    if (threadIdx.x == 0) {
        unsigned* bar = b.bar;
        __builtin_amdgcn_s_waitcnt(0);
        unsigned nloc = b.st[0], nx = b.st[1];
        if (nloc == 0u) { xcd_barrier_complete(bar, b.x, nloc, nx); b.st[0] = nloc; b.st[1] = nx; }
        const unsigned old = xb_add(&bar[XB_XSUB(b.x)], 1u);
        const unsigned gen = old / nloc;
        if (old + 1u == (gen + 1u) * nloc) {
            __builtin_amdgcn_fence(__ATOMIC_RELEASE, "agent");
            asm volatile("s_waitcnt vmcnt(0)" ::: "memory");
            const unsigned og = xb_add(&bar[XB_TOP], 1u);
            const unsigned tg = og / nx;
            if (og + 1u == (tg + 1u) * nx) xb_add(&bar[XB_TOPGEN], 1u);
            else XB_SPIN(xb_ld(&bar[XB_TOPGEN]) == tg, bar);
            __builtin_amdgcn_fence(__ATOMIC_ACQUIRE, "agent");
            xb_add(&bar[XB_XGEN(b.x)], 1u);
            asm volatile("s_waitcnt vmcnt(0)" ::: "memory");
        } else {
            XB_SPIN(xb_ld(&bar[XB_XGEN(b.x)]) == gen, bar);
            __builtin_amdgcn_fence(__ATOMIC_ACQUIRE, "agent");
            asm volatile("s_waitcnt vmcnt(0)" ::: "memory");
        }
    }
    __syncthreads();
}

struct Args { const float* in[23]; float* out; unsigned char* ws; int ph_lo, ph_hi, b0, pad; };

struct Frame {
    unsigned char* lds;
    int tid, lane, wid, G, bid;
    int b0;
    const float *x, *c, *ctx, *c_ctx, *w_ada, *b_ada, *g_pre_mix, *g_post_mix, *g_pre_ffn, *g_post_ffn, *w_in, *sink, *w_o_attn,
        *conv_dw, *conv_dw_b, *conv_ln_g, *conv_ln_b, *w_o_conv, *w_out, *peer_wq, *peer_keys, *peer_u, *peer_v;
    float* out;
    float* mod; float* rope;
    act_t *win_t, *woa_t, *woc_t, *wout_t, *wq_t, *keys_t;
    act_t *q, *k, *vT, *u, *sg, *kc, *vTc, *att, *cact, *hx, *hc, *m, *h2, *pq;
    float *mixed, *topv, *peg; int *topi, *pei;
    unsigned char *pu8, *pv8;
};

constexpr int BK = 32;
#if GOLD
constexpr int LDT = 36;
#else
constexpr int LDT = 40;
#endif
constexpr int TILE_LDS = 128 * LDT * AS;
constexpr int GEMM_LDS = 2 * TILE_LDS;

__device__ __forceinline__ void acc_zero(f32x4 (&acc)[2][4]) {
#pragma unroll
    for (int i = 0; i < 2; ++i)
#pragma unroll
        for (int j = 0; j < 4; ++j) acc[i][j] = (f32x4){0.f, 0.f, 0.f, 0.f};
}

__device__ __forceinline__ void mma_tile(f32x4 (&acc)[2][4], unsigned char* lds, const act_t* __restrict__ A, int lda,
                                         const act_t* __restrict__ Bt, int ldb, int K, int m0, int n0) {
    const int tid = threadIdx.x, lane = tid & 63, wid = tid >> 6, wm = wid >> 1, wn = wid & 1, fr = lane & 15, fq = lane >> 4;
    act_t* As = (act_t*)lds; act_t* Bs = (act_t*)(lds + TILE_LDS);
    constexpr int EPC = 16 / AS, CPR = BK / EPC, NCH = 128 * CPR / 512;
    u32x4 ra[NCH], rb[NCH];
#pragma unroll
    for (int i = 0; i < NCH; ++i) { const int cidx = tid + 512 * i, row = cidx / CPR, ch = cidx % CPR;
        ra[i] = *(const u32x4*)(A + (size_t)(m0 + row) * lda + ch * EPC);
        rb[i] = *(const u32x4*)(Bt + (size_t)(n0 + row) * ldb + ch * EPC); }
    const int nk = K / BK;
    for (int kt = 0; kt < nk; ++kt) {
        __syncthreads();
#pragma unroll
        for (int i = 0; i < NCH; ++i) { const int cidx = tid + 512 * i, row = cidx / CPR, ch = cidx % CPR;
            *(u32x4*)(As + row * LDT + ch * EPC) = ra[i];
            *(u32x4*)(Bs + row * LDT + ch * EPC) = rb[i]; }
        __syncthreads();
        if (kt + 1 < nk) {
            const int k1 = (kt + 1) * BK;
#pragma unroll
            for (int i = 0; i < NCH; ++i) { const int cidx = tid + 512 * i, row = cidx / CPR, ch = cidx % CPR;
                ra[i] = *(const u32x4*)(A + (size_t)(m0 + row) * lda + k1 + ch * EPC);
                rb[i] = *(const u32x4*)(Bt + (size_t)(n0 + row) * ldb + k1 + ch * EPC); }
        }
#if GOLD
        f32x4 a4[2][2], b4[4][2];
#pragma unroll
        for (int mi = 0; mi < 2; ++mi)
#pragma unroll
            for (int g = 0; g < 2; ++g) a4[mi][g] = *(const f32x4*)(As + (wm * 32 + mi * 16 + fr) * LDT + 16 * g + 4 * fq);
#pragma unroll
        for (int ni = 0; ni < 4; ++ni)
#pragma unroll
            for (int g = 0; g < 2; ++g) b4[ni][g] = *(const f32x4*)(Bs + (wn * 64 + ni * 16 + fr) * LDT + 16 * g + 4 * fq);
#pragma unroll
        for (int mi = 0; mi < 2; ++mi)
#pragma unroll
            for (int ni = 0; ni < 4; ++ni)
#pragma unroll
                for (int g = 0; g < 2; ++g)
#pragma unroll
                    for (int j = 0; j < 4; ++j) acc[mi][ni] = __builtin_amdgcn_mfma_f32_16x16x4f32(b4[ni][g][j], a4[mi][g][j], acc[mi][ni], 0, 0, 0);
#else
        bf16x8 af[2], bfr[4];
#pragma unroll
        for (int mi = 0; mi < 2; ++mi) af[mi] = *(const bf16x8*)(As + (wm * 32 + mi * 16 + fr) * LDT + fq * 8);
#pragma unroll
        for (int ni = 0; ni < 4; ++ni) bfr[ni] = *(const bf16x8*)(Bs + (wn * 64 + ni * 16 + fr) * LDT + fq * 8);
#pragma unroll
        for (int mi = 0; mi < 2; ++mi)
#pragma unroll
            for (int ni = 0; ni < 4; ++ni) acc[mi][ni] = __builtin_amdgcn_mfma_f32_16x16x32_bf16(bfr[ni], af[mi], acc[mi][ni], 0, 0, 0);
#endif
    }
}
template <class F> __device__ __forceinline__ void epi_foreach(const f32x4 (&acc)[2][4], int m0, int n0, F f) {
    const int tid = threadIdx.x, lane = tid & 63, wid = tid >> 6, wm = wid >> 1, wn = wid & 1, fr = lane & 15, fq = lane >> 4;
#pragma unroll
    for (int mi = 0; mi < 2; ++mi)
#pragma unroll
        for (int gp = 0; gp < 2; ++gp) f(m0 + wm * 32 + mi * 16 + fr, n0 + wn * 64 + gp * 32 + 4 * fq, acc[mi][2 * gp], acc[mi][2 * gp + 1]);
}


#if !GOLD
namespace pg8 {
#define PG8_LAS __attribute__((address_space(3)))
typedef unsigned short bf16_t;
typedef short bf16x8 __attribute__((ext_vector_type(8)));
typedef float f32x4 __attribute__((ext_vector_type(4)));
typedef unsigned u32x4 __attribute__((ext_vector_type(4)));
constexpr int BM = 256, BK = 64, HALF = 128, HTB = HALF * BK * 2  , STAGE_BYTES = 8 * HTB, NXCD = 8, WGM = 8;

__host__ __device__ __forceinline__ int lds_byte(int r, int c) { const int st = (r >> 4) * 2 + (c >> 5), rr = r & 15, cc = c & 31, ob = rr * 64 + cc * 2; return st * 1024 + (ob ^ (((ob >> 9) & 1) << 5)); }
__host__ __device__ __forceinline__ void stage_rc(int b, int& R, int& C) { const int st = b / 1024, sb = b % 1024, swz = sb ^ (((sb >> 9) & 1) << 5); R = (st >> 1) * 16 + swz / 64; C = (st & 1) * 32 + (swz % 64) / 2; }
__host__ __device__ __forceinline__ int perm32(int rho) { const int n = rho >> 4, i = rho & 15; return 8 * (i >> 2) + 4 * n + (i & 3); }

struct Unit { int pm, pn; };
struct Gemm { const bf16_t* A; const bf16_t* Bt; int M, N, K; };

struct StaticOrder {
    int nM, nN, nwg, G, c;
    __host__ __device__ void init(int M, int N, int G_, int c_) { nM = M / BM; nN = N / BM; nwg = nM * nN; G = G_; c = c_; }
    __host__ __device__ bool next(int i, Unit& u) const {
        const long L = (long)i * G + c; if (L >= nwg) return false;
        int wgid = (int)L; { const int q = nwg / NXCD, r = nwg % NXCD, xcd = wgid % NXCD, off = wgid / NXCD; wgid = (xcd < r ? xcd * (q + 1) : r * (q + 1) + (xcd - r) * q) + off; }
        const int nig = WGM * nN, gid = wgid / nig, fm = gid * WGM, gsz = (nM - fm) < WGM ? (nM - fm) : WGM;
        u.pm = fm + ((wgid % nig) % gsz); u.pn = (wgid % nig) / gsz; return true;
    }
    __device__ __forceinline__ void a_ready(const Unit&) const {}
    __device__ __forceinline__ void done(const Unit&) const {}
};
template <class Epi, class Sched, bool ALIGN_EPI = false, bool SP2 = false>
__device__ __forceinline__ void gemm_phase(PG8_LAS unsigned char* lds, const Gemm g, const Sched& S, const Epi& E) {
    const int tid = threadIdx.x, wid = __builtin_amdgcn_readfirstlane(tid >> 6), lane = tid & 63, wr = wid >> 2, wc = wid & 3, fr = lane & 15, fq = lane >> 4;
    const int K = g.K, nt = K / BK;
    unsigned voffA[2], voffB[2];
#pragma unroll
    for (int i = 0; i < 2; ++i) { int R, C; stage_rc(tid * 16 + i * 8192, R, C); const int Rb = Epi::PERM ? ((R & ~31) + perm32(R & 31)) : R;
        voffA[i] = (unsigned)(R * K + C) * 2u; voffB[i] = (unsigned)(Rb * K + C) * 2u; }
    const size_t kstep = (size_t)(BK * 2);
    const size_t hstep = (size_t)HALF * K * 2;
    const size_t tstep = 2 * hstep;
    const unsigned ldsw = (unsigned)wid * 1024u;
    const int aoff = lds_byte(wr * 64 + fr, fq * 8), boff = lds_byte(wc * 32 + fr, fq * 8);
#define PG8_SA(b, h) (((b) * 2 + (h)) * HTB)
#define PG8_SB(b, h) ((4 + (b) * 2 + (h)) * HTB)
#define PG8_STAGE(bufoff, gbase, voff) do { _Pragma("unroll") for (int _i = 0; _i < 2; ++_i) \
        __builtin_amdgcn_global_load_lds((const unsigned*)((const char*)(gbase) + (voff)[_i]), (PG8_LAS unsigned*)(lds + (bufoff) + ldsw + _i * 8192), 16, 0, 0); } while (0)
#define PG8_LDA(dst, b, h) do { _Pragma("unroll") for (int m = 0; m < 4; ++m) _Pragma("unroll") for (int k = 0; k < 2; ++k) dst[m][k] = *(const PG8_LAS bf16x8*)(lds + PG8_SA(b, h) + aoff + m * 2048 + k * 1024); } while (0)
#define PG8_LDB(dst, b, h) do { _Pragma("unroll") for (int n = 0; n < 2; ++n) _Pragma("unroll") for (int k = 0; k < 2; ++k) dst[n][k] = *(const PG8_LAS bf16x8*)(lds + PG8_SB(b, h) + boff + n * 2048 + k * 1024); } while (0)
#define PG8_MMA(ai, bj, At, Bt) do { __builtin_amdgcn_s_setprio(1); _Pragma("unroll") for (int m = 0; m < 4; ++m) _Pragma("unroll") for (int n = 0; n < 2; ++n) _Pragma("unroll") for (int k = 0; k < 2; ++k) \
        acc[ai][bj][m][n] = __builtin_amdgcn_mfma_f32_16x16x32_bf16(Bt[n][k], At[m][k], acc[ai][bj][m][n], 0, 0, 0); __builtin_amdgcn_s_setprio(0); } while (0)
#define PG8_WAIT_V(n) asm volatile("s_waitcnt vmcnt(" #n ")" ::: "memory")
#define PG8_WAIT_L(n) asm volatile("s_waitcnt lgkmcnt(" #n ")" ::: "memory")
#define PG8_BAR __builtin_amdgcn_s_barrier()
#define PG8_SCHED __builtin_amdgcn_sched_barrier(0)
    Unit cur, nxt; int ui = 0;
    if (!S.next(0, cur)) return;
    f32x4 acc[2][2][4][2];
#pragma unroll
    for (int a = 0; a < 2; ++a)
#pragma unroll
        for (int b = 0; b < 2; ++b)
#pragma unroll
            for (int m = 0; m < 4; ++m)
#pragma unroll
                for (int n = 0; n < 2; ++n) acc[a][b][m][n] = (f32x4){0.f, 0.f, 0.f, 0.f};
    bf16x8 At[4][2], B0[2][2], B1[2][2];
    const char* cA = (const char*)g.A + (size_t)cur.pm * tstep; const char* cB = (const char*)g.Bt + (size_t)cur.pn * tstep;
    S.a_ready(cur);
    if constexpr (SP2) {
        PG8_STAGE(PG8_SB(0, 0), cB, voffB); PG8_STAGE(PG8_SB(0, 1), cB + hstep, voffB); PG8_STAGE(PG8_SA(0, 0), cA, voffA); PG8_STAGE(PG8_SA(0, 1), cA + hstep, voffA);
        if (wr == 1) PG8_BAR;
        PG8_WAIT_V(2); PG8_BAR;
        PG8_STAGE(PG8_SB(1, 0), cB + kstep, voffB); PG8_STAGE(PG8_SA(1, 0), cA + kstep, voffA); PG8_STAGE(PG8_SB(1, 1), cB + hstep + kstep, voffB);
        PG8_WAIT_V(6); PG8_BAR;
    } else {
        PG8_STAGE(PG8_SB(0, 0), cB, voffB); PG8_STAGE(PG8_SA(0, 0), cA, voffA); PG8_STAGE(PG8_SB(0, 1), cB + hstep, voffB); PG8_STAGE(PG8_SA(0, 1), cA + hstep, voffA);
        if (wr == 1) PG8_BAR;
        PG8_WAIT_V(4); PG8_BAR;
        PG8_STAGE(PG8_SB(1, 0), cB + kstep, voffB); PG8_STAGE(PG8_SA(1, 0), cA + kstep, voffA); PG8_STAGE(PG8_SB(1, 1), cB + hstep + kstep, voffB);
        PG8_WAIT_V(6); PG8_BAR;
    }
    for (;;) {
        const bool has_next = S.next(ui + 1, nxt);
        const char* nA = has_next ? (const char*)g.A + (size_t)nxt.pm * tstep : cA; const char* nB = has_next ? (const char*)g.Bt + (size_t)nxt.pn * tstep : cB;
        for (int t = 0; t < nt; t += 2) {
            const bool last = (t == nt - 2);
            const char* a1 = cA + (size_t)(t + 1) * kstep;
            const char* a2 = last ? nA : cA + (size_t)(t + 2) * kstep; const char* b2 = last ? nB : cB + (size_t)(t + 2) * kstep;
            const char* a3 = a2 + kstep; const char* b3 = b2 + kstep;
            if (last && has_next) S.a_ready(nxt);
            if constexpr (SP2) {
            PG8_LDB(B0, 0, 0); PG8_LDB(B1, 0, 1); PG8_SCHED; PG8_LDA(At, 0, 0); PG8_STAGE(PG8_SA(1, 1), a1 + hstep, voffA);
            PG8_WAIT_V(8); PG8_WAIT_L(0); PG8_BAR; PG8_MMA(0, 0, At, B0); PG8_MMA(0, 1, At, B1); PG8_BAR; PG8_SCHED;
            PG8_LDA(At, 0, 1); PG8_STAGE(PG8_SB(0, 0), b2, voffB); PG8_STAGE(PG8_SB(0, 1), b2 + hstep, voffB); PG8_STAGE(PG8_SA(0, 0), a2, voffA);
            PG8_WAIT_V(8); PG8_WAIT_L(0); PG8_BAR; PG8_MMA(1, 0, At, B0); PG8_MMA(1, 1, At, B1); PG8_BAR; PG8_SCHED;
            PG8_LDB(B0, 1, 0); PG8_LDB(B1, 1, 1); PG8_SCHED; PG8_LDA(At, 1, 0); PG8_STAGE(PG8_SA(0, 1), a2 + hstep, voffA);
            PG8_WAIT_V(8); PG8_WAIT_L(0); PG8_BAR; PG8_MMA(0, 0, At, B0); PG8_MMA(0, 1, At, B1); PG8_BAR; PG8_SCHED;
            PG8_LDA(At, 1, 1); PG8_STAGE(PG8_SB(1, 0), b3, voffB); PG8_STAGE(PG8_SB(1, 1), b3 + hstep, voffB); PG8_STAGE(PG8_SA(1, 0), a3, voffA);
            PG8_WAIT_V(8); PG8_WAIT_L(0); PG8_BAR; PG8_MMA(1, 0, At, B0); PG8_MMA(1, 1, At, B1); PG8_BAR; PG8_SCHED;
            } else {
            PG8_LDB(B0, 0, 0); PG8_SCHED; PG8_LDA(At, 0, 0); PG8_STAGE(PG8_SA(1, 1), a1 + hstep, voffA);
            PG8_WAIT_L(8); PG8_BAR; PG8_WAIT_L(0); PG8_MMA(0, 0, At, B0); PG8_BAR; PG8_SCHED;
            PG8_LDB(B1, 0, 1); PG8_STAGE(PG8_SB(0, 0), b2, voffB);
            PG8_BAR; PG8_WAIT_L(0); PG8_MMA(0, 1, At, B1); PG8_BAR;
            PG8_LDA(At, 0, 1); PG8_STAGE(PG8_SA(0, 0), a2, voffA);
            PG8_BAR; PG8_WAIT_L(0); PG8_MMA(1, 0, At, B0); PG8_BAR; PG8_SCHED;
            PG8_STAGE(PG8_SB(0, 1), b2 + hstep, voffB);
            PG8_WAIT_V(6); PG8_BAR; PG8_MMA(1, 1, At, B1); PG8_BAR;
            PG8_LDB(B0, 1, 0); PG8_SCHED; PG8_LDA(At, 1, 0); PG8_STAGE(PG8_SA(0, 1), a2 + hstep, voffA);
            PG8_WAIT_L(8); PG8_BAR; PG8_WAIT_L(0); PG8_MMA(0, 0, At, B0); PG8_BAR; PG8_SCHED;
            PG8_LDB(B1, 1, 1); PG8_STAGE(PG8_SB(1, 0), b3, voffB);
            PG8_BAR; PG8_WAIT_L(0); PG8_MMA(0, 1, At, B1); PG8_BAR;
            PG8_LDA(At, 1, 1); PG8_STAGE(PG8_SA(1, 0), a3, voffA);
            PG8_BAR; PG8_WAIT_L(0); PG8_MMA(1, 0, At, B0); PG8_BAR; PG8_SCHED;
            PG8_STAGE(PG8_SB(1, 1), b3 + hstep, voffB);
            PG8_WAIT_V(6); PG8_BAR; PG8_MMA(1, 1, At, B1); PG8_BAR;
            }
        }
        if constexpr (ALIGN_EPI) { if (wr == 0) PG8_BAR; }
        if constexpr (!Epi::AFTER_DRAIN) { E(acc, cur, wr, wc, fr, fq); S.done(cur); }
        if (!has_next) break;
#pragma unroll
        for (int a = 0; a < 2; ++a)
#pragma unroll
            for (int b = 0; b < 2; ++b)
#pragma unroll
                for (int m = 0; m < 4; ++m)
#pragma unroll
                    for (int n = 0; n < 2; ++n) acc[a][b][m][n] = (f32x4){0.f, 0.f, 0.f, 0.f};
        cur = nxt; cA = nA; cB = nB; ++ui;
        if constexpr (ALIGN_EPI) { if (wr == 1) PG8_BAR; }
    }
    PG8_WAIT_V(0);
    if constexpr (!ALIGN_EPI) { if (wr == 0) PG8_BAR; }
    PG8_BAR;
    if constexpr (Epi::AFTER_DRAIN) { E.fused(acc, cur, wr, wc, fr, fq, lds, wid, lane); S.done(cur); }
#undef PG8_SA
#undef PG8_SB
#undef PG8_STAGE
#undef PG8_LDA
#undef PG8_LDB
#undef PG8_MMA
#undef PG8_WAIT_V
#undef PG8_WAIT_L
#undef PG8_BAR
#undef PG8_SCHED
}
}

template <class Fn> struct EpiFn {
    static constexpr bool PERM = false, AFTER_DRAIN = false;
    Fn f;
    __device__ __forceinline__ void operator()(const f32x4 (&acc)[2][2][4][2], const pg8::Unit& u, int wr, int wc, int fr, int fq) const {
#pragma unroll
        for (int ai = 0; ai < 2; ++ai)
#pragma unroll
            for (int m = 0; m < 4; ++m) { const int row = u.pm * 256 + ai * 128 + wr * 64 + m * 16 + fr;
#pragma unroll
                for (int bj = 0; bj < 2; ++bj) f(row, u.pn * 256 + bj * 128 + wc * 32 + 4 * fq, acc[ai][bj][m][0], acc[ai][bj][m][1]); }
    }
};
struct InOrder : pg8::StaticOrder {
    int repn;
    __device__ bool next(int i, pg8::Unit& u) const {
        const int ii = i / repn; const long L = (long)ii * G + c;
        if (L < nwg) return pg8::StaticOrder::next(ii, u);
        const int x = (int)(L - nwg); if (x >= (CT_ / 256) * 2) return false;
        u.pm = T_ / 256 + (x >> 1); u.pn = 4 + (x & 1); return true;
    }
};
struct RepOrder : pg8::StaticOrder {
    int repn;
    __device__ bool next(int i, pg8::Unit& u) const { return pg8::StaticOrder::next(i / repn, u); }
};
template <int PH, class Fn> __device__ __forceinline__ void run_gemm(const Frame& F, const act_t* A, const act_t* Bt, int M, int N, int K, Fn fn) {
    const pg8::Gemm g{A, Bt, M, N, K}; RepOrder S; S.init(M, N, F.G, F.bid); S.repn = (PROBE_PH == PH) ? PROBE_N : 1;
    const EpiFn<Fn> E{fn};
    pg8::gemm_phase<EpiFn<Fn>, RepOrder, true, true>((PG8_LAS unsigned char*)F.lds, g, S, E);
}
__device__ __forceinline__ float fsig(float x) { return __builtin_amdgcn_rcpf(1.0f + __builtin_amdgcn_exp2f(-LOG2E * x)); }
#else
__device__ __forceinline__ float fsig(float x) { return 1.0f / (1.0f + expf(-x)); }
#endif

__device__ __forceinline__ void p0_adaln_item(const Frame& F, int item) {
    float* sc = (float*)F.lds;
    float* part = sc + 9 * 1024;
    __syncthreads();
    for (int e = F.tid; e < 9 * 1024; e += 512) { const int r = e >> 10, kk = e & 1023; const float v = (r < 8) ? F.c[r * DM + kk] : F.c_ctx[kk]; sc[e] = v / (1.0f + expf(-v)); }
    __syncthreads();
    const int col = item * 64 + F.lane, kg = F.wid;
    float a[9];
#pragma unroll
    for (int r = 0; r < 9; ++r) a[r] = 0.f;
    for (int kk = kg * 128; kk < kg * 128 + 128; ++kk) {
        const float w = F.w_ada[(size_t)kk * 6144 + col];
#pragma unroll
        for (int r = 0; r < 9; ++r) a[r] += sc[r * 1024 + kk] * w;
    }
#pragma unroll
    for (int r = 0; r < 9; ++r) part[(kg * 9 + r) * 64 + F.lane] = a[r];
    __syncthreads();
    for (int e = F.tid; e < 9 * 64; e += 512) { const int r = e >> 6, cl = e & 63; float s = F.b_ada[item * 64 + cl];
#pragma unroll
        for (int g = 0; g < 8; ++g) s += part[(g * 9 + r) * 64 + cl];
        F.mod[r * 6144 + item * 64 + cl] = s; }
}
template <class CM> __device__ __forceinline__ void p0_transpose_item(const Frame& F, const float* W, int K, int Nsrc, act_t* dst, int item, int ntn, CM cmap) {
    float* tl = (float*)F.lds;
    const int kb = item / ntn, nb = item % ntn, k0 = kb * 64, n0 = nb * 64;
    __syncthreads();
    { const int n4 = F.tid & 15, kk0 = F.tid >> 4; const int sc = cmap(n0 + 4 * n4);
#pragma unroll
      for (int i = 0; i < 2; ++i) { const int kk = kk0 + 32 * i; const f32x4 v = *(const f32x4*)(W + (size_t)(k0 + kk) * Nsrc + sc);
          tl[kk * 65 + 4 * n4] = v[0]; tl[kk * 65 + 4 * n4 + 1] = v[1]; tl[kk * 65 + 4 * n4 + 2] = v[2]; tl[kk * 65 + 4 * n4 + 3] = v[3]; } }
    __syncthreads();
    { const int k8 = F.tid & 7, n = F.tid >> 3;
      act_t* d = dst + (size_t)(n0 + n) * K + k0 + 8 * k8;
      f32x4 a, b;
#pragma unroll
      for (int i = 0; i < 4; ++i) { a[i] = tl[(8 * k8 + i) * 65 + n]; b[i] = tl[(8 * k8 + 4 + i) * 65 + n]; }
      st4(d, a); st4(d + 4, b); }
}
__device__ __forceinline__ int cmap_in(int n) {
    if (n < 1536 || n >= 2560) return n;
    const int g = (n - 1536) >> 5, e = n & 31;
    return (e < 16) ? (1536 + 16 * g + e) : (2048 + 16 * g + (e - 16));
}
__device__ __forceinline__ void p0_prep(const Frame& F) {
    for (int it = F.bid; it < 96; it += F.G) p0_adaln_item(F, it);
    constexpr int I_IN = 16 * 72, I_OA = 16 * 16, I_OC = 8 * 16, I_OUT = 16 * 16, I_WQ = 16 * 32;
    constexpr int NIT = I_IN + I_OA + I_OC + I_OUT + I_WQ;
    auto ident = [](int n) { return n; };
    for (int it = F.bid; it < NIT; it += F.G) {
        int r = it;
        if (r < I_IN) { p0_transpose_item(F, F.w_in, 1024, INW, F.win_t, r, 72, [](int n) { return cmap_in(n); }); continue; } r -= I_IN;
        if (r < I_OA) { p0_transpose_item(F, F.w_o_attn, 1024, 1024, F.woa_t, r, 16, ident); continue; } r -= I_OA;
        if (r < I_OC) { p0_transpose_item(F, F.w_o_conv, 512, 1024, F.woc_t, r, 16, ident); continue; } r -= I_OC;
        if (r < I_OUT) { p0_transpose_item(F, F.w_out, 1024, 1024, F.wout_t, r, 16, ident); continue; } r -= I_OUT;
        p0_transpose_item(F, F.peer_wq, 1024, PQW, F.wq_t, r, 32, ident);
    }
    for (int e = F.bid * 512 + F.tid; e < 16 * 128 * 128; e += F.G * 512) st_act(F.keys_t + e, F.peer_keys[e]);
    for (int e = F.bid * 512 + F.tid; e < 64 * 16; e += F.G * 512) {
        const int pos = e >> 4, f = e & 15;
        const float freq = powf(10000.0f, -(float)(2 * f) / 32.0f);
        const float ang = (float)pos * freq;
        const double TWO_PI = 6.283185307179586476925286766559;
        double r = (double)ang; r -= TWO_PI * rint(r / TWO_PI);
        const double r2 = r * r;
        double sn = 0.0, cs = 0.0;
        double ts = r, tc = 1.0;
#pragma unroll 1
        for (int n = 0; n < 14; ++n) { sn += ts; cs += tc; ts *= -r2 / (double)((2 * n + 2) * (2 * n + 3)); tc *= -r2 / (double)((2 * n + 1) * (2 * n + 2)); }
        F.rope[e * 2] = (float)cs; F.rope[e * 2 + 1] = (float)sn;
    }
}

__device__ __forceinline__ void p1_norm(const Frame& F) {
    const int gw = F.bid * 8 + F.wid, NGW = F.G * 8;
    for (int r0 = gw * 4; r0 < T_ + CT_; r0 += NGW * 4) {
        const bool isx = r0 < T_;
        const int rr0 = isx ? r0 : r0 - T_;
        const float* src = isx ? F.x + ((size_t)F.b0 * SEQ + rr0) * DM : F.ctx + ((size_t)F.b0 * CTXL + rr0) * DM;
        act_t* dst = isx ? F.hx + (size_t)rr0 * DM : F.hc + (size_t)rr0 * DM;
        const float* mrow = isx ? F.mod + (size_t)(F.b0 + rr0 / SEQ) * 6144 : F.mod + (size_t)8 * 6144;
        f32x4 v[4][4]; float ss[4];
#pragma unroll
        for (int q = 0; q < 4; ++q)
#pragma unroll
            for (int j = 0; j < 4; ++j) v[q][j] = *(const f32x4*)(src + (size_t)q * DM + j * 256 + F.lane * 4);
#pragma unroll
        for (int q = 0; q < 4; ++q) { float s = 0.f;
#pragma unroll
            for (int j = 0; j < 4; ++j) s += v[q][j][0] * v[q][j][0] + v[q][j][1] * v[q][j][1] + v[q][j][2] * v[q][j][2] + v[q][j][3] * v[q][j][3];
            ss[q] = s; }
#pragma unroll
        for (int o = 1; o < 64; o <<= 1) {
#pragma unroll
            for (int q = 0; q < 4; ++q) ss[q] += __shfl_xor(ss[q], o); }
#pragma unroll
        for (int j = 0; j < 4; ++j) { const int d = j * 256 + F.lane * 4;
            const f32x4 g = *(const f32x4*)(F.g_pre_mix + d), sh = *(const f32x4*)(mrow + d), sc = *(const f32x4*)(mrow + 1024 + d);
#pragma unroll
            for (int q = 0; q < 4; ++q) { const float rstd = 1.0f / sqrtf(ss[q] * (1.0f / DM) + EPS);
                f32x4 o;
#pragma unroll
                for (int i = 0; i < 4; ++i) o[i] = (v[q][j][i] * rstd) * g[i] * (1.0f + sc[i]) + sh[i];
                st4(dst + (size_t)q * DM + d, o); } }
    }
}

__device__ __forceinline__ void epi_in(const Frame& F, int r, int c, f32x4 v0, f32x4 v1) {
    const int s = r & (SEQ - 1);
    if (c < 1280) {
        const int axis = (c >> 5) & 1, pos = axis ? (s & 63) : (s >> 6);
        const float* rp = F.rope + (pos * 16 + (c & 15)) * 2;
        const f32x4 cs0 = *(const f32x4*)rp, cs1 = *(const f32x4*)(rp + 4);
        f32x4 o1, o2;
        o1[0] = v0[0] * cs0[0] - v1[0] * cs0[1]; o2[0] = v1[0] * cs0[0] + v0[0] * cs0[1];
        o1[1] = v0[1] * cs0[2] - v1[1] * cs0[3]; o2[1] = v1[1] * cs0[2] + v0[1] * cs0[3];
        o1[2] = v0[2] * cs1[0] - v1[2] * cs1[1]; o2[2] = v1[2] * cs1[0] + v0[2] * cs1[1];
        o1[3] = v0[3] * cs1[2] - v1[3] * cs1[3]; o2[3] = v1[3] * cs1[2] + v0[3] * cs1[3];
        if (c < 1024) { o1 *= QS; o2 *= QS; st4(F.q + (size_t)r * 1024 + c, o1); st4(F.q + (size_t)r * 1024 + c + 16, o2); }
        else { st4(F.k + (size_t)r * 256 + (c - 1024), o1); st4(F.k + (size_t)r * 256 + (c - 1024) + 16, o2); }
    } else if (c < 1536) {
        const int cc = c - 1280, hk = cc >> 6, d = cc & 63, bl = r / SEQ;
        act_t* base = F.vT + ((size_t)(bl * 4 + hk) * 64 + d) * SEQ + s;
#pragma unroll
        for (int i = 0; i < 4; ++i) { st_act(base + (size_t)i * SEQ, v0[i]); st_act(base + (size_t)(16 + i) * SEQ, v1[i]); }
    } else if (c < 2560) {
        const int ch = ((c - 1536) >> 5) * 16 + (c & 15);
        f32x4 o;
#pragma unroll
        for (int i = 0; i < 4; ++i) o[i] = v0[i] * fsig(v1[i]);
        st4(F.u + (size_t)r * 512 + ch, o);
    } else {
        const int g = c - 2560; f32x4 o0, o1;
#pragma unroll
        for (int i = 0; i < 4; ++i) { o0[i] = fsig(v0[i]); o1[i] = fsig(v1[i]); }
        st4(F.sg + (size_t)r * 2048 + g, o0); st4(F.sg + (size_t)r * 2048 + g + 16, o1);
    }
}
__device__ __forceinline__ void epi_ctx(const Frame& F, int r, int c, f32x4 v0, f32x4 v1) {
    if (c < 256) { st4(F.kc + (size_t)r * 256 + c, v0); st4(F.kc + (size_t)r * 256 + c + 16, v1); }
    else { const int cc = c - 256, hk = cc >> 6, d = cc & 63, bl = r / CTXL, sx = r % CTXL;
        act_t* base = F.vTc + ((size_t)(bl * 4 + hk) * 64 + d) * CTXL + sx;
#pragma unroll
        for (int i = 0; i < 4; ++i) { st_act(base + (size_t)i * CTXL, v0[i]); st_act(base + (size_t)(16 + i) * CTXL, v1[i]); } }
}
#if GOLD
__device__ __forceinline__ void p2_inproj(const Frame& F) {
    constexpr int nM = T_ / 128, nN = INW / 128, nMc = CT_ / 128, nNc = 4;
    const int ntile = nM * nN + nMc * nNc;
    for (int t = F.bid; t < ntile; t += F.G) {
        f32x4 acc[2][4]; acc_zero(acc);
        if (t < nM * nN) {
            const int pm = t / nN, pn = t % nN;
            mma_tile(acc, F.lds, F.hx, DM, F.win_t, DM, DM, pm * 128, pn * 128);
            epi_foreach(acc, pm * 128, pn * 128, [&](int r, int c, f32x4 v0, f32x4 v1) { epi_in(F, r, c, v0, v1); });
        } else {
            const int tt = t - nM * nN, pm = tt / nNc, pn = tt % nNc;
            mma_tile(acc, F.lds, F.hc, DM, F.win_t + (size_t)1024 * DM, DM, DM, pm * 128, pn * 128);
            epi_foreach(acc, pm * 128, pn * 128, [&](int r, int c, f32x4 v0, f32x4 v1) { epi_ctx(F, r, c, v0, v1); });
        }
    }
}
#else
__device__ __forceinline__ void p2_inproj(const Frame& F) {
    auto fn = [&](int r, int c, f32x4 v0, f32x4 v1) { if (r < T_) epi_in(F, r, c, v0, v1); else epi_ctx(F, r - T_, c - 1024, v0, v1); };
    const pg8::Gemm g{F.hx, F.win_t, T_ + CT_, INW, DM}; InOrder S; S.init(T_, INW, F.G, F.bid); S.repn = (PROBE_PH == 20) ? PROBE_N : 1;
    const EpiFn<decltype(fn)> E{fn};
    pg8::gemm_phase<EpiFn<decltype(fn)>, InOrder, true, true>((PG8_LAS unsigned char*)F.lds, g, S, E);
}
#endif

#if GOLD
__device__ __forceinline__ void p3_attn(const Frame& F) {
    float* qs = (float*)F.lds + F.wid * 64;
    float* ps = (float*)F.lds + 512 + F.wid * 640;
    const int gw = F.bid * 8 + F.wid, NGW = F.G * 8;
    for (int it = gw; it < T_ * NH; it += NGW) {
        const int r = it / NH, head = it % NH, hk = head >> 2, bl = r / SEQ, s = r % SEQ;
        qs[F.lane] = F.q[(size_t)r * 1024 + head * 64 + F.lane];
        const int lo = (s - 128 < 0) ? 0 : s - 128, hi = (s + 128 > SEQ - 1) ? SEQ - 1 : s + 128, nwin = hi - lo + 1, ntot = nwin + CTXL;
        float mx = -1e30f;
        for (int jj = F.lane; jj < ntot; jj += 64) {
            const float* kr = (jj < nwin) ? F.k + ((size_t)(bl * SEQ + lo + jj)) * 256 + hk * 64 : F.kc + ((size_t)(bl * CTXL + jj - nwin)) * 256 + hk * 64;
            float d = 0.f;
            for (int e = 0; e < 64; e += 4) { const f32x4 kv = *(const f32x4*)(kr + e); d += qs[e] * kv[0] + qs[e + 1] * kv[1] + qs[e + 2] * kv[2] + qs[e + 3] * kv[3]; }
            ps[jj] = d; mx = fmaxf(mx, d);
        }
        mx = wave_max(mx);
        float l = 0.f;
        for (int jj = F.lane; jj < ntot; jj += 64) { const float p = exp2f(ps[jj] - mx); ps[jj] = p; l += p; }
        l = wave_sum(l) + exp2f(F.sink[head] * LOG2E - mx);
        const float* vr = F.vT + ((size_t)(bl * 4 + hk) * 64 + F.lane) * SEQ + lo;
        const float* vc = F.vTc + ((size_t)(bl * 4 + hk) * 64 + F.lane) * CTXL;
        float o = 0.f;
        for (int jj = 0; jj < nwin; ++jj) o += ps[jj] * vr[jj];
        for (int jj = 0; jj < CTXL; ++jj) o += ps[nwin + jj] * vc[jj];
        F.att[(size_t)r * 1024 + head * 64 + F.lane] = o / l;
    }
}
#else
__device__ __forceinline__ void p3_attn(const Frame& F) {
    constexpr int KLD = 72;
    bf16_t* Kt = (bf16_t*)F.lds;
    bf16_t* Vt = (bf16_t*)(F.lds + 64 * KLD * 2);
    const int lane = F.lane, l31 = lane & 31, hi = lane >> 5;
    const int g = F.wid >> 1, half = F.wid & 1;
    constexpr int NUNIT = CH_B * NKV * (SEQ / 128);
    for (int un = F.bid; un < NUNIT; un += F.G) {
        const int nb = un & 15, hk = (un >> 4) & 3, bl = un >> 6;
        const int head = hk * 4 + g;
        const int r0 = bl * SEQ + nb * 128 + half * 64;
        bf16x8 qf[2][4];
#pragma unroll
        for (int qt = 0; qt < 2; ++qt)
#pragma unroll
            for (int s = 0; s < 4; ++s) qf[qt][s] = *(const bf16x8*)(F.q + (size_t)(r0 + qt * 32 + l31) * 1024 + head * 64 + s * 16 + 8 * hi);
        float mrun[2] = {-1e30f, -1e30f}, lrun[2] = {0.f, 0.f};
        f32x16 O[2][2];
#pragma unroll
        for (int a = 0; a < 2; ++a)
#pragma unroll
            for (int b = 0; b < 2; ++b)
#pragma unroll
                for (int r = 0; r < 16; ++r) O[a][b][r] = 0.f;
        for (int tile = 0; tile < 10; ++tile) {
            const bool isctx = tile < 4;
            const int ks = isctx ? tile * 64 : nb * 128 - 128 + 64 * (tile - 4);
            if (!isctx && (ks < 0 || ks >= SEQ)) continue;
            __syncthreads();
            { const int row = F.tid >> 3, ch = F.tid & 7;
              const act_t* ksrc = isctx ? F.kc + ((size_t)(bl * CTXL + ks + row)) * 256 + hk * 64 + ch * 8
                                        : F.k + ((size_t)(bl * SEQ + ks + row)) * 256 + hk * 64 + ch * 8;
              const act_t* vsrc = isctx ? F.vTc + ((size_t)(bl * 4 + hk) * 64 + row) * CTXL + ks + ch * 8
                                        : F.vT + ((size_t)(bl * 4 + hk) * 64 + row) * SEQ + ks + ch * 8;
              *(u32x4*)(Kt + row * KLD + ch * 8) = *(const u32x4*)ksrc;
              *(u32x4*)(Vt + row * KLD + ch * 8) = *(const u32x4*)vsrc; }
            __syncthreads();
            const int j = tile - 4;
            const bool need = isctx || (half == 0 ? (j <= 4) : (j >= 1));
            if (need) {
                f32x16 st[2][2];
#pragma unroll
                for (int a = 0; a < 2; ++a)
#pragma unroll
                    for (int b = 0; b < 2; ++b)
#pragma unroll
                        for (int r = 0; r < 16; ++r) st[a][b][r] = 0.f;
#pragma unroll
                for (int s = 0; s < 4; ++s)
#pragma unroll
                    for (int kt = 0; kt < 2; ++kt) {
                        const bf16x8 a = *(const bf16x8*)(Kt + (kt * 32 + l31) * KLD + s * 16 + 8 * hi);
#pragma unroll
                        for (int qt = 0; qt < 2; ++qt) st[kt][qt] = __builtin_amdgcn_mfma_f32_32x32x16_bf16(a, qf[qt][s], st[kt][qt], 0, 0, 0);
                    }
                if (!isctx) {
#pragma unroll
                    for (int kt = 0; kt < 2; ++kt)
#pragma unroll
                        for (int qt = 0; qt < 2; ++qt) {
                            const int qp = nb * 128 + half * 64 + qt * 32 + l31;
#pragma unroll
                            for (int r = 0; r < 16; ++r) { const int kp = ks + kt * 32 + crow(r, hi); const int dd = qp - kp; if (dd > 128 || dd < -128) st[kt][qt][r] = -1e30f; }
                        }
                }
                bf16x8 pf[2][2][2];
#pragma unroll
                for (int qt = 0; qt < 2; ++qt) {
                    float mx = -1e30f;
#pragma unroll
                    for (int kt = 0; kt < 2; ++kt)
#pragma unroll
                        for (int r = 0; r < 16; ++r) mx = fmaxf(mx, st[kt][qt][r]);
                    mx = fmaxf(mx, __shfl_xor(mx, 32));
                    const float mn = fmaxf(mrun[qt], mx);
                    const float alpha = __builtin_amdgcn_exp2f(mrun[qt] - mn);
                    mrun[qt] = mn; lrun[qt] *= alpha;
#pragma unroll
                    for (int dt = 0; dt < 2; ++dt)
#pragma unroll
                        for (int r = 0; r < 16; ++r) O[dt][qt][r] *= alpha;
                    float ls = 0.f;
#pragma unroll
                    for (int kt = 0; kt < 2; ++kt) {
                        float p[16];
#pragma unroll
                        for (int r = 0; r < 16; ++r) { p[r] = __builtin_amdgcn_exp2f(st[kt][qt][r] - mn); ls += p[r]; }
#pragma unroll
                        for (int s2 = 0; s2 < 2; ++s2) {
                            u32x4 w;
                            w[0] = pk2(p[8 * s2 + 0], p[8 * s2 + 1]); w[1] = pk2(p[8 * s2 + 2], p[8 * s2 + 3]);
                            w[2] = pk2(p[8 * s2 + 4], p[8 * s2 + 5]); w[3] = pk2(p[8 * s2 + 6], p[8 * s2 + 7]);
                            pf[kt][s2][qt] = __builtin_bit_cast(bf16x8, w);
                        }
                    }
                    lrun[qt] += ls;
                }
#pragma unroll
                for (int kt = 0; kt < 2; ++kt)
#pragma unroll
                    for (int s2 = 0; s2 < 2; ++s2)
#pragma unroll
                        for (int dt = 0; dt < 2; ++dt) {
                            const bf16_t* vp = Vt + (dt * 32 + l31) * KLD + kt * 32 + s2 * 16 + 4 * hi;
                            const s16x4 lo = *(const s16x4*)vp, hh = *(const s16x4*)(vp + 8);
                            const bf16x8 a = (bf16x8){lo[0], lo[1], lo[2], lo[3], hh[0], hh[1], hh[2], hh[3]};
#pragma unroll
                            for (int qt = 0; qt < 2; ++qt) O[dt][qt] = __builtin_amdgcn_mfma_f32_32x32x16_bf16(a, pf[kt][s2][qt], O[dt][qt], 0, 0, 0);
                        }
            }
        }
        const float sk = F.sink[head] * LOG2E;
#pragma unroll
        for (int qt = 0; qt < 2; ++qt) {
            float lt = lrun[qt] + __shfl_xor(lrun[qt], 32);
            lt += __builtin_amdgcn_exp2f(sk - mrun[qt]);
            const float inv = 1.0f / lt;
            act_t* orow = F.att + (size_t)(r0 + qt * 32 + l31) * 1024 + head * 64;
#pragma unroll
            for (int dt = 0; dt < 2; ++dt)
#pragma unroll
                for (int g4 = 0; g4 < 4; ++g4) {
                    f32x4 o; o[0] = O[dt][qt][4 * g4] * inv; o[1] = O[dt][qt][4 * g4 + 1] * inv; o[2] = O[dt][qt][4 * g4 + 2] * inv; o[3] = O[dt][qt][4 * g4 + 3] * inv;
                    st4(orow + dt * 32 + 8 * g4 + 4 * hi, o);
                }
        }
    }
}
#endif

#if GOLD
constexpr int CTK = 32;
#else
constexpr int CTK = 64;
#endif
__device__ __forceinline__ void p3_conv(const Frame& F) {
    act_t* ub = (act_t*)F.lds;
    float* yb = (float*)(F.lds + (size_t)(CTK + 30) * 512 * AS);
    static_assert((CTK + 30) * 512 * AS + 8 * 512 * 4 <= LDS_MISC, "conv LDS");
    const int c = F.tid;
    float w[CONV_W];
#pragma unroll
    for (int i = 0; i < CONV_W; ++i) w[i] = F.conv_dw[i * CONV_CH + c];
    const float bias = F.conv_dw_b[c];
    constexpr int NT = T_ / CTK;
    for (int t = F.bid; t < NT; t += F.G) {
        const int r0 = t * CTK, bl = r0 / SEQ, s0 = r0 % SEQ;
        __syncthreads();
        constexpr int CPRW = 512 * AS / 16;
        for (int e = F.tid; e < (CTK + 30) * CPRW; e += 512) {
            const int rr = e / CPRW, ch = e % CPRW, sp = s0 + rr - 15;
            u32x4 v = (u32x4){0u, 0u, 0u, 0u};
            if (sp >= 0 && sp < SEQ) v = *(const u32x4*)((const unsigned char*)(F.u + (size_t)(bl * SEQ + sp) * 512) + ch * 16);
            *(u32x4*)((unsigned char*)ub + (size_t)rr * 512 * AS + ch * 16) = v;
        }
        __syncthreads();
        for (int chunk = 0; chunk < CTK / 8; ++chunk) {
#pragma unroll 1
            for (int tt = 0; tt < 8; ++tt) {
                const int tk = chunk * 8 + tt;
                float a = 0.f;
#pragma unroll
                for (int i = 0; i < CONV_W; ++i) a += ld_act(ub + (size_t)(tk + i) * 512 + c) * w[i];
                yb[tt * 512 + c] = a + bias;
            }
            __syncthreads();
            {
                const int tk = chunk * 8 + F.wid;
                float y[8];
                const f32x4 y0 = *(const f32x4*)(yb + F.wid * 512 + F.lane * 8), y1 = *(const f32x4*)(yb + F.wid * 512 + F.lane * 8 + 4);
                y[0] = y0[0]; y[1] = y0[1]; y[2] = y0[2]; y[3] = y0[3]; y[4] = y1[0]; y[5] = y1[1]; y[6] = y1[2]; y[7] = y1[3];
                float s = 0.f;
#pragma unroll
                for (int i = 0; i < 8; ++i) s += y[i];
                const float mean = wave_sum(s) * (1.0f / CONV_CH);
                float q = 0.f;
#pragma unroll
                for (int i = 0; i < 8; ++i) { y[i] -= mean; q += y[i] * y[i]; }
                const float rstd = 1.0f / sqrtf(wave_sum(q) * (1.0f / CONV_CH) + EPS);
                f32x4 o0, o1;
#pragma unroll
                for (int i = 0; i < 8; ++i) { const int ch = F.lane * 8 + i; const float z = y[i] * rstd * F.conv_ln_g[ch] + F.conv_ln_b[ch]; const float o = z * fsig(z); if (i < 4) o0[i] = o; else o1[i - 4] = o; }
                act_t* dst = F.cact + (size_t)(r0 + tk) * 512 + F.lane * 8;
                st4(dst, o0); st4(dst + 4, o1);
            }
            __syncthreads();
        }
    }
}

#if GOLD
__device__ __forceinline__ void p4_merge(const Frame& F) {
    constexpr int nM = T_ / 128, nN = 8;
    for (int t = F.bid; t < nM * nN; t += F.G) {
        const int pm = t / nN, pn = t % nN;
        f32x4 accA[2][4], accC[2][4]; acc_zero(accA); acc_zero(accC);
        mma_tile(accA, F.lds, F.att, 1024, F.woa_t, 1024, 1024, pm * 128, pn * 128);
        mma_tile(accC, F.lds, F.cact, 512, F.woc_t, 512, 512, pm * 128, pn * 128);
        const int lane = F.lane, wm = F.wid >> 1, wn = F.wid & 1, fr = lane & 15, fq = lane >> 4;
#pragma unroll
        for (int mi = 0; mi < 2; ++mi)
#pragma unroll
            for (int ni = 0; ni < 4; ++ni) {
                const int r = pm * 128 + wm * 32 + mi * 16 + fr, c = pn * 128 + wn * 64 + ni * 16 + 4 * fq;
                const f32x4 ga = ld4(F.sg + (size_t)r * 2048 + c), gc = ld4(F.sg + (size_t)r * 2048 + 1024 + c);
                st4(F.m + (size_t)r * 1024 + c, ga * accA[mi][ni] + gc * accC[mi][ni]);
            }
    }
}
__device__ __forceinline__ void p5_out(const Frame& F) {
    constexpr int nM = T_ / 128, nN = 8;
    for (int t = F.bid; t < nM * nN; t += F.G) {
        const int pm = t / nN, pn = t % nN;
        f32x4 acc[2][4]; acc_zero(acc);
        mma_tile(acc, F.lds, F.m, 1024, F.wout_t, 1024, 1024, pm * 128, pn * 128);
        const int lane = F.lane, wm = F.wid >> 1, wn = F.wid & 1, fr = lane & 15, fq = lane >> 4;
#pragma unroll
        for (int mi = 0; mi < 2; ++mi)
#pragma unroll
            for (int ni = 0; ni < 4; ++ni) {
                const int r = pm * 128 + wm * 32 + mi * 16 + fr, c = pn * 128 + wn * 64 + ni * 16 + 4 * fq;
                *(f32x4*)(F.mixed + (size_t)r * 1024 + c) = acc[mi][ni];
            }
    }
}
#else
__device__ __forceinline__ void p4_merge(const Frame& F) {
    run_gemm<22>(F, F.att, F.woa_t, T_, 1024, 1024, [&](int r, int c, f32x4 v0, f32x4 v1) {
        const act_t* gp = F.sg + (size_t)r * 2048 + c; act_t* mp = F.m + (size_t)r * 1024 + c;
        st4(mp, ld4(gp) * v0); st4(mp + 16, ld4(gp + 16) * v1); });
    run_gemm<-2>(F, F.cact, F.woc_t, T_, 1024, 512, [&](int r, int c, f32x4 v0, f32x4 v1) {
        const act_t* gp = F.sg + (size_t)r * 2048 + 1024 + c; act_t* mp = F.m + (size_t)r * 1024 + c;
        st4(mp, ld4(mp) + ld4(gp) * v0); st4(mp + 16, ld4(mp + 16) + ld4(gp + 16) * v1); });
}
__device__ __forceinline__ void p5_out(const Frame& F) {
    run_gemm<23>(F, F.m, F.wout_t, T_, 1024, 1024, [&](int r, int c, f32x4 v0, f32x4 v1) {
        float* p = F.mixed + (size_t)r * 1024 + c; *(f32x4*)p = v0; *(f32x4*)(p + 16) = v1; });
}
#endif
__device__ __forceinline__ void p6_rows(const Frame& F) {
    const int gw = F.bid * 8 + F.wid, NGW = F.G * 8;
    for (int r0 = gw * 2; r0 < T_; r0 += NGW * 2) {
        const float* mrow = F.mod + (size_t)(F.b0 + r0 / SEQ) * 6144;
        const float* xr = F.x + ((size_t)F.b0 * SEQ + r0) * DM;
        float* outr = F.out + ((size_t)F.b0 * SEQ + r0) * DM;
        f32x4 mv[2][4], xv[2][4]; float ss[2], s1[2];
#pragma unroll
        for (int q = 0; q < 2; ++q)
#pragma unroll
            for (int j = 0; j < 4; ++j) { mv[q][j] = *(const f32x4*)(F.mixed + (size_t)(r0 + q) * 1024 + j * 256 + F.lane * 4); xv[q][j] = *(const f32x4*)(xr + (size_t)q * DM + j * 256 + F.lane * 4); }
#pragma unroll
        for (int q = 0; q < 2; ++q) { float s = 0.f;
#pragma unroll
            for (int j = 0; j < 4; ++j) s += mv[q][j][0] * mv[q][j][0] + mv[q][j][1] * mv[q][j][1] + mv[q][j][2] * mv[q][j][2] + mv[q][j][3] * mv[q][j][3];
            ss[q] = s; }
#pragma unroll
        for (int o = 1; o < 64; o <<= 1) { ss[0] += __shfl_xor(ss[0], o); ss[1] += __shfl_xor(ss[1], o); }
        s1[0] = 0.f; s1[1] = 0.f;
#pragma unroll
        for (int j = 0; j < 4; ++j) { const int d = j * 256 + F.lane * 4;
            const f32x4 g = *(const f32x4*)(F.g_post_mix + d), gt = *(const f32x4*)(mrow + 2048 + d);
#pragma unroll
            for (int q = 0; q < 2; ++q) { const float rstd = 1.0f / sqrtf(ss[q] * (1.0f / DM) + EPS);
#pragma unroll
                for (int i = 0; i < 4; ++i) { xv[q][j][i] = xv[q][j][i] + gt[i] * ((mv[q][j][i] * rstd) * g[i]); s1[q] += xv[q][j][i] * xv[q][j][i]; }
                *(f32x4*)(outr + (size_t)q * DM + d) = xv[q][j]; } }
#pragma unroll
        for (int o = 1; o < 64; o <<= 1) { s1[0] += __shfl_xor(s1[0], o); s1[1] += __shfl_xor(s1[1], o); }
#pragma unroll
        for (int j = 0; j < 4; ++j) { const int d = j * 256 + F.lane * 4;
            const f32x4 g = *(const f32x4*)(F.g_pre_ffn + d), sh = *(const f32x4*)(mrow + 3072 + d), sc = *(const f32x4*)(mrow + 4096 + d);
#pragma unroll
            for (int q = 0; q < 2; ++q) { const float rstd1 = 1.0f / sqrtf(s1[q] * (1.0f / DM) + EPS);
                f32x4 o;
#pragma unroll
                for (int i = 0; i < 4; ++i) o[i] = (xv[q][j][i] * rstd1) * g[i] * (1.0f + sc[i]) + sh[i];
                st4(F.h2 + (size_t)(r0 + q) * 1024 + d, o); } }
    }
}
__device__ __forceinline__ void p7_wq(const Frame& F) {
#if GOLD
    constexpr int nM = T_ / 128, nN = PQW / 128;
    for (int t = F.bid; t < nM * nN; t += F.G) {
        const int pm = t / nN, pn = t % nN;
        f32x4 acc[2][4]; acc_zero(acc);
        mma_tile(acc, F.lds, F.h2, 1024, F.wq_t, 1024, 1024, pm * 128, pn * 128);
        const int lane = F.lane, wm = F.wid >> 1, wn = F.wid & 1, fr = lane & 15, fq = lane >> 4;
#pragma unroll
        for (int mi = 0; mi < 2; ++mi)
#pragma unroll
            for (int ni = 0; ni < 4; ++ni) {
                const int r = pm * 128 + wm * 32 + mi * 16 + fr, c = pn * 128 + wn * 64 + ni * 16 + 4 * fq;
                st4(F.pq + (size_t)r * PQW + c, acc[mi][ni]);
            }
    }
#else
    run_gemm<24>(F, F.h2, F.wq_t, T_, PQW, 1024, [&](int r, int c, f32x4 v0, f32x4 v1) {
        act_t* p = F.pq + (size_t)r * PQW + c; st4(p, v0); st4(p + 16, v1); });
#endif
}
__device__ __forceinline__ int f2sort(float f) { const int b = __float_as_int(f); return b ^ ((b >> 31) & 0x7fffffff); }
__device__ __forceinline__ float sort2f(int k) { return __int_as_float(k ^ ((k >> 31) & 0x7fffffff)); }
__device__ __forceinline__ void p8_partial(const Frame& F, int (&L)[16], int t, int hp, int l31, int hi) {
#pragma unroll
    for (int i = 0; i < 16; ++i) L[i] = (int)0x80000000;
    const act_t* qrow = F.pq + (size_t)t * PQW + hp * 128;
#pragma unroll 1
    for (int kt = 0; kt < 4; ++kt) {
        const act_t* krow = F.keys_t + ((size_t)hp * 128 + kt * 32 + l31) * 128;
        f32x16 sc;
#pragma unroll
        for (int r = 0; r < 16; ++r) sc[r] = 0.f;
#if GOLD
        for (int s = 0; s < 64; ++s) sc = __builtin_amdgcn_mfma_f32_32x32x2f32(krow[2 * s + hi], qrow[2 * s + hi], sc, 0, 0, 0);
#else
#pragma unroll
        for (int s = 0; s < 8; ++s) { const bf16x8 a = *(const bf16x8*)(krow + 16 * s + 8 * hi), b = *(const bf16x8*)(qrow + 16 * s + 8 * hi);
            sc = __builtin_amdgcn_mfma_f32_32x32x16_bf16(a, b, sc, 0, 0, 0); }
#endif
#pragma unroll
        for (int r = 0; r < 16; ++r) {
            int v = (f2sort(sc[r]) & ~127) | (127 - (kt * 32 + crow(r, hi)));
#pragma unroll
            for (int i = 0; i < 16; ++i) { const int h_ = max(L[i], v); v = min(L[i], v); L[i] = h_; }
        }
    }
}
#if !GOLD
__device__ __forceinline__ void p8_convert_tables(const Frame& F) {
    const int gw = F.bid * 8 + F.wid, NGW = F.G * 8;
    for (size_t e = (size_t)gw * 64 + F.lane; e < (size_t)NEXP * 1024 / 16; e += (size_t)NGW * 64) {
        u32x4 wa, wb;
#pragma unroll
        for (int j = 0; j < 4; ++j) { const f32x4 a = *(const f32x4*)(F.peer_u + e * 16 + 4 * j), b = *(const f32x4*)(F.peer_v + e * 16 + 4 * j);
            int pa = 0, pb = 0;
            pa = __builtin_amdgcn_cvt_pk_fp8_f32(a[0] * 256.0f, a[1] * 256.0f, pa, false); pa = __builtin_amdgcn_cvt_pk_fp8_f32(a[2] * 256.0f, a[3] * 256.0f, pa, true);
            pb = __builtin_amdgcn_cvt_pk_fp8_f32(b[0] * 256.0f, b[1] * 256.0f, pb, false); pb = __builtin_amdgcn_cvt_pk_fp8_f32(b[2] * 256.0f, b[3] * 256.0f, pb, true);
            wa[j] = (unsigned)pa; wb[j] = (unsigned)pb; }
        *(u32x4*)(F.pu8 + e * 16) = wa; *(u32x4*)(F.pv8 + e * 16) = wb;
    }
}
#endif
__device__ __forceinline__ void p8_topk(const Frame& F) {
    const int gw = F.bid * 8 + F.wid, NGW = F.G * 8, lane = F.lane, l31 = lane & 31, hi = lane >> 5;
#if !GOLD
    if (F.wid >= 4) p8_convert_tables(F);
#endif
    for (int task = gw; task < (T_ / 32) * 4; task += NGW) {
        const int tb = task >> 2, h0 = (task & 3) * 2, t = tb * 32 + l31;
        int a[16], b[16];
        {
            int P0[16], P1[16];
            p8_partial(F, P0, t, 2 * h0, l31, hi); p8_partial(F, P1, t, 2 * h0 + 2, l31, hi);
#pragma unroll
            for (int i = 0; i < 16; ++i) { const auto rr = __builtin_amdgcn_permlane32_swap((unsigned)P0[i], (unsigned)P1[i], false, false); a[i] = (int)rr[0]; P1[i] = (int)rr[1]; }
#pragma unroll
            for (int e = 0; e < 16; ++e) { int v = P1[e];
#pragma unroll
                for (int i = 0; i < 16; ++i) { const int h_ = max(a[i], v); v = min(a[i], v); a[i] = h_; } }
        }
        {
            int P0[16], P1[16];
            p8_partial(F, P0, t, 2 * h0 + 1, l31, hi); p8_partial(F, P1, t, 2 * h0 + 3, l31, hi);
#pragma unroll
            for (int i = 0; i < 16; ++i) { const auto rr = __builtin_amdgcn_permlane32_swap((unsigned)P0[i], (unsigned)P1[i], false, false); b[i] = (int)rr[0]; P1[i] = (int)rr[1]; }
#pragma unroll
            for (int e = 0; e < 16; ++e) { int v = P1[e];
#pragma unroll
                for (int i = 0; i < 16; ++i) { const int h_ = max(b[i], v); v = min(b[i], v); b[i] = h_; } }
        }
        float fa[16], fb[16]; int ia[16], ib[16];
#pragma unroll
        for (int i = 0; i < 16; ++i) { fa[i] = sort2f(a[i]); fb[i] = sort2f(b[i]); ia[i] = (127 - (a[i] & 127)) * 128; ib[i] = 127 - (b[i] & 127); }
        int c[16], cp[16];
#pragma unroll
        for (int j = 0; j < 16; ++j) { c[j] = f2sort(fa[0] + fb[j]); cp[j] = ia[0] + ib[j]; }
#pragma unroll
        for (int i = 1; i < 16; ++i)
#pragma unroll
            for (int j = 0; j < 16 / (i + 1); ++j) {
                int v = f2sort(fa[i] + fb[j]), pv = ia[i] + ib[j];
#pragma unroll
                for (int s = (i + 1) * (j + 1) - 1; s < 16; ++s) { const bool gt = v > c[s]; const int nk = gt ? v : c[s], lo = gt ? c[s] : v, np = gt ? pv : cp[s], lp = gt ? cp[s] : pv; c[s] = nk; cp[s] = np; v = lo; pv = lp; }
            }
        float e[16], sum = 0.f; const float c0 = sort2f(c[0]);
#pragma unroll
        for (int i = 0; i < 16; ++i) { e[i] = exp2f((sort2f(c[i]) - c0) * LOG2E); sum += e[i]; }
        const float inv = 1.0f / sum;
        const size_t ob = (size_t)t * 128 + (h0 + hi) * 16;
#pragma unroll
        for (int i4 = 0; i4 < 16; i4 += 4) {
#if GOLD
            *(u32x4*)(F.pei + ob + i4) = (u32x4){(unsigned)cp[i4], (unsigned)cp[i4 + 1], (unsigned)cp[i4 + 2], (unsigned)cp[i4 + 3]};
            *(f32x4*)(F.peg + ob + i4) = (f32x4){e[i4] * inv, e[i4 + 1] * inv, e[i4 + 2] * inv, e[i4 + 3] * inv};
#else
            u32x4 pw;
#pragma unroll
            for (int i = 0; i < 4; ++i) pw[i] = ((unsigned)cp[i4 + i] << 16) | (unsigned)__builtin_bit_cast(unsigned short, (_Float16)(e[i4 + i] * inv));
            *(u32x4*)(F.pei + ob + i4) = pw;
#endif
        }
    }
#if !GOLD
    if (F.wid < 4) p8_convert_tables(F);
#endif
}
#if GOLD
__device__ __forceinline__ void p10_experts(const Frame& F) {
    const int gw = F.bid * 8 + F.wid, NGW = F.G * 8, lane = F.lane;
    constexpr int EPL = 4, NLD = 4;
    const float* TU = F.peer_u; const float* TV = F.peer_v;
    for (int r = gw; r < T_; r += NGW) {
        float hv[NLD][EPL], acc[NLD][EPL];
#pragma unroll
        for (int j = 0; j < NLD; ++j)
#pragma unroll
            for (int i = 0; i < EPL; ++i) { hv[j][i] = ld_act(F.h2 + (size_t)r * 1024 + j * 64 * EPL + lane * EPL + i); acc[j][i] = 0.f; }
        const int id0 = F.pei[(size_t)r * 128 + lane], id1 = F.pei[(size_t)r * 128 + 64 + lane];
        const float g0 = F.peg[(size_t)r * 128 + lane], g1 = F.peg[(size_t)r * 128 + 64 + lane];
        for (int e = 0; e < 128; ++e) {
            const int idx = __shfl((e < 64) ? id0 : id1, e & 63);
            const float gt = __shfl((e < 64) ? g0 : g1, e & 63);
            float uv[NLD][EPL], vv[NLD][EPL];
#pragma unroll
            for (int j = 0; j < NLD; ++j) {
                const f32x4 a = *(const f32x4*)(TU + (size_t)idx * 1024 + j * 256 + lane * 4), b = *(const f32x4*)(TV + (size_t)idx * 1024 + j * 256 + lane * 4);
#pragma unroll
                for (int i = 0; i < 4; ++i) { uv[j][i] = a[i]; vv[j][i] = b[i]; }
            }
            float d = 0.f;
#pragma unroll
            for (int j = 0; j < NLD; ++j)
#pragma unroll
                for (int i = 0; i < EPL; ++i) d += uv[j][i] * hv[j][i];
            d = wave_sum(d);
            const float act = 0.5f * d * (1.0f + erff(d * 0.70710678118654752f));
            const float wgt = gt * act;
#pragma unroll
            for (int j = 0; j < NLD; ++j)
#pragma unroll
                for (int i = 0; i < EPL; ++i) acc[j][i] += wgt * vv[j][i];
        }
        float ss = 0.f;
#pragma unroll
        for (int j = 0; j < NLD; ++j)
#pragma unroll
            for (int i = 0; i < EPL; ++i) ss += acc[j][i] * acc[j][i];
        const float rstd = 1.0f / sqrtf(wave_sum(ss) * (1.0f / DM) + EPS);
        const float* mrow = F.mod + (size_t)(F.b0 + r / SEQ) * 6144 + 5120;
        float* outr = F.out + ((size_t)F.b0 * SEQ + r) * DM;
#pragma unroll
        for (int j = 0; j < NLD; ++j)
#pragma unroll
            for (int i4 = 0; i4 < EPL; i4 += 4) { const int d0 = j * 64 * EPL + lane * EPL + i4;
                const f32x4 x1 = *(const f32x4*)(outr + d0), g = *(const f32x4*)(F.g_post_ffn + d0), gt2 = *(const f32x4*)(mrow + d0);
                f32x4 o;
#pragma unroll
                for (int i = 0; i < 4; ++i) o[i] = x1[i] + gt2[i] * ((acc[j][i4 + i] * rstd) * g[i]);
                *(f32x4*)(outr + d0) = o; }
    }
}
#else
typedef _Float16 h2_t __attribute__((ext_vector_type(2)));
__device__ __forceinline__ float gelu_fast(float v) {
    const float av = __builtin_fabsf(v), d = av * 0.2316418882f + 1.0f, t = __builtin_amdgcn_rcpf(d);
    float q = t * 0.5307027145f + (-0.7265760135f); q = q * t + 0.7107068705f; q = q * t + (-0.142248368f); q = q * t + 0.127414796f; q = q * t;
    const float ex = __builtin_amdgcn_exp2f(v * v * (-0.72134752044f));
    const float m = v * (q * ex), r = v - m; return v < 0.f ? m : r;
}
#define CVT_LO(w) __builtin_bit_cast(h2_t, __builtin_amdgcn_cvt_scalef32_pk_f16_fp8((int)(w), 1.0f, false))
#define CVT_HI(w) __builtin_bit_cast(h2_t, __builtin_amdgcn_cvt_scalef32_pk_f16_fp8((int)(w), 1.0f, true))
#define P10_LOAD(U, V, b, q) do { _Pragma("unroll") for (int e_ = 0; e_ < 4; ++e_) { \
        const unsigned w_ = (unsigned)__builtin_amdgcn_readlane((int)(((b) < 16) ? sw[q][0] : sw[q][1]), (4 * (b) + e_) & 63); \
        const size_t ro_ = (size_t)(w_ >> 16) * 1024 + lane * 16; U[e_] = *(const u32x4*)(TU + ro_); V[e_] = *(const u32x4*)(TV + ro_); } } while (0)
#define P10_COMPUTE(U, V, b, q) do { float d_[4]; unsigned wj_[4]; \
        _Pragma("unroll") for (int e_ = 0; e_ < 4; ++e_) { wj_[e_] = (unsigned)__builtin_amdgcn_readlane((int)(((b) < 16) ? sw[q][0] : sw[q][1]), (4 * (b) + e_) & 63); float s_ = 0.f; \
            _Pragma("unroll") for (int w_ = 0; w_ < 4; ++w_) { s_ = __builtin_amdgcn_fdot2(CVT_LO(U[e_][w_]), hv[q][2 * w_], s_, false); s_ = __builtin_amdgcn_fdot2(CVT_HI(U[e_][w_]), hv[q][2 * w_ + 1], s_, false); } d_[e_] = s_; } \
        float d2_[2], d1_; \
        _Pragma("unroll") for (int e_ = 0; e_ < 2; ++e_) { const float k_ = b5 ? d_[e_ + 2] : d_[e_], s_ = b5 ? d_[e_] : d_[e_ + 2]; d2_[e_] = k_ + __shfl_xor(s_, 32); } \
        { const float k_ = b4 ? d2_[1] : d2_[0], s_ = b4 ? d2_[0] : d2_[1]; d1_ = k_ + __shfl_xor(s_, 16); } \
        d1_ += __shfl_xor(d1_, 8); d1_ += __shfl_xor(d1_, 4); d1_ += __shfl_xor(d1_, 2); d1_ += __shfl_xor(d1_, 1); \
        unsigned gw_ = wj_[0]; gw_ = (eid == 1) ? wj_[1] : gw_; gw_ = (eid == 2) ? wj_[2] : gw_; gw_ = (eid == 3) ? wj_[3] : gw_; \
        const float gate_ = (float)__builtin_bit_cast(_Float16, (unsigned short)(gw_ & 0xffffu)); \
        const float wv_ = gate_ * gelu_fast(d1_ * (1.0f / 256.0f)); \
        const _Float16 wh_ = (_Float16)wv_; const h2_t w2_ = {wh_, wh_}; const unsigned wbits_ = __builtin_bit_cast(unsigned, w2_); \
        _Pragma("unroll") for (int e_ = 0; e_ < 4; ++e_) { \
            const h2_t we_ = __builtin_bit_cast(h2_t, (unsigned)__builtin_amdgcn_readlane((int)wbits_, (e_ & 1) * 16 + ((e_ >> 1) & 1) * 32)); \
            _Pragma("unroll") for (int w_ = 0; w_ < 4; ++w_) { acc[q][2 * w_] = CVT_LO(V[e_][w_]) * we_ + acc[q][2 * w_]; acc[q][2 * w_ + 1] = CVT_HI(V[e_][w_]) * we_ + acc[q][2 * w_ + 1]; } } } while (0)
__device__ __forceinline__ void p10_experts(const Frame& F) {
    const int gw = F.bid * 8 + F.wid, lane = F.lane;
    const unsigned char* TU = F.pu8; const unsigned char* TV = F.pv8;
    const bool b5 = (lane & 32) != 0, b4 = (lane & 16) != 0;
    const int eid = ((lane >> 4) & 1) | (((lane >> 5) & 1) << 1);
    unsigned* sl = (unsigned*)F.lds + F.wid * 128;
    for (int t0 = gw * 4; t0 < T_; t0 += F.G * 8 * 4) {
        h2_t hv[4][8], acc[4][8]; unsigned sw[4][2];
#pragma unroll
        for (int q = 0; q < 4; ++q) {
            const int r = t0 + q;
            const act_t* hp = F.h2 + (size_t)r * 1024 + lane * 16;
#pragma unroll
            for (int j = 0; j < 4; ++j) { const f32x4 t = ld4(hp + 4 * j); hv[q][2 * j] = (h2_t){(_Float16)t[0], (_Float16)t[1]}; hv[q][2 * j + 1] = (h2_t){(_Float16)t[2], (_Float16)t[3]}; }
            const unsigned w0 = (unsigned)F.pei[(size_t)r * 128 + lane], w1 = (unsigned)F.pei[(size_t)r * 128 + 64 + lane];
            const int k0 = (int)(w0 >> 26), k1 = (int)(w1 >> 26);
            int pos0 = 0, pos1 = 0, base = 0;
#pragma unroll 1
            for (int s = 0; s < 16; ++s) {
                const unsigned long long m0 = __builtin_amdgcn_ballot_w64(k0 == s), m1 = __builtin_amdgcn_ballot_w64(k1 == s);
                const int c0 = __builtin_popcountll(m0);
                const int p0 = (int)__builtin_amdgcn_mbcnt_hi((unsigned)(m0 >> 32), __builtin_amdgcn_mbcnt_lo((unsigned)m0, 0u));
                const int p1 = (int)__builtin_amdgcn_mbcnt_hi((unsigned)(m1 >> 32), __builtin_amdgcn_mbcnt_lo((unsigned)m1, 0u));
                if (k0 == s) pos0 = base + p0;
                if (k1 == s) pos1 = base + c0 + p1;
                base += c0 + __builtin_popcountll(m1);
            }
            sl[pos0] = w0; sl[pos1] = w1;
            sw[q][0] = sl[lane]; sw[q][1] = sl[64 + lane];
        }
        u32x4 ua[4], va[4], ub[4], vb[4];
        for (int rep_ = 0; rep_ < ((PROBE_PH == 9) ? PROBE_N : 1); ++rep_) {
#pragma unroll
        for (int q = 0; q < 4; ++q)
#pragma unroll
            for (int i = 0; i < 8; ++i) acc[q][i] = (h2_t){(_Float16)0.f, (_Float16)0.f};
        P10_LOAD(ua, va, 0, 0);
#pragma unroll 1
        for (int bb = 0; bb < 32; ++bb) {
            P10_LOAD(ub, vb, bb, 1); P10_COMPUTE(ua, va, bb, 0);
            P10_LOAD(ua, va, bb, 2); P10_COMPUTE(ub, vb, bb, 1);
            P10_LOAD(ub, vb, bb, 3); P10_COMPUTE(ua, va, bb, 2);
            if (bb + 1 < 32) P10_LOAD(ua, va, bb + 1, 0);
            P10_COMPUTE(ub, vb, bb, 3);
        }
        }
        const float* mrow = F.mod + (size_t)(F.b0 + t0 / SEQ) * 6144 + 5120;
#pragma unroll
        for (int q = 0; q < 4; ++q) {
            float o[16], ss = 0.f;
#pragma unroll
            for (int i = 0; i < 8; ++i) { o[2 * i] = (float)acc[q][i][0] * (1.0f / 256.0f); o[2 * i + 1] = (float)acc[q][i][1] * (1.0f / 256.0f); ss += o[2 * i] * o[2 * i] + o[2 * i + 1] * o[2 * i + 1]; }
            const float rstd = 1.0f / sqrtf(wave_sum(ss) * (1.0f / DM) + EPS);
            float* outr = F.out + ((size_t)F.b0 * SEQ + t0 + q) * DM;
#pragma unroll
            for (int j = 0; j < 4; ++j) { const int d0 = lane * 16 + 4 * j;
                const f32x4 x1 = *(const f32x4*)(outr + d0), g = *(const f32x4*)(F.g_post_ffn + d0), gt2 = *(const f32x4*)(mrow + d0);
                f32x4 ov;
#pragma unroll
                for (int i = 0; i < 4; ++i) ov[i] = x1[i] + gt2[i] * ((o[4 * j + i] * rstd) * g[i]);
                *(f32x4*)(outr + d0) = ov; }
        }
    }
}
#endif

__global__ void __launch_bounds__(512, 2) fwd_kernel(Args a) {
    extern __shared__ __attribute__((aligned(16))) unsigned char lds[];
    Frame F;
    F.lds = lds; F.tid = threadIdx.x; F.lane = F.tid & 63; F.wid = __builtin_amdgcn_readfirstlane(F.tid >> 6); F.G = gridDim.x; F.bid = blockIdx.x; F.b0 = a.b0;
    F.x = a.in[0]; F.c = a.in[1]; F.ctx = a.in[2]; F.c_ctx = a.in[3]; F.w_ada = a.in[4]; F.b_ada = a.in[5]; F.g_pre_mix = a.in[6]; F.g_post_mix = a.in[7];
    F.g_pre_ffn = a.in[8]; F.g_post_ffn = a.in[9]; F.w_in = a.in[10]; F.sink = a.in[11]; F.w_o_attn = a.in[12]; F.conv_dw = a.in[13]; F.conv_dw_b = a.in[14];
    F.conv_ln_g = a.in[15]; F.conv_ln_b = a.in[16]; F.w_o_conv = a.in[17]; F.w_out = a.in[18]; F.peer_wq = a.in[19]; F.peer_keys = a.in[20]; F.peer_u = a.in[21]; F.peer_v = a.in[22];
    F.out = a.out;
    unsigned char* ws = a.ws;
    F.mod = (float*)(ws + WS_MOD); F.rope = (float*)(ws + WS_ROPE);
    F.win_t = (act_t*)(ws + WS_WIN); F.woa_t = (act_t*)(ws + WS_WOA); F.woc_t = (act_t*)(ws + WS_WOC); F.wout_t = (act_t*)(ws + WS_WOUT); F.wq_t = (act_t*)(ws + WS_WQ); F.keys_t = (act_t*)(ws + WS_KEYS);
    F.q = (act_t*)(ws + O_Q); F.k = (act_t*)(ws + O_K); F.vT = (act_t*)(ws + O_VT); F.u = (act_t*)(ws + O_U); F.sg = (act_t*)(ws + O_SG); F.kc = (act_t*)(ws + O_KC); F.vTc = (act_t*)(ws + O_VTC);
    F.att = (act_t*)(ws + O_ATT); F.cact = (act_t*)(ws + O_CACT); F.hx = (act_t*)(ws + O_HX); F.hc = (act_t*)(ws + O_HC); F.m = (act_t*)(ws + O_M); F.h2 = (act_t*)(ws + O_H2); F.pq = (act_t*)(ws + O_PQ);
    F.mixed = (float*)(ws + O_MIXED); F.topv = (float*)(ws + O_TOPV); F.topi = (int*)(ws + O_TOPI); F.pei = (int*)(ws + O_PEI); F.peg = (float*)(ws + O_PEG);
    F.pu8 = ws + O_PU; F.pv8 = ws + O_PV;

    volatile LAS unsigned* misc = (volatile LAS unsigned*)(LAS unsigned char*)(lds + LDS_MISC);
    if (F.tid < 64) misc[F.tid] = 0u;
    __syncthreads();
    const int lo = a.ph_lo, hi = a.ph_hi;
    XcdBarrier bar; bar.bar = (unsigned*)(ws + WS_CTL); bar.x = 0; bar.st = misc;
    if (hi - lo > 1) bar = xcd_barrier_post((unsigned*)(ws + WS_CTL), misc);
#define IN(k) (lo <= (k) && (k) < hi)
#define SEAM(k) do { if (IN(k) && IN((k) + 1)) xcd_barrier(bar); } while (0)
#define REP(k) for (int rep_ = 0; rep_ < ((PROBE_PH == (k)) ? PROBE_N : 1); ++rep_)
    if (IN(0)) { REP(0) { p0_prep(F); __syncthreads(); } } SEAM(0);
    if (IN(1)) { REP(1) { p1_norm(F); } } SEAM(1);
    if (IN(2)) { REP(2) { p2_inproj(F); } } SEAM(2);
    if (IN(3)) { REP(3) { p3_attn(F); __syncthreads(); } REP(11) { p3_conv(F); __syncthreads(); } } SEAM(3);
    if (IN(4)) { REP(4) { p4_merge(F); } } SEAM(4);
    if (IN(5)) { REP(5) { p5_out(F); } } SEAM(5);
    if (IN(6)) { REP(6) { p6_rows(F); } } SEAM(6);
    if (IN(7)) { REP(7) { p7_wq(F); } } SEAM(7);
    if (IN(8)) { REP(8) { p8_topk(F); } } SEAM(8);
#if PROBE_PH == 30
    for (int i_ = 0; i_ < 10; ++i_) xcd_barrier(bar);
#endif
    if (IN(9)) { p10_experts(F); }
#undef REP
#undef IN
#undef SEAM
}

extern "C" void kernel_launch(void* const* d_in, const int* in_sizes, int n_in, void* d_out, int out_size, void* d_ws, size_t ws_size, hipStream_t stream) {
    static int grid = 0;
    if (grid == 0) {
        if (n_in != 23 || ws_size < WS_END) { fprintf(stderr, "kernel_launch: need 23 inputs and %zu B of workspace (got %d, %zu)\n", (size_t)WS_END, n_in, ws_size); grid = -1; return; }
        int dev = 0, cus = 0;
        if (hipGetDevice(&dev) != hipSuccess || hipDeviceGetAttribute(&cus, hipDeviceAttributeMultiprocessorCount, dev) != hipSuccess) { grid = -1; return; }
        if (hipFuncSetAttribute((const void*)fwd_kernel, hipFuncAttributeMaxDynamicSharedMemorySize, LDS_BYTES) != hipSuccess) { fprintf(stderr, "kernel_launch: hipFuncSetAttribute failed\n"); grid = -1; return; }
        grid = cus;
    }
    if (grid < 0) return;
    (void)hipMemsetAsync((char*)d_ws + WS_CTL, 0, CTL_BYTES, stream);
    Args a{};
    for (int i = 0; i < 23; ++i) a.in[i] = (const float*)d_in[i];
    a.out = (float*)d_out; a.ws = (unsigned char*)d_ws;
#if ONE_LAUNCH
    a.ph_lo = 0; a.ph_hi = NPHASE; a.b0 = 0;
    hipLaunchKernelGGL(fwd_kernel, dim3(grid), dim3(512), LDS_BYTES, stream, a);
#else
    a.ph_lo = 0; a.ph_hi = 1; a.b0 = 0;
    hipLaunchKernelGGL(fwd_kernel, dim3(grid), dim3(512), LDS_BYTES, stream, a);
    for (int b0 = 0; b0 < BATCH; b0 += CH_B)
        for (int ph = 1; ph < NPHASE; ++ph) { a.ph_lo = ph; a.ph_hi = ph + 1; a.b0 = b0; hipLaunchKernelGGL(fwd_kernel, dim3(grid), dim3(512), LDS_BYTES, stream, a); }
#endif
}
```

```cpp
#include <hip/hip_runtime.h>
#include <cstdint>
#include <cstdio>

#ifndef GOLD
#define GOLD 0
#endif
#ifndef PROBE_PH
#define PROBE_PH -1
#endif
#ifndef PROBE_N
#define PROBE_N 2
#endif
#ifndef ONE_LAUNCH
#define ONE_LAUNCH 1
#endif

typedef unsigned short bf16_t;
typedef short bf16x8 __attribute__((ext_vector_type(8)));
typedef short s16x4 __attribute__((ext_vector_type(4)));
typedef float f32x4 __attribute__((ext_vector_type(4)));
typedef float f32x16 __attribute__((ext_vector_type(16)));
typedef unsigned u32x2 __attribute__((ext_vector_type(2)));
typedef unsigned u32x4 __attribute__((ext_vector_type(4)));
typedef float f32x2 __attribute__((ext_vector_type(2)));

#if GOLD
typedef float act_t;
#else
typedef bf16_t act_t;
#endif
constexpr int AS = sizeof(act_t);

constexpr int DM = 1024, BATCH = 8, SEQ = 2048, CTXL = 256, NH = 16, NKV = 4, HD = 64;
constexpr int INW = 4608, PQW = 2048, NEXP = 16384;
constexpr int CONV_CH = 512, CONV_W = 31;
constexpr float EPS = 1e-6f;
constexpr float LOG2E = 1.4426950408889634f;
constexpr float QS = 0.125f * LOG2E;
#if GOLD
constexpr int CH_B = 1;
#else
constexpr int CH_B = 8;
#endif
constexpr int T_ = CH_B * SEQ;
constexpr int CT_ = CH_B * CTXL;
constexpr int NPHASE = 10;

constexpr size_t MiB = 1u << 20;
constexpr size_t WS_CTL = 0, CTL_BYTES = 1 * MiB;
constexpr size_t WS_MOD = 512 * 1024;
constexpr size_t WS_ROPE = 1 * MiB;
constexpr size_t WS_WIN = 2 * MiB;
constexpr size_t WS_WOA = 22 * MiB;
constexpr size_t WS_WOC = 26 * MiB;
constexpr size_t WS_WOUT = 28 * MiB;
constexpr size_t WS_WQ = 32 * MiB;
constexpr size_t WS_KEYS = 40 * MiB;
constexpr size_t AR = 42 * MiB;
constexpr size_t A0 = AR;
constexpr size_t O_Q = A0;
constexpr size_t O_K = O_Q + (size_t)T_ * 1024 * AS;
constexpr size_t O_VT = O_K + (size_t)T_ * 256 * AS;
constexpr size_t O_U = O_VT + (size_t)T_ * 256 * AS;
constexpr size_t O_SG = O_U + (size_t)T_ * 512 * AS;
constexpr size_t O_KC = O_SG + (size_t)T_ * 2048 * AS;
constexpr size_t O_VTC = O_KC + (size_t)CT_ * 256 * AS;
constexpr size_t A0_END = O_VTC + (size_t)CT_ * 256 * AS;
constexpr size_t O_MIXED = A0;
constexpr size_t O_PQ = A0 + (size_t)T_ * 4096;
constexpr size_t O_TOPV = A0;
constexpr size_t O_TOPI = A0 + (size_t)T_ * 1024;
constexpr size_t O_PV = A0 + 32 * MiB;
constexpr size_t A1 = A0_END;
constexpr size_t O_ATT = A1;
constexpr size_t O_CACT = O_ATT + (size_t)T_ * 1024 * AS;
constexpr size_t A1_END = O_CACT + (size_t)T_ * 512 * AS;
constexpr size_t O_HX = A1;
constexpr size_t O_HC = A1 + (size_t)T_ * 1024 * AS;
constexpr size_t O_PU = A1;
constexpr size_t O_PEI = O_CACT;
constexpr size_t O_PEG = O_CACT + (size_t)T_ * 512;
constexpr size_t A2 = A1_END;
constexpr size_t O_M = A2;
constexpr size_t O_H2 = A2;
constexpr size_t WS_END = A2 + (size_t)T_ * 1024 * AS;
static_assert(O_PQ + (size_t)T_ * 2048 * AS <= A0_END, "pq overlay");
static_assert(O_TOPI + (size_t)T_ * 1024 <= O_PQ, "topk overlay");
static_assert(GOLD || (O_PV >= O_TOPI + (size_t)T_ * 1024 && O_PV + 32 * MiB <= O_PQ), "pv overlay");
static_assert(GOLD || (O_PU + 32 * MiB <= O_PEI), "pu overlay");
static_assert(O_PEG + (size_t)T_ * 512 <= A1_END, "pe overlay");
static_assert(O_HC + (size_t)CT_ * 1024 * AS <= A1_END, "hc overlay");

constexpr int LDS_BYTES = 147456;
constexpr int LDS_MISC = LDS_BYTES - 256;

__device__ __forceinline__ float bf2f(bf16_t h) { return __uint_as_float((unsigned)h << 16); }
__device__ __forceinline__ unsigned f2bf(float f) { unsigned u = __float_as_uint(f); return (u + 0x7fffu + ((u >> 16) & 1u)) >> 16; }
__device__ __forceinline__ unsigned pk2(float lo, float hi) { return f2bf(lo) | (f2bf(hi) << 16); }
#if GOLD
__device__ __forceinline__ float ld_act(const act_t* p) { return *p; }
__device__ __forceinline__ void st_act(act_t* p, float v) { *p = v; }
__device__ __forceinline__ f32x4 ld4(const act_t* p) { return *(const f32x4*)p; }
__device__ __forceinline__ void st4(act_t* p, f32x4 v) { *(f32x4*)p = v; }
#else
__device__ __forceinline__ float ld_act(const act_t* p) { return bf2f(*p); }
__device__ __forceinline__ void st_act(act_t* p, float v) { *p = (bf16_t)f2bf(v); }
__device__ __forceinline__ f32x4 ld4(const act_t* p) { u32x2 w = *(const u32x2*)p; f32x4 r; r[0] = __uint_as_float(w[0] << 16); r[1] = __uint_as_float(w[0] & 0xffff0000u); r[2] = __uint_as_float(w[1] << 16); r[3] = __uint_as_float(w[1] & 0xffff0000u); return r; }
__device__ __forceinline__ void st4(act_t* p, f32x4 v) { u32x2 w; w[0] = pk2(v[0], v[1]); w[1] = pk2(v[2], v[3]); *(u32x2*)p = w; }
#endif
__device__ __forceinline__ float wave_sum(float v) {
#pragma unroll
    for (int o = 1; o < 64; o <<= 1) v += __shfl_xor(v, o);
    return v;
}
__device__ __forceinline__ float wave_max(float v) {
#pragma unroll
    for (int o = 1; o < 64; o <<= 1) v = fmaxf(v, __shfl_xor(v, o));
    return v;
}
__device__ __forceinline__ float sigmoidf_(float x) { return 1.0f / (1.0f + expf(-x)); }
__device__ __forceinline__ int crow(int r, int hi) { return (r & 3) + 8 * (r >> 2) + 4 * hi; }

#define LAS __attribute__((address_space(3)))
#define XB_TMO      128
#define XB_XCNT(j)  (256  + 64 * (j))
#define XB_XSUB(j)  (1280 + 64 * (j))
#define XB_XGEN(j)  (2304 + 64 * (j))
#define XB_TOP      3328
#define XB_TOPGEN   3392
#define XCD_BAR_WORDS 3456
#define XB_SPIN_CAP (1u << 18)
__device__ __forceinline__ unsigned xb_ld(unsigned* p)              { return __hip_atomic_load(p, __ATOMIC_RELAXED, __HIP_MEMORY_SCOPE_AGENT); }
__device__ __forceinline__ unsigned xb_add(unsigned* p, unsigned v) { return __hip_atomic_fetch_add(p, v, __ATOMIC_RELAXED, __HIP_MEMORY_SCOPE_AGENT); }
__device__ __forceinline__ unsigned xb_xcc_id() { return (unsigned)__builtin_amdgcn_s_getreg((3 << 11) | 20) & 0xFu; }
#define XB_SPIN(cond, bar) do { unsigned _sp = 0; while (cond) { __builtin_amdgcn_s_sleep(1); \
    if ((++_sp & 255u) == 0u) { if (xb_ld(&(bar)[XB_TMO])) break; if (_sp > XB_SPIN_CAP) { atomicAdd(&(bar)[XB_TMO], 1u); break; } } } } while (0)
struct XcdBarrier { unsigned* bar; unsigned x; volatile LAS unsigned* st; };
__device__ __forceinline__ XcdBarrier xcd_barrier_post(unsigned* bar, volatile LAS unsigned* st) {
    XcdBarrier b; b.bar = bar; b.x = xb_xcc_id(); b.st = st;
    if (threadIdx.x == 0) (void)xb_add(&bar[XB_XCNT(b.x)], 1u);
    return b;
}
__device__ __forceinline__ void xcd_barrier_complete(unsigned* bar, unsigned x, unsigned& nloc, unsigned& nx) {
    const unsigned G = gridDim.x * gridDim.y * gridDim.z;
    unsigned sum, cnt, mine, sp = 0u;
    for (;;) {
        sum = 0u; cnt = 0u; mine = 0u;
#pragma unroll
        for (unsigned j = 0; j < 16; ++j) { const unsigned c = xb_ld(&bar[XB_XCNT(j)]); sum += c; cnt += (c > 0u) ? 1u : 0u; mine = (j == x) ? c : mine; }
        if (sum == G) break;
        __builtin_amdgcn_s_sleep(1);
        if ((++sp & 255u) == 0u) { if (xb_ld(&bar[XB_TMO])) break; if (sp > XB_SPIN_CAP) { atomicAdd(&bar[XB_TMO], 1u); break; } }
    }
    nloc = mine > 0u ? mine : 1u; nx = cnt > 0u ? cnt : 1u;
}
__device__ __forceinline__ void xcd_barrier(const XcdBarrier& b) {
    asm volatile("s_waitcnt vmcnt(0)" ::: "memory");
    __syncthreads();
    if (threadIdx.x == 0) {
        unsigned* bar = b.bar;
        __builtin_amdgcn_s_waitcnt(0);
        unsigned nloc = b.st[0], nx = b.st[1];
        if (nloc == 0u) { xcd_barrier_complete(bar, b.x, nloc, nx); b.st[0] = nloc; b.st[1] = nx; }
        const unsigned old = xb_add(&bar[XB_XSUB(b.x)], 1u);
        const unsigned gen = old / nloc;
        if (old + 1u == (gen + 1u) * nloc) {
            __builtin_amdgcn_fence(__ATOMIC_RELEASE, "agent");
            asm volatile("s_waitcnt vmcnt(0)" ::: "memory");
            const unsigned og = xb_add(&bar[XB_TOP], 1u);
            const unsigned tg = og / nx;
            if (og + 1u == (tg + 1u) * nx) xb_add(&bar[XB_TOPGEN], 1u);
            else XB_SPIN(xb_ld(&bar[XB_TOPGEN]) == tg, bar);
            __builtin_amdgcn_fence(__ATOMIC_ACQUIRE, "agent");
            xb_add(&bar[XB_XGEN(b.x)], 1u);
            asm volatile("s_waitcnt vmcnt(0)" ::: "memory");
        } else {
            XB_SPIN(xb_ld(&bar[XB_XGEN(b.x)]) == gen, bar);
            __builtin_amdgcn_fence(__ATOMIC_ACQUIRE, "agent");
            asm volatile("s_waitcnt vmcnt(0)" ::: "memory");
        }
    }
    __syncthreads();
}

struct Args { const float* in[23]; float* out; unsigned char* ws; int ph_lo, ph_hi, b0, pad; };

struct Frame {
    unsigned char* lds;
    int tid, lane, wid, G, bid;
    int b0;
    const float *x, *c, *ctx, *c_ctx, *w_ada, *b_ada, *g_pre_mix, *g_post_mix, *g_pre_ffn, *g_post_ffn, *w_in, *sink, *w_o_attn,
        *conv_dw, *conv_dw_b, *conv_ln_g, *conv_ln_b, *w_o_conv, *w_out, *peer_wq, *peer_keys, *peer_u, *peer_v;
    float* out;
    float* mod; float* rope;
    act_t *win_t, *woa_t, *woc_t, *wout_t, *wq_t, *keys_t;
    act_t *q, *k, *vT, *u, *sg, *kc, *vTc, *att, *cact, *hx, *hc, *m, *h2, *pq;
    float *mixed, *topv, *peg; int *topi, *pei;
    unsigned char *pu8, *pv8;
};

constexpr int BK = 32;
#if GOLD
constexpr int LDT = 36;
#else
constexpr int LDT = 40;
#endif
constexpr int TILE_LDS = 128 * LDT * AS;
constexpr int GEMM_LDS = 2 * TILE_LDS;

__device__ __forceinline__ void acc_zero(f32x4 (&acc)[2][4]) {
#pragma unroll
    for (int i = 0; i < 2; ++i)
#pragma unroll
        for (int j = 0; j < 4; ++j) acc[i][j] = (f32x4){0.f, 0.f, 0.f, 0.f};
}

__device__ __forceinline__ void mma_tile(f32x4 (&acc)[2][4], unsigned char* lds, const act_t* __restrict__ A, int lda,
                                         const act_t* __restrict__ Bt, int ldb, int K, int m0, int n0) {
    const int tid = threadIdx.x, lane = tid & 63, wid = tid >> 6, wm = wid >> 1, wn = wid & 1, fr = lane & 15, fq = lane >> 4;
    act_t* As = (act_t*)lds; act_t* Bs = (act_t*)(lds + TILE_LDS);
    constexpr int EPC = 16 / AS, CPR = BK / EPC, NCH = 128 * CPR / 512;
    u32x4 ra[NCH], rb[NCH];
#pragma unroll
    for (int i = 0; i < NCH; ++i) { const int cidx = tid + 512 * i, row = cidx / CPR, ch = cidx % CPR;
        ra[i] = *(const u32x4*)(A + (size_t)(m0 + row) * lda + ch * EPC);
        rb[i] = *(const u32x4*)(Bt + (size_t)(n0 + row) * ldb + ch * EPC); }
    const int nk = K / BK;
    for (int kt = 0; kt < nk; ++kt) {
        __syncthreads();
#pragma unroll
        for (int i = 0; i < NCH; ++i) { const int cidx = tid + 512 * i, row = cidx / CPR, ch = cidx % CPR;
            *(u32x4*)(As + row * LDT + ch * EPC) = ra[i];
            *(u32x4*)(Bs + row * LDT + ch * EPC) = rb[i]; }
        __syncthreads();
        if (kt + 1 < nk) {
            const int k1 = (kt + 1) * BK;
#pragma unroll
            for (int i = 0; i < NCH; ++i) { const int cidx = tid + 512 * i, row = cidx / CPR, ch = cidx % CPR;
                ra[i] = *(const u32x4*)(A + (size_t)(m0 + row) * lda + k1 + ch * EPC);
                rb[i] = *(const u32x4*)(Bt + (size_t)(n0 + row) * ldb + k1 + ch * EPC); }
        }
#if GOLD
        f32x4 a4[2][2], b4[4][2];
#pragma unroll
        for (int mi = 0; mi < 2; ++mi)
#pragma unroll
            for (int g = 0; g < 2; ++g) a4[mi][g] = *(const f32x4*)(As + (wm * 32 + mi * 16 + fr) * LDT + 16 * g + 4 * fq);
#pragma unroll
        for (int ni = 0; ni < 4; ++ni)
#pragma unroll
            for (int g = 0; g < 2; ++g) b4[ni][g] = *(const f32x4*)(Bs + (wn * 64 + ni * 16 + fr) * LDT + 16 * g + 4 * fq);
#pragma unroll
        for (int mi = 0; mi < 2; ++mi)
#pragma unroll
            for (int ni = 0; ni < 4; ++ni)
#pragma unroll
                for (int g = 0; g < 2; ++g)
#pragma unroll
                    for (int j = 0; j < 4; ++j) acc[mi][ni] = __builtin_amdgcn_mfma_f32_16x16x4f32(b4[ni][g][j], a4[mi][g][j], acc[mi][ni], 0, 0, 0);
#else
        bf16x8 af[2], bfr[4];
#pragma unroll
        for (int mi = 0; mi < 2; ++mi) af[mi] = *(const bf16x8*)(As + (wm * 32 + mi * 16 + fr) * LDT + fq * 8);
#pragma unroll
        for (int ni = 0; ni < 4; ++ni) bfr[ni] = *(const bf16x8*)(Bs + (wn * 64 + ni * 16 + fr) * LDT + fq * 8);
#pragma unroll
        for (int mi = 0; mi < 2; ++mi)
#pragma unroll
            for (int ni = 0; ni < 4; ++ni) acc[mi][ni] = __builtin_amdgcn_mfma_f32_16x16x32_bf16(bfr[ni], af[mi], acc[mi][ni], 0, 0, 0);
#endif
    }
}
template <class F> __device__ __forceinline__ void epi_foreach(const f32x4 (&acc)[2][4], int m0, int n0, F f) {
    const int tid = threadIdx.x, lane = tid & 63, wid = tid >> 6, wm = wid >> 1, wn = wid & 1, fr = lane & 15, fq = lane >> 4;
#pragma unroll
    for (int mi = 0; mi < 2; ++mi)
#pragma unroll
        for (int gp = 0; gp < 2; ++gp) f(m0 + wm * 32 + mi * 16 + fr, n0 + wn * 64 + gp * 32 + 4 * fq, acc[mi][2 * gp], acc[mi][2 * gp + 1]);
}


#if !GOLD
namespace pg8 {
#define PG8_LAS __attribute__((address_space(3)))
typedef unsigned short bf16_t;
typedef short bf16x8 __attribute__((ext_vector_type(8)));
typedef float f32x4 __attribute__((ext_vector_type(4)));
typedef unsigned u32x4 __attribute__((ext_vector_type(4)));
constexpr int BM = 256, BK = 64, HALF = 128, HTB = HALF * BK * 2  , STAGE_BYTES = 8 * HTB, NXCD = 8, WGM = 8;

__host__ __device__ __forceinline__ int lds_byte(int r, int c) { const int st = (r >> 4) * 2 + (c >> 5), rr = r & 15, cc = c & 31, ob = rr * 64 + cc * 2; return st * 1024 + (ob ^ (((ob >> 9) & 1) << 5)); }
__host__ __device__ __forceinline__ void stage_rc(int b, int& R, int& C) { const int st = b / 1024, sb = b % 1024, swz = sb ^ (((sb >> 9) & 1) << 5); R = (st >> 1) * 16 + swz / 64; C = (st & 1) * 32 + (swz % 64) / 2; }
__host__ __device__ __forceinline__ int perm32(int rho) { const int n = rho >> 4, i = rho & 15; return 8 * (i >> 2) + 4 * n + (i & 3); }

struct Unit { int pm, pn; };
struct Gemm { const bf16_t* A; const bf16_t* Bt; int M, N, K; };

struct StaticOrder {
    int nM, nN, nwg, G, c;
    __host__ __device__ void init(int M, int N, int G_, int c_) { nM = M / BM; nN = N / BM; nwg = nM * nN; G = G_; c = c_; }
    __host__ __device__ bool next(int i, Unit& u) const {
        const long L = (long)i * G + c; if (L >= nwg) return false;
        int wgid = (int)L; { const int q = nwg / NXCD, r = nwg % NXCD, xcd = wgid % NXCD, off = wgid / NXCD; wgid = (xcd < r ? xcd * (q + 1) : r * (q + 1) + (xcd - r) * q) + off; }
        const int nig = WGM * nN, gid = wgid / nig, fm = gid * WGM, gsz = (nM - fm) < WGM ? (nM - fm) : WGM;
        u.pm = fm + ((wgid % nig) % gsz); u.pn = (wgid % nig) / gsz; return true;
    }
    __device__ __forceinline__ void a_ready(const Unit&) const {}
    __device__ __forceinline__ void done(const Unit&) const {}
};
template <class Epi, class Sched, bool ALIGN_EPI = false, bool SP2 = false>
__device__ __forceinline__ void gemm_phase(PG8_LAS unsigned char* lds, const Gemm g, const Sched& S, const Epi& E) {
    const int tid = threadIdx.x, wid = __builtin_amdgcn_readfirstlane(tid >> 6), lane = tid & 63, wr = wid >> 2, wc = wid & 3, fr = lane & 15, fq = lane >> 4;
    const int K = g.K, nt = K / BK;
    unsigned voffA[2], voffB[2];
#pragma unroll
    for (int i = 0; i < 2; ++i) { int R, C; stage_rc(tid * 16 + i * 8192, R, C); const int Rb = Epi::PERM ? ((R & ~31) + perm32(R & 31)) : R;
        voffA[i] = (unsigned)(R * K + C) * 2u; voffB[i] = (unsigned)(Rb * K + C) * 2u; }
    const size_t kstep = (size_t)(BK * 2);
    const size_t hstep = (size_t)HALF * K * 2;
    const size_t tstep = 2 * hstep;
    const unsigned ldsw = (unsigned)wid * 1024u;
    const int aoff = lds_byte(wr * 64 + fr, fq * 8), boff = lds_byte(wc * 32 + fr, fq * 8);
#define PG8_SA(b, h) (((b) * 2 + (h)) * HTB)
#define PG8_SB(b, h) ((4 + (b) * 2 + (h)) * HTB)
#define PG8_STAGE(bufoff, gbase, voff) do { _Pragma("unroll") for (int _i = 0; _i < 2; ++_i) \
        __builtin_amdgcn_global_load_lds((const unsigned*)((const char*)(gbase) + (voff)[_i]), (PG8_LAS unsigned*)(lds + (bufoff) + ldsw + _i * 8192), 16, 0, 0); } while (0)
#define PG8_LDA(dst, b, h) do { _Pragma("unroll") for (int m = 0; m < 4; ++m) _Pragma("unroll") for (int k = 0; k < 2; ++k) dst[m][k] = *(const PG8_LAS bf16x8*)(lds + PG8_SA(b, h) + aoff + m * 2048 + k * 1024); } while (0)
#define PG8_LDB(dst, b, h) do { _Pragma("unroll") for (int n = 0; n < 2; ++n) _Pragma("unroll") for (int k = 0; k < 2; ++k) dst[n][k] = *(const PG8_LAS bf16x8*)(lds + PG8_SB(b, h) + boff + n * 2048 + k * 1024); } while (0)
#define PG8_MMA(ai, bj, At, Bt) do { __builtin_amdgcn_s_setprio(1); _Pragma("unroll") for (int m = 0; m < 4; ++m) _Pragma("unroll") for (int n = 0; n < 2; ++n) _Pragma("unroll") for (int k = 0; k < 2; ++k) \
        acc[ai][bj][m][n] = __builtin_amdgcn_mfma_f32_16x16x32_bf16(Bt[n][k], At[m][k], acc[ai][bj][m][n], 0, 0, 0); __builtin_amdgcn_s_setprio(0); } while (0)
#define PG8_WAIT_V(n) asm volatile("s_waitcnt vmcnt(" #n ")" ::: "memory")
#define PG8_WAIT_L(n) asm volatile("s_waitcnt lgkmcnt(" #n ")" ::: "memory")
#define PG8_BAR __builtin_amdgcn_s_barrier()
#define PG8_SCHED __builtin_amdgcn_sched_barrier(0)
    Unit cur, nxt; int ui = 0;
    if (!S.next(0, cur)) return;
    f32x4 acc[2][2][4][2];
#pragma unroll
    for (int a = 0; a < 2; ++a)
#pragma unroll
        for (int b = 0; b < 2; ++b)
#pragma unroll
            for (int m = 0; m < 4; ++m)
#pragma unroll
                for (int n = 0; n < 2; ++n) acc[a][b][m][n] = (f32x4){0.f, 0.f, 0.f, 0.f};
    bf16x8 At[4][2], B0[2][2], B1[2][2];
    const char* cA = (const char*)g.A + (size_t)cur.pm * tstep; const char* cB = (const char*)g.Bt + (size_t)cur.pn * tstep;
    S.a_ready(cur);
    if constexpr (SP2) {
        PG8_STAGE(PG8_SB(0, 0), cB, voffB); PG8_STAGE(PG8_SB(0, 1), cB + hstep, voffB); PG8_STAGE(PG8_SA(0, 0), cA, voffA); PG8_STAGE(PG8_SA(0, 1), cA + hstep, voffA);
        if (wr == 1) PG8_BAR;
        PG8_WAIT_V(2); PG8_BAR;
        PG8_STAGE(PG8_SB(1, 0), cB + kstep, voffB); PG8_STAGE(PG8_SA(1, 0), cA + kstep, voffA); PG8_STAGE(PG8_SB(1, 1), cB + hstep + kstep, voffB);
        PG8_WAIT_V(6); PG8_BAR;
    } else {
        PG8_STAGE(PG8_SB(0, 0), cB, voffB); PG8_STAGE(PG8_SA(0, 0), cA, voffA); PG8_STAGE(PG8_SB(0, 1), cB + hstep, voffB); PG8_STAGE(PG8_SA(0, 1), cA + hstep, voffA);
        if (wr == 1) PG8_BAR;
        PG8_WAIT_V(4); PG8_BAR;
        PG8_STAGE(PG8_SB(1, 0), cB + kstep, voffB); PG8_STAGE(PG8_SA(1, 0), cA + kstep, voffA); PG8_STAGE(PG8_SB(1, 1), cB + hstep + kstep, voffB);
        PG8_WAIT_V(6); PG8_BAR;
    }
    for (;;) {
        const bool has_next = S.next(ui + 1, nxt);
        const char* nA = has_next ? (const char*)g.A + (size_t)nxt.pm * tstep : cA; const char* nB = has_next ? (const char*)g.Bt + (size_t)nxt.pn * tstep : cB;
        for (int t = 0; t < nt; t += 2) {
            const bool last = (t == nt - 2);
            const char* a1 = cA + (size_t)(t + 1) * kstep;
            const char* a2 = last ? nA : cA + (size_t)(t + 2) * kstep; const char* b2 = last ? nB : cB + (size_t)(t + 2) * kstep;
            const char* a3 = a2 + kstep; const char* b3 = b2 + kstep;
            if (last && has_next) S.a_ready(nxt);
            if constexpr (SP2) {
            PG8_LDB(B0, 0, 0); PG8_LDB(B1, 0, 1); PG8_SCHED; PG8_LDA(At, 0, 0); PG8_STAGE(PG8_SA(1, 1), a1 + hstep, voffA);
            PG8_WAIT_V(8); PG8_WAIT_L(0); PG8_BAR; PG8_MMA(0, 0, At, B0); PG8_MMA(0, 1, At, B1); PG8_BAR; PG8_SCHED;
            PG8_LDA(At, 0, 1); PG8_STAGE(PG8_SB(0, 0), b2, voffB); PG8_STAGE(PG8_SB(0, 1), b2 + hstep, voffB); PG8_STAGE(PG8_SA(0, 0), a2, voffA);
            PG8_WAIT_V(8); PG8_WAIT_L(0); PG8_BAR; PG8_MMA(1, 0, At, B0); PG8_MMA(1, 1, At, B1); PG8_BAR; PG8_SCHED;
            PG8_LDB(B0, 1, 0); PG8_LDB(B1, 1, 1); PG8_SCHED; PG8_LDA(At, 1, 0); PG8_STAGE(PG8_SA(0, 1), a2 + hstep, voffA);
            PG8_WAIT_V(8); PG8_WAIT_L(0); PG8_BAR; PG8_MMA(0, 0, At, B0); PG8_MMA(0, 1, At, B1); PG8_BAR; PG8_SCHED;
            PG8_LDA(At, 1, 1); PG8_STAGE(PG8_SB(1, 0), b3, voffB); PG8_STAGE(PG8_SB(1, 1), b3 + hstep, voffB); PG8_STAGE(PG8_SA(1, 0), a3, voffA);
            PG8_WAIT_V(8); PG8_WAIT_L(0); PG8_BAR; PG8_MMA(1, 0, At, B0); PG8_MMA(1, 1, At, B1); PG8_BAR; PG8_SCHED;
            } else {
            PG8_LDB(B0, 0, 0); PG8_SCHED; PG8_LDA(At, 0, 0); PG8_STAGE(PG8_SA(1, 1), a1 + hstep, voffA);
            PG8_WAIT_L(8); PG8_BAR; PG8_WAIT_L(0); PG8_MMA(0, 0, At, B0); PG8_BAR; PG8_SCHED;
            PG8_LDB(B1, 0, 1); PG8_STAGE(PG8_SB(0, 0), b2, voffB);
            PG8_BAR; PG8_WAIT_L(0); PG8_MMA(0, 1, At, B1); PG8_BAR;
            PG8_LDA(At, 0, 1); PG8_STAGE(PG8_SA(0, 0), a2, voffA);
            PG8_BAR; PG8_WAIT_L(0); PG8_MMA(1, 0, At, B0); PG8_BAR; PG8_SCHED;
            PG8_STAGE(PG8_SB(0, 1), b2 + hstep, voffB);
            PG8_WAIT_V(6); PG8_BAR; PG8_MMA(1, 1, At, B1); PG8_BAR;
            PG8_LDB(B0, 1, 0); PG8_SCHED; PG8_LDA(At, 1, 0); PG8_STAGE(PG8_SA(0, 1), a2 + hstep, voffA);
            PG8_WAIT_L(8); PG8_BAR; PG8_WAIT_L(0); PG8_MMA(0, 0, At, B0); PG8_BAR; PG8_SCHED;
            PG8_LDB(B1, 1, 1); PG8_STAGE(PG8_SB(1, 0), b3, voffB);
            PG8_BAR; PG8_WAIT_L(0); PG8_MMA(0, 1, At, B1); PG8_BAR;
            PG8_LDA(At, 1, 1); PG8_STAGE(PG8_SA(1, 0), a3, voffA);
            PG8_BAR; PG8_WAIT_L(0); PG8_MMA(1, 0, At, B0); PG8_BAR; PG8_SCHED;
            PG8_STAGE(PG8_SB(1, 1), b3 + hstep, voffB);
            PG8_WAIT_V(6); PG8_BAR; PG8_MMA(1, 1, At, B1); PG8_BAR;
            }
        }
        if constexpr (ALIGN_EPI) { if (wr == 0) PG8_BAR; }
        if constexpr (!Epi::AFTER_DRAIN) { E(acc, cur, wr, wc, fr, fq); S.done(cur); }
        if (!has_next) break;
#pragma unroll
        for (int a = 0; a < 2; ++a)
#pragma unroll
            for (int b = 0; b < 2; ++b)
#pragma unroll
                for (int m = 0; m < 4; ++m)
#pragma unroll
                    for (int n = 0; n < 2; ++n) acc[a][b][m][n] = (f32x4){0.f, 0.f, 0.f, 0.f};
        cur = nxt; cA = nA; cB = nB; ++ui;
        if constexpr (ALIGN_EPI) { if (wr == 1) PG8_BAR; }
    }
    PG8_WAIT_V(0);
    if constexpr (!ALIGN_EPI) { if (wr == 0) PG8_BAR; }
    PG8_BAR;
    if constexpr (Epi::AFTER_DRAIN) { E.fused(acc, cur, wr, wc, fr, fq, lds, wid, lane); S.done(cur); }
#undef PG8_SA
#undef PG8_SB
#undef PG8_STAGE
#undef PG8_LDA
#undef PG8_LDB
#undef PG8_MMA
#undef PG8_WAIT_V
#undef PG8_WAIT_L
#undef PG8_BAR
#undef PG8_SCHED
}
}

template <class Fn> struct EpiFn {
    static constexpr bool PERM = false, AFTER_DRAIN = false;
    Fn f;
    __device__ __forceinline__ void operator()(const f32x4 (&acc)[2][2][4][2], const pg8::Unit& u, int wr, int wc, int fr, int fq) const {
#pragma unroll
        for (int ai = 0; ai < 2; ++ai)
#pragma unroll
            for (int m = 0; m < 4; ++m) { const int row = u.pm * 256 + ai * 128 + wr * 64 + m * 16 + fr;
#pragma unroll
                for (int bj = 0; bj < 2; ++bj) f(row, u.pn * 256 + bj * 128 + wc * 32 + 4 * fq, acc[ai][bj][m][0], acc[ai][bj][m][1]); }
    }
};
struct InOrder : pg8::StaticOrder {
    int repn;
    __device__ bool next(int i, pg8::Unit& u) const {
        const int ii = i / repn; const long L = (long)ii * G + c;
        if (L < nwg) return pg8::StaticOrder::next(ii, u);
        const int x = (int)(L - nwg); if (x >= (CT_ / 256) * 2) return false;
        u.pm = T_ / 256 + (x >> 1); u.pn = 4 + (x & 1); return true;
    }
};
struct RepOrder : pg8::StaticOrder {
    int repn;
    __device__ bool next(int i, pg8::Unit& u) const { return pg8::StaticOrder::next(i / repn, u); }
};
template <int PH, class Fn> __device__ __forceinline__ void run_gemm(const Frame& F, const act_t* A, const act_t* Bt, int M, int N, int K, Fn fn) {
    const pg8::Gemm g{A, Bt, M, N, K}; RepOrder S; S.init(M, N, F.G, F.bid); S.repn = (PROBE_PH == PH) ? PROBE_N : 1;
    const EpiFn<Fn> E{fn};
    pg8::gemm_phase<EpiFn<Fn>, RepOrder, true, true>((PG8_LAS unsigned char*)F.lds, g, S, E);
}
__device__ __forceinline__ float fsig(float x) { return __builtin_amdgcn_rcpf(1.0f + __builtin_amdgcn_exp2f(-LOG2E * x)); }
#else
__device__ __forceinline__ float fsig(float x) { return 1.0f / (1.0f + expf(-x)); }
#endif

__device__ __forceinline__ void p0_adaln_item(const Frame& F, int item) {
    float* sc = (float*)F.lds;
    float* part = sc + 9 * 1024;
    __syncthreads();
    for (int e = F.tid; e < 9 * 1024; e += 512) { const int r = e >> 10, kk = e & 1023; const float v = (r < 8) ? F.c[r * DM + kk] : F.c_ctx[kk]; sc[e] = v / (1.0f + expf(-v)); }
    __syncthreads();
    const int col = item * 64 + F.lane, kg = F.wid;
    float a[9];
#pragma unroll
    for (int r = 0; r < 9; ++r) a[r] = 0.f;
    for (int kk = kg * 128; kk < kg * 128 + 128; ++kk) {
        const float w = F.w_ada[(size_t)kk * 6144 + col];
#pragma unroll
        for (int r = 0; r < 9; ++r) a[r] += sc[r * 1024 + kk] * w;
    }
#pragma unroll
    for (int r = 0; r < 9; ++r) part[(kg * 9 + r) * 64 + F.lane] = a[r];
    __syncthreads();
    for (int e = F.tid; e < 9 * 64; e += 512) { const int r = e >> 6, cl = e & 63; float s = F.b_ada[item * 64 + cl];
#pragma unroll
        for (int g = 0; g < 8; ++g) s += part[(g * 9 + r) * 64 + cl];
        F.mod[r * 6144 + item * 64 + cl] = s; }
}
template <class CM> __device__ __forceinline__ void p0_transpose_item(const Frame& F, const float* W, int K, int Nsrc, act_t* dst, int item, int ntn, CM cmap) {
    float* tl = (float*)F.lds;
    const int kb = item / ntn, nb = item % ntn, k0 = kb * 64, n0 = nb * 64;
    __syncthreads();
    { const int n4 = F.tid & 15, kk0 = F.tid >> 4; const int sc = cmap(n0 + 4 * n4);
#pragma unroll
      for (int i = 0; i < 2; ++i) { const int kk = kk0 + 32 * i; const f32x4 v = *(const f32x4*)(W + (size_t)(k0 + kk) * Nsrc + sc);
          tl[kk * 65 + 4 * n4] = v[0]; tl[kk * 65 + 4 * n4 + 1] = v[1]; tl[kk * 65 + 4 * n4 + 2] = v[2]; tl[kk * 65 + 4 * n4 + 3] = v[3]; } }
    __syncthreads();
    { const int k8 = F.tid & 7, n = F.tid >> 3;
      act_t* d = dst + (size_t)(n0 + n) * K + k0 + 8 * k8;
      f32x4 a, b;
#pragma unroll
      for (int i = 0; i < 4; ++i) { a[i] = tl[(8 * k8 + i) * 65 + n]; b[i] = tl[(8 * k8 + 4 + i) * 65 + n]; }
      st4(d, a); st4(d + 4, b); }
}
__device__ __forceinline__ int cmap_in(int n) {
    if (n < 1536 || n >= 2560) return n;
    const int g = (n - 1536) >> 5, e = n & 31;
    return (e < 16) ? (1536 + 16 * g + e) : (2048 + 16 * g + (e - 16));
}
__device__ __forceinline__ void p0_prep(const Frame& F) {
    for (int it = F.bid; it < 96; it += F.G) p0_adaln_item(F, it);
    constexpr int I_IN = 16 * 72, I_OA = 16 * 16, I_OC = 8 * 16, I_OUT = 16 * 16, I_WQ = 16 * 32;
    constexpr int NIT = I_IN + I_OA + I_OC + I_OUT + I_WQ;
    auto ident = [](int n) { return n; };
    for (int it = F.bid; it < NIT; it += F.G) {
        int r = it;
        if (r < I_IN) { p0_transpose_item(F, F.w_in, 1024, INW, F.win_t, r, 72, [](int n) { return cmap_in(n); }); continue; } r -= I_IN;
        if (r < I_OA) { p0_transpose_item(F, F.w_o_attn, 1024, 1024, F.woa_t, r, 16, ident); continue; } r -= I_OA;
        if (r < I_OC) { p0_transpose_item(F, F.w_o_conv, 512, 1024, F.woc_t, r, 16, ident); continue; } r -= I_OC;
        if (r < I_OUT) { p0_transpose_item(F, F.w_out, 1024, 1024, F.wout_t, r, 16, ident); continue; } r -= I_OUT;
        p0_transpose_item(F, F.peer_wq, 1024, PQW, F.wq_t, r, 32, ident);
    }
    for (int e = F.bid * 512 + F.tid; e < 16 * 128 * 128; e += F.G * 512) st_act(F.keys_t + e, F.peer_keys[e]);
    for (int e = F.bid * 512 + F.tid; e < 64 * 16; e += F.G * 512) {
        const int pos = e >> 4, f = e & 15;
        const float freq = powf(10000.0f, -(float)(2 * f) / 32.0f);
        const float ang = (float)pos * freq;
        const double TWO_PI = 6.283185307179586476925286766559;
        double r = (double)ang; r -= TWO_PI * rint(r / TWO_PI);
        const double r2 = r * r;
        double sn = 0.0, cs = 0.0;
        double ts = r, tc = 1.0;
#pragma unroll 1
        for (int n = 0; n < 14; ++n) { sn += ts; cs += tc; ts *= -r2 / (double)((2 * n + 2) * (2 * n + 3)); tc *= -r2 / (double)((2 * n + 1) * (2 * n + 2)); }
        F.rope[e * 2] = (float)cs; F.rope[e * 2 + 1] = (float)sn;
    }
}

__device__ __forceinline__ void p1_norm(const Frame& F) {
    const int gw = F.bid * 8 + F.wid, NGW = F.G * 8;
    for (int r0 = gw * 4; r0 < T_ + CT_; r0 += NGW * 4) {
        const bool isx = r0 < T_;
        const int rr0 = isx ? r0 : r0 - T_;
        const float* src = isx ? F.x + ((size_t)F.b0 * SEQ + rr0) * DM : F.ctx + ((size_t)F.b0 * CTXL + rr0) * DM;
        act_t* dst = isx ? F.hx + (size_t)rr0 * DM : F.hc + (size_t)rr0 * DM;
        const float* mrow = isx ? F.mod + (size_t)(F.b0 + rr0 / SEQ) * 6144 : F.mod + (size_t)8 * 6144;
        f32x4 v[4][4]; float ss[4];
#pragma unroll
        for (int q = 0; q < 4; ++q)
#pragma unroll
            for (int j = 0; j < 4; ++j) v[q][j] = *(const f32x4*)(src + (size_t)q * DM + j * 256 + F.lane * 4);
#pragma unroll
        for (int q = 0; q < 4; ++q) { float s = 0.f;
#pragma unroll
            for (int j = 0; j < 4; ++j) s += v[q][j][0] * v[q][j][0] + v[q][j][1] * v[q][j][1] + v[q][j][2] * v[q][j][2] + v[q][j][3] * v[q][j][3];
            ss[q] = s; }
#pragma unroll
        for (int o = 1; o < 64; o <<= 1) {
#pragma unroll
            for (int q = 0; q < 4; ++q) ss[q] += __shfl_xor(ss[q], o); }
#pragma unroll
        for (int j = 0; j < 4; ++j) { const int d = j * 256 + F.lane * 4;
            const f32x4 g = *(const f32x4*)(F.g_pre_mix + d), sh = *(const f32x4*)(mrow + d), sc = *(const f32x4*)(mrow + 1024 + d);
#pragma unroll
            for (int q = 0; q < 4; ++q) { const float rstd = 1.0f / sqrtf(ss[q] * (1.0f / DM) + EPS);
                f32x4 o;
#pragma unroll
                for (int i = 0; i < 4; ++i) o[i] = (v[q][j][i] * rstd) * g[i] * (1.0f + sc[i]) + sh[i];
                st4(dst + (size_t)q * DM + d, o); } }
    }
}

__device__ __forceinline__ void epi_in(const Frame& F, int r, int c, f32x4 v0, f32x4 v1) {
    const int s = r & (SEQ - 1);
    if (c < 1280) {
        const int axis = (c >> 5) & 1, pos = axis ? (s & 63) : (s >> 6);
        const float* rp = F.rope + (pos * 16 + (c & 15)) * 2;
        const f32x4 cs0 = *(const f32x4*)rp, cs1 = *(const f32x4*)(rp + 4);
        f32x4 o1, o2;
        o1[0] = v0[0] * cs0[0] - v1[0] * cs0[1]; o2[0] = v1[0] * cs0[0] + v0[0] * cs0[1];
        o1[1] = v0[1] * cs0[2] - v1[1] * cs0[3]; o2[1] = v1[1] * cs0[2] + v0[1] * cs0[3];
        o1[2] = v0[2] * cs1[0] - v1[2] * cs1[1]; o2[2] = v1[2] * cs1[0] + v0[2] * cs1[1];
        o1[3] = v0[3] * cs1[2] - v1[3] * cs1[3]; o2[3] = v1[3] * cs1[2] + v0[3] * cs1[3];
        if (c < 1024) { o1 *= QS; o2 *= QS; st4(F.q + (size_t)r * 1024 + c, o1); st4(F.q + (size_t)r * 1024 + c + 16, o2); }
        else { st4(F.k + (size_t)r * 256 + (c - 1024), o1); st4(F.k + (size_t)r * 256 + (c - 1024) + 16, o2); }
    } else if (c < 1536) {
        const int cc = c - 1280, hk = cc >> 6, d = cc & 63, bl = r / SEQ;
        act_t* base = F.vT + ((size_t)(bl * 4 + hk) * 64 + d) * SEQ + s;
#pragma unroll
        for (int i = 0; i < 4; ++i) { st_act(base + (size_t)i * SEQ, v0[i]); st_act(base + (size_t)(16 + i) * SEQ, v1[i]); }
    } else if (c < 2560) {
        const int ch = ((c - 1536) >> 5) * 16 + (c & 15);
        f32x4 o;
#pragma unroll
        for (int i = 0; i < 4; ++i) o[i] = v0[i] * fsig(v1[i]);
        st4(F.u + (size_t)r * 512 + ch, o);
    } else {
        const int g = c - 2560; f32x4 o0, o1;
#pragma unroll
        for (int i = 0; i < 4; ++i) { o0[i] = fsig(v0[i]); o1[i] = fsig(v1[i]); }
        st4(F.sg + (size_t)r * 2048 + g, o0); st4(F.sg + (size_t)r * 2048 + g + 16, o1);
    }
}
__device__ __forceinline__ void epi_ctx(const Frame& F, int r, int c, f32x4 v0, f32x4 v1) {
    if (c < 256) { st4(F.kc + (size_t)r * 256 + c, v0); st4(F.kc + (size_t)r * 256 + c + 16, v1); }
    else { const int cc = c - 256, hk = cc >> 6, d = cc & 63, bl = r / CTXL, sx = r % CTXL;
        act_t* base = F.vTc + ((size_t)(bl * 4 + hk) * 64 + d) * CTXL + sx;
#pragma unroll
        for (int i = 0; i < 4; ++i) { st_act(base + (size_t)i * CTXL, v0[i]); st_act(base + (size_t)(16 + i) * CTXL, v1[i]); } }
}
#if GOLD
__device__ __forceinline__ void p2_inproj(const Frame& F) {
    constexpr int nM = T_ / 128, nN = INW / 128, nMc = CT_ / 128, nNc = 4;
    const int ntile = nM * nN + nMc * nNc;
    for (int t = F.bid; t < ntile; t += F.G) {
        f32x4 acc[2][4]; acc_zero(acc);
        if (t < nM * nN) {
            const int pm = t / nN, pn = t % nN;
            mma_tile(acc, F.lds, F.hx, DM, F.win_t, DM, DM, pm * 128, pn * 128);
            epi_foreach(acc, pm * 128, pn * 128, [&](int r, int c, f32x4 v0, f32x4 v1) { epi_in(F, r, c, v0, v1); });
        } else {
            const int tt = t - nM * nN, pm = tt / nNc, pn = tt % nNc;
            mma_tile(acc, F.lds, F.hc, DM, F.win_t + (size_t)1024 * DM, DM, DM, pm * 128, pn * 128);
            epi_foreach(acc, pm * 128, pn * 128, [&](int r, int c, f32x4 v0, f32x4 v1) { epi_ctx(F, r, c, v0, v1); });
        }
    }
}
#else
__device__ __forceinline__ void p2_inproj(const Frame& F) {
    auto fn = [&](int r, int c, f32x4 v0, f32x4 v1) { if (r < T_) epi_in(F, r, c, v0, v1); else epi_ctx(F, r - T_, c - 1024, v0, v1); };
    const pg8::Gemm g{F.hx, F.win_t, T_ + CT_, INW, DM}; InOrder S; S.init(T_, INW, F.G, F.bid); S.repn = (PROBE_PH == 20) ? PROBE_N : 1;
    const EpiFn<decltype(fn)> E{fn};
    pg8::gemm_phase<EpiFn<decltype(fn)>, InOrder, true, true>((PG8_LAS unsigned char*)F.lds, g, S, E);
}
#endif

#if GOLD
__device__ __forceinline__ void p3_attn(const Frame& F) {
    float* qs = (float*)F.lds + F.wid * 64;
    float* ps = (float*)F.lds + 512 + F.wid * 640;
    const int gw = F.bid * 8 + F.wid, NGW = F.G * 8;
    for (int it = gw; it < T_ * NH; it += NGW) {
        const int r = it / NH, head = it % NH, hk = head >> 2, bl = r / SEQ, s = r % SEQ;
        qs[F.lane] = F.q[(size_t)r * 1024 + head * 64 + F.lane];
        const int lo = (s - 128 < 0) ? 0 : s - 128, hi = (s + 128 > SEQ - 1) ? SEQ - 1 : s + 128, nwin = hi - lo + 1, ntot = nwin + CTXL;
        float mx = -1e30f;
        for (int jj = F.lane; jj < ntot; jj += 64) {
            const float* kr = (jj < nwin) ? F.k + ((size_t)(bl * SEQ + lo + jj)) * 256 + hk * 64 : F.kc + ((size_t)(bl * CTXL + jj - nwin)) * 256 + hk * 64;
            float d = 0.f;
            for (int e = 0; e < 64; e += 4) { const f32x4 kv = *(const f32x4*)(kr + e); d += qs[e] * kv[0] + qs[e + 1] * kv[1] + qs[e + 2] * kv[2] + qs[e + 3] * kv[3]; }
            ps[jj] = d; mx = fmaxf(mx, d);
        }
        mx = wave_max(mx);
        float l = 0.f;
        for (int jj = F.lane; jj < ntot; jj += 64) { const float p = exp2f(ps[jj] - mx); ps[jj] = p; l += p; }
        l = wave_sum(l) + exp2f(F.sink[head] * LOG2E - mx);
        const float* vr = F.vT + ((size_t)(bl * 4 + hk) * 64 + F.lane) * SEQ + lo;
        const float* vc = F.vTc + ((size_t)(bl * 4 + hk) * 64 + F.lane) * CTXL;
        float o = 0.f;
        for (int jj = 0; jj < nwin; ++jj) o += ps[jj] * vr[jj];
        for (int jj = 0; jj < CTXL; ++jj) o += ps[nwin + jj] * vc[jj];
        F.att[(size_t)r * 1024 + head * 64 + F.lane] = o / l;
    }
}
#else
__device__ __forceinline__ void p3_attn(const Frame& F) {
    constexpr int KLD = 72;
    bf16_t* Kt = (bf16_t*)F.lds;
    bf16_t* Vt = (bf16_t*)(F.lds + 64 * KLD * 2);
    const int lane = F.lane, l31 = lane & 31, hi = lane >> 5;
    const int g = F.wid >> 1, half = F.wid & 1;
    constexpr int NUNIT = CH_B * NKV * (SEQ / 128);
    for (int un = F.bid; un < NUNIT; un += F.G) {
        const int nb = un & 15, hk = (un >> 4) & 3, bl = un >> 6;
        const int head = hk * 4 + g;
        const int r0 = bl * SEQ + nb * 128 + half * 64;
        bf16x8 qf[2][4];
#pragma unroll
        for (int qt = 0; qt < 2; ++qt)
#pragma unroll
            for (int s = 0; s < 4; ++s) qf[qt][s] = *(const bf16x8*)(F.q + (size_t)(r0 + qt * 32 + l31) * 1024 + head * 64 + s * 16 + 8 * hi);
        float mrun[2] = {-1e30f, -1e30f}, lrun[2] = {0.f, 0.f};
        f32x16 O[2][2];
#pragma unroll
        for (int a = 0; a < 2; ++a)
#pragma unroll
            for (int b = 0; b < 2; ++b)
#pragma unroll
                for (int r = 0; r < 16; ++r) O[a][b][r] = 0.f;
        for (int tile = 0; tile < 10; ++tile) {
            const bool isctx = tile < 4;
            const int ks = isctx ? tile * 64 : nb * 128 - 128 + 64 * (tile - 4);
            if (!isctx && (ks < 0 || ks >= SEQ)) continue;
            __syncthreads();
            { const int row = F.tid >> 3, ch = F.tid & 7;
              const act_t* ksrc = isctx ? F.kc + ((size_t)(bl * CTXL + ks + row)) * 256 + hk * 64 + ch * 8
                                        : F.k + ((size_t)(bl * SEQ + ks + row)) * 256 + hk * 64 + ch * 8;
              const act_t* vsrc = isctx ? F.vTc + ((size_t)(bl * 4 + hk) * 64 + row) * CTXL + ks + ch * 8
                                        : F.vT + ((size_t)(bl * 4 + hk) * 64 + row) * SEQ + ks + ch * 8;
              *(u32x4*)(Kt + row * KLD + ch * 8) = *(const u32x4*)ksrc;
              *(u32x4*)(Vt + row * KLD + ch * 8) = *(const u32x4*)vsrc; }
            __syncthreads();
            const int j = tile - 4;
            const bool need = isctx || (half == 0 ? (j <= 4) : (j >= 1));
            if (need) {
                f32x16 st[2][2];
#pragma unroll
                for (int a = 0; a < 2; ++a)
#pragma unroll
                    for (int b = 0; b < 2; ++b)
#pragma unroll
                        for (int r = 0; r < 16; ++r) st[a][b][r] = 0.f;
#pragma unroll
                for (int s = 0; s < 4; ++s)
#pragma unroll
                    for (int kt = 0; kt < 2; ++kt) {
                        const bf16x8 a = *(const bf16x8*)(Kt + (kt * 32 + l31) * KLD + s * 16 + 8 * hi);
#pragma unroll
                        for (int qt = 0; qt < 2; ++qt) st[kt][qt] = __builtin_amdgcn_mfma_f32_32x32x16_bf16(a, qf[qt][s], st[kt][qt], 0, 0, 0);
                    }
                if (!isctx) {
#pragma unroll
                    for (int kt = 0; kt < 2; ++kt)
#pragma unroll
                        for (int qt = 0; qt < 2; ++qt) {
                            const int qp = nb * 128 + half * 64 + qt * 32 + l31;
#pragma unroll
                            for (int r = 0; r < 16; ++r) { const int kp = ks + kt * 32 + crow(r, hi); const int dd = qp - kp; if (dd > 128 || dd < -128) st[kt][qt][r] = -1e30f; }
                        }
                }
                bf16x8 pf[2][2][2];
#pragma unroll
                for (int qt = 0; qt < 2; ++qt) {
                    float mx = -1e30f;
#pragma unroll
                    for (int kt = 0; kt < 2; ++kt)
#pragma unroll
                        for (int r = 0; r < 16; ++r) mx = fmaxf(mx, st[kt][qt][r]);
                    mx = fmaxf(mx, __shfl_xor(mx, 32));
                    const float mn = fmaxf(mrun[qt], mx);
                    const float alpha = __builtin_amdgcn_exp2f(mrun[qt] - mn);
                    mrun[qt] = mn; lrun[qt] *= alpha;
#pragma unroll
                    for (int dt = 0; dt < 2; ++dt)
#pragma unroll
                        for (int r = 0; r < 16; ++r) O[dt][qt][r] *= alpha;
                    float ls = 0.f;
#pragma unroll
                    for (int kt = 0; kt < 2; ++kt) {
                        float p[16];
#pragma unroll
                        for (int r = 0; r < 16; ++r) { p[r] = __builtin_amdgcn_exp2f(st[kt][qt][r] - mn); ls += p[r]; }
#pragma unroll
                        for (int s2 = 0; s2 < 2; ++s2) {
                            u32x4 w;
                            w[0] = pk2(p[8 * s2 + 0], p[8 * s2 + 1]); w[1] = pk2(p[8 * s2 + 2], p[8 * s2 + 3]);
                            w[2] = pk2(p[8 * s2 + 4], p[8 * s2 + 5]); w[3] = pk2(p[8 * s2 + 6], p[8 * s2 + 7]);
                            pf[kt][s2][qt] = __builtin_bit_cast(bf16x8, w);
                        }
                    }
                    lrun[qt] += ls;
                }
#pragma unroll
                for (int kt = 0; kt < 2; ++kt)
#pragma unroll
                    for (int s2 = 0; s2 < 2; ++s2)
#pragma unroll
                        for (int dt = 0; dt < 2; ++dt) {
                            const bf16_t* vp = Vt + (dt * 32 + l31) * KLD + kt * 32 + s2 * 16 + 4 * hi;
                            const s16x4 lo = *(const s16x4*)vp, hh = *(const s16x4*)(vp + 8);
                            const bf16x8 a = (bf16x8){lo[0], lo[1], lo[2], lo[3], hh[0], hh[1], hh[2], hh[3]};
#pragma unroll
                            for (int qt = 0; qt < 2; ++qt) O[dt][qt] = __builtin_amdgcn_mfma_f32_32x32x16_bf16(a, pf[kt][s2][qt], O[dt][qt], 0, 0, 0);
                        }
            }
        }
        const float sk = F.sink[head] * LOG2E;
#pragma unroll
        for (int qt = 0; qt < 2; ++qt) {
            float lt = lrun[qt] + __shfl_xor(lrun[qt], 32);
            lt += __builtin_amdgcn_exp2f(sk - mrun[qt]);
            const float inv = 1.0f / lt;
            act_t* orow = F.att + (size_t)(r0 + qt * 32 + l31) * 1024 + head * 64;
#pragma unroll
            for (int dt = 0; dt < 2; ++dt)
#pragma unroll
                for (int g4 = 0; g4 < 4; ++g4) {
                    f32x4 o; o[0] = O[dt][qt][4 * g4] * inv; o[1] = O[dt][qt][4 * g4 + 1] * inv; o[2] = O[dt][qt][4 * g4 + 2] * inv; o[3] = O[dt][qt][4 * g4 + 3] * inv;
                    st4(orow + dt * 32 + 8 * g4 + 4 * hi, o);
                }
        }
    }
}
#endif

#if GOLD
constexpr int CTK = 32;
#else
constexpr int CTK = 64;
#endif
__device__ __forceinline__ void p3_conv(const Frame& F) {
    act_t* ub = (act_t*)F.lds;
    float* yb = (float*)(F.lds + (size_t)(CTK + 30) * 512 * AS);
    static_assert((CTK + 30) * 512 * AS + 8 * 512 * 4 <= LDS_MISC, "conv LDS");
    const int c = F.tid;
    float w[CONV_W];
#pragma unroll
    for (int i = 0; i < CONV_W; ++i) w[i] = F.conv_dw[i * CONV_CH + c];
    const float bias = F.conv_dw_b[c];
    constexpr int NT = T_ / CTK;
    for (int t = F.bid; t < NT; t += F.G) {
        const int r0 = t * CTK, bl = r0 / SEQ, s0 = r0 % SEQ;
        __syncthreads();
        constexpr int CPRW = 512 * AS / 16;
        for (int e = F.tid; e < (CTK + 30) * CPRW; e += 512) {
            const int rr = e / CPRW, ch = e % CPRW, sp = s0 + rr - 15;
            u32x4 v = (u32x4){0u, 0u, 0u, 0u};
            if (sp >= 0 && sp < SEQ) v = *(const u32x4*)((const unsigned char*)(F.u + (size_t)(bl * SEQ + sp) * 512) + ch * 16);
            *(u32x4*)((unsigned char*)ub + (size_t)rr * 512 * AS + ch * 16) = v;
        }
        __syncthreads();
        for (int chunk = 0; chunk < CTK / 8; ++chunk) {
#pragma unroll 1
            for (int tt = 0; tt < 8; ++tt) {
                const int tk = chunk * 8 + tt;
                float a = 0.f;
#pragma unroll
                for (int i = 0; i < CONV_W; ++i) a += ld_act(ub + (size_t)(tk + i) * 512 + c) * w[i];
                yb[tt * 512 + c] = a + bias;
            }
            __syncthreads();
            {
                const int tk = chunk * 8 + F.wid;
                float y[8];
                const f32x4 y0 = *(const f32x4*)(yb + F.wid * 512 + F.lane * 8), y1 = *(const f32x4*)(yb + F.wid * 512 + F.lane * 8 + 4);
                y[0] = y0[0]; y[1] = y0[1]; y[2] = y0[2]; y[3] = y0[3]; y[4] = y1[0]; y[5] = y1[1]; y[6] = y1[2]; y[7] = y1[3];
                float s = 0.f;
#pragma unroll
                for (int i = 0; i < 8; ++i) s += y[i];
                const float mean = wave_sum(s) * (1.0f / CONV_CH);
                float q = 0.f;
#pragma unroll
                for (int i = 0; i < 8; ++i) { y[i] -= mean; q += y[i] * y[i]; }
                const float rstd = 1.0f / sqrtf(wave_sum(q) * (1.0f / CONV_CH) + EPS);
                f32x4 o0, o1;
#pragma unroll
                for (int i = 0; i < 8; ++i) { const int ch = F.lane * 8 + i; const float z = y[i] * rstd * F.conv_ln_g[ch] + F.conv_ln_b[ch]; const float o = z * fsig(z); if (i < 4) o0[i] = o; else o1[i - 4] = o; }
                act_t* dst = F.cact + (size_t)(r0 + tk) * 512 + F.lane * 8;
                st4(dst, o0); st4(dst + 4, o1);
            }
            __syncthreads();
        }
    }
}

#if GOLD
__device__ __forceinline__ void p4_merge(const Frame& F) {
    constexpr int nM = T_ / 128, nN = 8;
    for (int t = F.bid; t < nM * nN; t += F.G) {
        const int pm = t / nN, pn = t % nN;
        f32x4 accA[2][4], accC[2][4]; acc_zero(accA); acc_zero(accC);
        mma_tile(accA, F.lds, F.att, 1024, F.woa_t, 1024, 1024, pm * 128, pn * 128);
        mma_tile(accC, F.lds, F.cact, 512, F.woc_t, 512, 512, pm * 128, pn * 128);
        const int lane = F.lane, wm = F.wid >> 1, wn = F.wid & 1, fr = lane & 15, fq = lane >> 4;
#pragma unroll
        for (int mi = 0; mi < 2; ++mi)
#pragma unroll
            for (int ni = 0; ni < 4; ++ni) {
                const int r = pm * 128 + wm * 32 + mi * 16 + fr, c = pn * 128 + wn * 64 + ni * 16 + 4 * fq;
                const f32x4 ga = ld4(F.sg + (size_t)r * 2048 + c), gc = ld4(F.sg + (size_t)r * 2048 + 1024 + c);
                st4(F.m + (size_t)r * 1024 + c, ga * accA[mi][ni] + gc * accC[mi][ni]);
            }
    }
}
__device__ __forceinline__ void p5_out(const Frame& F) {
    constexpr int nM = T_ / 128, nN = 8;
    for (int t = F.bid; t < nM * nN; t += F.G) {
        const int pm = t / nN, pn = t % nN;
        f32x4 acc[2][4]; acc_zero(acc);
        mma_tile(acc, F.lds, F.m, 1024, F.wout_t, 1024, 1024, pm * 128, pn * 128);
        const int lane = F.lane, wm = F.wid >> 1, wn = F.wid & 1, fr = lane & 15, fq = lane >> 4;
#pragma unroll
        for (int mi = 0; mi < 2; ++mi)
#pragma unroll
            for (int ni = 0; ni < 4; ++ni) {
                const int r = pm * 128 + wm * 32 + mi * 16 + fr, c = pn * 128 + wn * 64 + ni * 16 + 4 * fq;
                *(f32x4*)(F.mixed + (size_t)r * 1024 + c) = acc[mi][ni];
            }
    }
}
#else
__device__ __forceinline__ void p4_merge(const Frame& F) {
    run_gemm<22>(F, F.att, F.woa_t, T_, 1024, 1024, [&](int r, int c, f32x4 v0, f32x4 v1) {
        const act_t* gp = F.sg + (size_t)r * 2048 + c; act_t* mp = F.m + (size_t)r * 1024 + c;
        st4(mp, ld4(gp) * v0); st4(mp + 16, ld4(gp + 16) * v1); });
    run_gemm<-2>(F, F.cact, F.woc_t, T_, 1024, 512, [&](int r, int c, f32x4 v0, f32x4 v1) {
        const act_t* gp = F.sg + (size_t)r * 2048 + 1024 + c; act_t* mp = F.m + (size_t)r * 1024 + c;
        st4(mp, ld4(mp) + ld4(gp) * v0); st4(mp + 16, ld4(mp + 16) + ld4(gp + 16) * v1); });
}
__device__ __forceinline__ void p5_out(const Frame& F) {
    run_gemm<23>(F, F.m, F.wout_t, T_, 1024, 1024, [&](int r, int c, f32x4 v0, f32x4 v1) {
        float* p = F.mixed + (size_t)r * 1024 + c; *(f32x4*)p = v0; *(f32x4*)(p + 16) = v1; });
}
#endif
__device__ __forceinline__ void p6_rows(const Frame& F) {
    const int gw = F.bid * 8 + F.wid, NGW = F.G * 8;
    for (int r0 = gw * 2; r0 < T_; r0 += NGW * 2) {
        const float* mrow = F.mod + (size_t)(F.b0 + r0 / SEQ) * 6144;
        const float* xr = F.x + ((size_t)F.b0 * SEQ + r0) * DM;
        float* outr = F.out + ((size_t)F.b0 * SEQ + r0) * DM;
        f32x4 mv[2][4], xv[2][4]; float ss[2], s1[2];
#pragma unroll
        for (int q = 0; q < 2; ++q)
#pragma unroll
            for (int j = 0; j < 4; ++j) { mv[q][j] = *(const f32x4*)(F.mixed + (size_t)(r0 + q) * 1024 + j * 256 + F.lane * 4); xv[q][j] = *(const f32x4*)(xr + (size_t)q * DM + j * 256 + F.lane * 4); }
#pragma unroll
        for (int q = 0; q < 2; ++q) { float s = 0.f;
#pragma unroll
            for (int j = 0; j < 4; ++j) s += mv[q][j][0] * mv[q][j][0] + mv[q][j][1] * mv[q][j][1] + mv[q][j][2] * mv[q][j][2] + mv[q][j][3] * mv[q][j][3];
            ss[q] = s; }
#pragma unroll
        for (int o = 1; o < 64; o <<= 1) { ss[0] += __shfl_xor(ss[0], o); ss[1] += __shfl_xor(ss[1], o); }
        s1[0] = 0.f; s1[1] = 0.f;
#pragma unroll
        for (int j = 0; j < 4; ++j) { const int d = j * 256 + F.lane * 4;
            const f32x4 g = *(const f32x4*)(F.g_post_mix + d), gt = *(const f32x4*)(mrow + 2048 + d);
#pragma unroll
            for (int q = 0; q < 2; ++q) { const float rstd = 1.0f / sqrtf(ss[q] * (1.0f / DM) + EPS);
#pragma unroll
                for (int i = 0; i < 4; ++i) { xv[q][j][i] = xv[q][j][i] + gt[i] * ((mv[q][j][i] * rstd) * g[i]); s1[q] += xv[q][j][i] * xv[q][j][i]; }
                *(f32x4*)(outr + (size_t)q * DM + d) = xv[q][j]; } }
#pragma unroll
        for (int o = 1; o < 64; o <<= 1) { s1[0] += __shfl_xor(s1[0], o); s1[1] += __shfl_xor(s1[1], o); }
#pragma unroll
        for (int j = 0; j < 4; ++j) { const int d = j * 256 + F.lane * 4;
            const f32x4 g = *(const f32x4*)(F.g_pre_ffn + d), sh = *(const f32x4*)(mrow + 3072 + d), sc = *(const f32x4*)(mrow + 4096 + d);
#pragma unroll
            for (int q = 0; q < 2; ++q) { const float rstd1 = 1.0f / sqrtf(s1[q] * (1.0f / DM) + EPS);
                f32x4 o;
#pragma unroll
                for (int i = 0; i < 4; ++i) o[i] = (xv[q][j][i] * rstd1) * g[i] * (1.0f + sc[i]) + sh[i];
                st4(F.h2 + (size_t)(r0 + q) * 1024 + d, o); } }
    }
}
__device__ __forceinline__ void p7_wq(const Frame& F) {
#if GOLD
    constexpr int nM = T_ / 128, nN = PQW / 128;
    for (int t = F.bid; t < nM * nN; t += F.G) {
        const int pm = t / nN, pn = t % nN;
        f32x4 acc[2][4]; acc_zero(acc);
        mma_tile(acc, F.lds, F.h2, 1024, F.wq_t, 1024, 1024, pm * 128, pn * 128);
        const int lane = F.lane, wm = F.wid >> 1, wn = F.wid & 1, fr = lane & 15, fq = lane >> 4;
#pragma unroll
        for (int mi = 0; mi < 2; ++mi)
#pragma unroll
            for (int ni = 0; ni < 4; ++ni) {
                const int r = pm * 128 + wm * 32 + mi * 16 + fr, c = pn * 128 + wn * 64 + ni * 16 + 4 * fq;
                st4(F.pq + (size_t)r * PQW + c, acc[mi][ni]);
            }
    }
#else
    run_gemm<24>(F, F.h2, F.wq_t, T_, PQW, 1024, [&](int r, int c, f32x4 v0, f32x4 v1) {
        act_t* p = F.pq + (size_t)r * PQW + c; st4(p, v0); st4(p + 16, v1); });
#endif
}
__device__ __forceinline__ int f2sort(float f) { const int b = __float_as_int(f); return b ^ ((b >> 31) & 0x7fffffff); }
__device__ __forceinline__ float sort2f(int k) { return __int_as_float(k ^ ((k >> 31) & 0x7fffffff)); }
__device__ __forceinline__ void p8_partial(const Frame& F, int (&L)[16], int t, int hp, int l31, int hi) {
#pragma unroll
    for (int i = 0; i < 16; ++i) L[i] = (int)0x80000000;
    const act_t* qrow = F.pq + (size_t)t * PQW + hp * 128;
#pragma unroll 1
    for (int kt = 0; kt < 4; ++kt) {
        const act_t* krow = F.keys_t + ((size_t)hp * 128 + kt * 32 + l31) * 128;
        f32x16 sc;
#pragma unroll
        for (int r = 0; r < 16; ++r) sc[r] = 0.f;
#if GOLD
        for (int s = 0; s < 64; ++s) sc = __builtin_amdgcn_mfma_f32_32x32x2f32(krow[2 * s + hi], qrow[2 * s + hi], sc, 0, 0, 0);
#else
#pragma unroll
        for (int s = 0; s < 8; ++s) { const bf16x8 a = *(const bf16x8*)(krow + 16 * s + 8 * hi), b = *(const bf16x8*)(qrow + 16 * s + 8 * hi);
            sc = __builtin_amdgcn_mfma_f32_32x32x16_bf16(a, b, sc, 0, 0, 0); }
#endif
#pragma unroll
        for (int r = 0; r < 16; ++r) {
            int v = (f2sort(sc[r]) & ~127) | (127 - (kt * 32 + crow(r, hi)));
#pragma unroll
            for (int i = 0; i < 16; ++i) { const int h_ = max(L[i], v); v = min(L[i], v); L[i] = h_; }
        }
    }
}
#if !GOLD
__device__ __forceinline__ void p8_convert_tables(const Frame& F) {
    const int gw = F.bid * 8 + F.wid, NGW = F.G * 8;
    for (size_t e = (size_t)gw * 64 + F.lane; e < (size_t)NEXP * 1024 / 16; e += (size_t)NGW * 64) {
        u32x4 wa, wb;
#pragma unroll
        for (int j = 0; j < 4; ++j) { const f32x4 a = *(const f32x4*)(F.peer_u + e * 16 + 4 * j), b = *(const f32x4*)(F.peer_v + e * 16 + 4 * j);
            int pa = 0, pb = 0;
            pa = __builtin_amdgcn_cvt_pk_fp8_f32(a[0] * 256.0f, a[1] * 256.0f, pa, false); pa = __builtin_amdgcn_cvt_pk_fp8_f32(a[2] * 256.0f, a[3] * 256.0f, pa, true);
            pb = __builtin_amdgcn_cvt_pk_fp8_f32(b[0] * 256.0f, b[1] * 256.0f, pb, false); pb = __builtin_amdgcn_cvt_pk_fp8_f32(b[2] * 256.0f, b[3] * 256.0f, pb, true);
            wa[j] = (unsigned)pa; wb[j] = (unsigned)pb; }
        *(u32x4*)(F.pu8 + e * 16) = wa; *(u32x4*)(F.pv8 + e * 16) = wb;
    }
}
#endif
__device__ __forceinline__ void p8_topk(const Frame& F) {
    const int gw = F.bid * 8 + F.wid, NGW = F.G * 8, lane = F.lane, l31 = lane & 31, hi = lane >> 5;
#if !GOLD
    if (F.wid >= 4) p8_convert_tables(F);
#endif
    for (int task = gw; task < (T_ / 32) * 4; task += NGW) {
        const int tb = task >> 2, h0 = (task & 3) * 2, t = tb * 32 + l31;
        int a[16], b[16];
        {
            int P0[16], P1[16];
            p8_partial(F, P0, t, 2 * h0, l31, hi); p8_partial(F, P1, t, 2 * h0 + 2, l31, hi);
#pragma unroll
            for (int i = 0; i < 16; ++i) { const auto rr = __builtin_amdgcn_permlane32_swap((unsigned)P0[i], (unsigned)P1[i], false, false); a[i] = (int)rr[0]; P1[i] = (int)rr[1]; }
#pragma unroll
            for (int e = 0; e < 16; ++e) { int v = P1[e];
#pragma unroll
                for (int i = 0; i < 16; ++i) { const int h_ = max(a[i], v); v = min(a[i], v); a[i] = h_; } }
        }
        {
            int P0[16], P1[16];
            p8_partial(F, P0, t, 2 * h0 + 1, l31, hi); p8_partial(F, P1, t, 2 * h0 + 3, l31, hi);
#pragma unroll
            for (int i = 0; i < 16; ++i) { const auto rr = __builtin_amdgcn_permlane32_swap((unsigned)P0[i], (unsigned)P1[i], false, false); b[i] = (int)rr[0]; P1[i] = (int)rr[1]; }
#pragma unroll
            for (int e = 0; e < 16; ++e) { int v = P1[e];
#pragma unroll
                for (int i = 0; i < 16; ++i) { const int h_ = max(b[i], v); v = min(b[i], v); b[i] = h_; } }
        }
        float fa[16], fb[16]; int ia[16], ib[16];
#pragma unroll
        for (int i = 0; i < 16; ++i) { fa[i] = sort2f(a[i]); fb[i] = sort2f(b[i]); ia[i] = (127 - (a[i] & 127)) * 128; ib[i] = 127 - (b[i] & 127); }
        int c[16], cp[16];
#pragma unroll
        for (int j = 0; j < 16; ++j) { c[j] = f2sort(fa[0] + fb[j]); cp[j] = ia[0] + ib[j]; }
#pragma unroll
        for (int i = 1; i < 16; ++i)
#pragma unroll
            for (int j = 0; j < 16 / (i + 1); ++j) {
                int v = f2sort(fa[i] + fb[j]), pv = ia[i] + ib[j];
#pragma unroll
                for (int s = (i + 1) * (j + 1) - 1; s < 16; ++s) { const bool gt = v > c[s]; const int nk = gt ? v : c[s], lo = gt ? c[s] : v, np = gt ? pv : cp[s], lp = gt ? cp[s] : pv; c[s] = nk; cp[s] = np; v = lo; pv = lp; }
            }
        float e[16], sum = 0.f; const float c0 = sort2f(c[0]);
#pragma unroll
        for (int i = 0; i < 16; ++i) { e[i] = exp2f((sort2f(c[i]) - c0) * LOG2E); sum += e[i]; }
        const float inv = 1.0f / sum;
        const size_t ob = (size_t)t * 128 + (h0 + hi) * 16;
#pragma unroll
        for (int i4 = 0; i4 < 16; i4 += 4) {
#if GOLD
            *(u32x4*)(F.pei + ob + i4) = (u32x4){(unsigned)cp[i4], (unsigned)cp[i4 + 1], (unsigned)cp[i4 + 2], (unsigned)cp[i4 + 3]};
            *(f32x4*)(F.peg + ob + i4) = (f32x4){e[i4] * inv, e[i4 + 1] * inv, e[i4 + 2] * inv, e[i4 + 3] * inv};
#else
            u32x4 pw;
#pragma unroll
            for (int i = 0; i < 4; ++i) pw[i] = ((unsigned)cp[i4 + i] << 16) | (unsigned)__builtin_bit_cast(unsigned short, (_Float16)(e[i4 + i] * inv));
            *(u32x4*)(F.pei + ob + i4) = pw;
#endif
        }
    }
#if !GOLD
    if (F.wid < 4) p8_convert_tables(F);
#endif
}
#if GOLD
__device__ __forceinline__ void p10_experts(const Frame& F) {
    const int gw = F.bid * 8 + F.wid, NGW = F.G * 8, lane = F.lane;
    constexpr int EPL = 4, NLD = 4;
    const float* TU = F.peer_u; const float* TV = F.peer_v;
    for (int r = gw; r < T_; r += NGW) {
        float hv[NLD][EPL], acc[NLD][EPL];
#pragma unroll
        for (int j = 0; j < NLD; ++j)
#pragma unroll
            for (int i = 0; i < EPL; ++i) { hv[j][i] = ld_act(F.h2 + (size_t)r * 1024 + j * 64 * EPL + lane * EPL + i); acc[j][i] = 0.f; }
        const int id0 = F.pei[(size_t)r * 128 + lane], id1 = F.pei[(size_t)r * 128 + 64 + lane];
        const float g0 = F.peg[(size_t)r * 128 + lane], g1 = F.peg[(size_t)r * 128 + 64 + lane];
        for (int e = 0; e < 128; ++e) {
            const int idx = __shfl((e < 64) ? id0 : id1, e & 63);
            const float gt = __shfl((e < 64) ? g0 : g1, e & 63);
            float uv[NLD][EPL], vv[NLD][EPL];
#pragma unroll
            for (int j = 0; j < NLD; ++j) {
                const f32x4 a = *(const f32x4*)(TU + (size_t)idx * 1024 + j * 256 + lane * 4), b = *(const f32x4*)(TV + (size_t)idx * 1024 + j * 256 + lane * 4);
#pragma unroll
                for (int i = 0; i < 4; ++i) { uv[j][i] = a[i]; vv[j][i] = b[i]; }
            }
            float d = 0.f;
#pragma unroll
            for (int j = 0; j < NLD; ++j)
#pragma unroll
                for (int i = 0; i < EPL; ++i) d += uv[j][i] * hv[j][i];
            d = wave_sum(d);
            const float act = 0.5f * d * (1.0f + erff(d * 0.70710678118654752f));
            const float wgt = gt * act;
#pragma unroll
            for (int j = 0; j < NLD; ++j)
#pragma unroll
                for (int i = 0; i < EPL; ++i) acc[j][i] += wgt * vv[j][i];
        }
        float ss = 0.f;
#pragma unroll
        for (int j = 0; j < NLD; ++j)
#pragma unroll
            for (int i = 0; i < EPL; ++i) ss += acc[j][i] * acc[j][i];
        const float rstd = 1.0f / sqrtf(wave_sum(ss) * (1.0f / DM) + EPS);
        const float* mrow = F.mod + (size_t)(F.b0 + r / SEQ) * 6144 + 5120;
        float* outr = F.out + ((size_t)F.b0 * SEQ + r) * DM;
#pragma unroll
        for (int j = 0; j < NLD; ++j)
#pragma unroll
            for (int i4 = 0; i4 < EPL; i4 += 4) { const int d0 = j * 64 * EPL + lane * EPL + i4;
                const f32x4 x1 = *(const f32x4*)(outr + d0), g = *(const f32x4*)(F.g_post_ffn + d0), gt2 = *(const f32x4*)(mrow + d0);
                f32x4 o;
#pragma unroll
                for (int i = 0; i < 4; ++i) o[i] = x1[i] + gt2[i] * ((acc[j][i4 + i] * rstd) * g[i]);
                *(f32x4*)(outr + d0) = o; }
    }
}
#else
typedef _Float16 h2_t __attribute__((ext_vector_type(2)));
__device__ __forceinline__ float gelu_fast(float v) {
    const float av = __builtin_fabsf(v), d = av * 0.2316418882f + 1.0f, t = __builtin_amdgcn_rcpf(d);
    float q = t * 0.5307027145f + (-0.7265760135f); q = q * t + 0.7107068705f; q = q * t + (-0.142248368f); q = q * t + 0.127414796f; q = q * t;
    const float ex = __builtin_amdgcn_exp2f(v * v * (-0.72134752044f));
    const float m = v * (q * ex), r = v - m; return v < 0.f ? m : r;
}
#define CVT_LO(w) __builtin_bit_cast(h2_t, __builtin_amdgcn_cvt_scalef32_pk_f16_fp8((int)(w), 1.0f, false))
#define CVT_HI(w) __builtin_bit_cast(h2_t, __builtin_amdgcn_cvt_scalef32_pk_f16_fp8((int)(w), 1.0f, true))
#define P10_WORD(b, q, e_) ((unsigned)__builtin_amdgcn_readlane((int)(((b) < 16) ? sw[q][0] : sw[q][1]), (4 * (b) + (e_)) & 63))
#define P10_LOADT(T, B, b, q) do { _Pragma("unroll") for (int e_ = 0; e_ < 4; ++e_) { B[q][e_] = *(const u32x4*)((T) + (size_t)(P10_WORD(b, q, e_) >> 16) * 1024 + lane * 16); } } while (0)
#define P10_COMPUTE_U(b, q) do { float d_[4]; unsigned wj_[4]; \
        _Pragma("unroll") for (int e_ = 0; e_ < 4; ++e_) { wj_[e_] = P10_WORD(b, q, e_); float s_ = 0.f; \
            _Pragma("unroll") for (int w_ = 0; w_ < 4; ++w_) { s_ = __builtin_amdgcn_fdot2(CVT_LO(UB[q][e_][w_]), hv[q][2 * w_], s_, false); s_ = __builtin_amdgcn_fdot2(CVT_HI(UB[q][e_][w_]), hv[q][2 * w_ + 1], s_, false); } d_[e_] = s_; } \
        float d2_[2], d1_; \
        _Pragma("unroll") for (int e_ = 0; e_ < 2; ++e_) { const float k_ = b5 ? d_[e_ + 2] : d_[e_], s_ = b5 ? d_[e_] : d_[e_ + 2]; d2_[e_] = k_ + __shfl_xor(s_, 32); } \
        { const float k_ = b4 ? d2_[1] : d2_[0], s_ = b4 ? d2_[0] : d2_[1]; d1_ = k_ + __shfl_xor(s_, 16); } \
        d1_ += __shfl_xor(d1_, 8); d1_ += __shfl_xor(d1_, 4); d1_ += __shfl_xor(d1_, 2); d1_ += __shfl_xor(d1_, 1); \
        unsigned gw_ = wj_[0]; gw_ = (eid == 1) ? wj_[1] : gw_; gw_ = (eid == 2) ? wj_[2] : gw_; gw_ = (eid == 3) ? wj_[3] : gw_; \
        const float gate_ = (float)__builtin_bit_cast(_Float16, (unsigned short)(gw_ & 0xffffu)); \
        const float wv_ = gate_ * gelu_fast(d1_ * (1.0f / 256.0f)); \
        const float wsel_ = __shfl(wv_, 16 * (lane & 3));                                     \
        const bool mine_ = (lane >> 2) == ((b) & 15); \
        wr[q][0] = (mine_ && (b) < 16) ? wsel_ : wr[q][0]; wr[q][1] = (mine_ && (b) >= 16) ? wsel_ : wr[q][1]; } while (0)
#define P10_COMPUTE_V(b, q) do { const float wsrc_ = ((b) < 16) ? wr[q][0] : wr[q][1]; \
        _Pragma("unroll") for (int e_ = 0; e_ < 4; ++e_) { \
            const float wf_ = __uint_as_float((unsigned)__builtin_amdgcn_readlane((int)__float_as_uint(wsrc_), (4 * (b) + e_) & 63)); \
            const _Float16 wh_ = (_Float16)wf_; const h2_t we_ = {wh_, wh_}; \
            _Pragma("unroll") for (int w_ = 0; w_ < 4; ++w_) { acc[q][2 * w_] = CVT_LO(VB[q][e_][w_]) * we_ + acc[q][2 * w_]; acc[q][2 * w_ + 1] = CVT_HI(VB[q][e_][w_]) * we_ + acc[q][2 * w_ + 1]; } } } while (0)
__device__ __forceinline__ void p10_experts(const Frame& F) {
    const int gw = F.bid * 8 + F.wid, lane = F.lane;
    const unsigned char* TU = F.pu8; const unsigned char* TV = F.pv8;
    const bool b5 = (lane & 32) != 0, b4 = (lane & 16) != 0;
    const int eid = ((lane >> 4) & 1) | (((lane >> 5) & 1) << 1);
    unsigned* sl = (unsigned*)F.lds + F.wid * 128;
    for (int t0 = gw * 4; t0 < T_; t0 += F.G * 8 * 4) {
        unsigned sw[4][2]; float wr[4][2];
        {
        h2_t hv[4][8];
#pragma unroll
        for (int q = 0; q < 4; ++q) {
            const int r = t0 + q;
            const act_t* hp = F.h2 + (size_t)r * 1024 + lane * 16;
#pragma unroll
            for (int j = 0; j < 4; ++j) { const f32x4 t = ld4(hp + 4 * j); hv[q][2 * j] = (h2_t){(_Float16)t[0], (_Float16)t[1]}; hv[q][2 * j + 1] = (h2_t){(_Float16)t[2], (_Float16)t[3]}; }
            const unsigned w0 = (unsigned)F.pei[(size_t)r * 128 + lane], w1 = (unsigned)F.pei[(size_t)r * 128 + 64 + lane];
            const int k0 = (int)(w0 >> 26), k1 = (int)(w1 >> 26);
            int pos0 = 0, pos1 = 0, base = 0;
#pragma unroll 1
            for (int s = 0; s < 16; ++s) {
                const unsigned long long m0 = __builtin_amdgcn_ballot_w64(k0 == s), m1 = __builtin_amdgcn_ballot_w64(k1 == s);
                const int c0 = __builtin_popcountll(m0);
                const int p0 = (int)__builtin_amdgcn_mbcnt_hi((unsigned)(m0 >> 32), __builtin_amdgcn_mbcnt_lo((unsigned)m0, 0u));
                const int p1 = (int)__builtin_amdgcn_mbcnt_hi((unsigned)(m1 >> 32), __builtin_amdgcn_mbcnt_lo((unsigned)m1, 0u));
                if (k0 == s) pos0 = base + p0;
                if (k1 == s) pos1 = base + c0 + p1;
                base += c0 + __builtin_popcountll(m1);
            }
            sl[pos0] = w0; sl[pos1] = w1;
            sw[q][0] = sl[lane]; sw[q][1] = sl[64 + lane];
            wr[q][0] = 0.f; wr[q][1] = 0.f;
        }
        u32x4 UB[4][4];
        for (int rep_ = 0; rep_ < ((PROBE_PH == 9) ? PROBE_N : 1); ++rep_) {
        P10_LOADT(TU, UB, 0, 0); P10_LOADT(TU, UB, 0, 1); P10_LOADT(TU, UB, 0, 2); P10_LOADT(TU, UB, 0, 3);
#pragma unroll 1
        for (int bb = 0; bb < 32; ++bb) {
            const int bn = (bb + 1 < 32) ? bb + 1 : 31;
            P10_COMPUTE_U(bb, 0); P10_LOADT(TU, UB, bn, 0);
            P10_COMPUTE_U(bb, 1); P10_LOADT(TU, UB, bn, 1);
            P10_COMPUTE_U(bb, 2); P10_LOADT(TU, UB, bn, 2);
            P10_COMPUTE_U(bb, 3); P10_LOADT(TU, UB, bn, 3);
        }
        }
        }
        h2_t acc[4][8];
        {
        u32x4 VB[4][4];
        for (int rep_ = 0; rep_ < ((PROBE_PH == 9) ? PROBE_N : 1); ++rep_) {
#pragma unroll
        for (int q = 0; q < 4; ++q)
#pragma unroll
            for (int i = 0; i < 8; ++i) acc[q][i] = (h2_t){(_Float16)0.f, (_Float16)0.f};
        P10_LOADT(TV, VB, 0, 0); P10_LOADT(TV, VB, 0, 1); P10_LOADT(TV, VB, 0, 2); P10_LOADT(TV, VB, 0, 3);
#pragma unroll 1
        for (int bb = 0; bb < 32; ++bb) {
            const int bn = (bb + 1 < 32) ? bb + 1 : 31;
            P10_COMPUTE_V(bb, 0); P10_LOADT(TV, VB, bn, 0);
            P10_COMPUTE_V(bb, 1); P10_LOADT(TV, VB, bn, 1);
            P10_COMPUTE_V(bb, 2); P10_LOADT(TV, VB, bn, 2);
            P10_COMPUTE_V(bb, 3); P10_LOADT(TV, VB, bn, 3);
        }
        }
        }
        const float* mrow = F.mod + (size_t)(F.b0 + t0 / SEQ) * 6144 + 5120;
#pragma unroll
        for (int q = 0; q < 4; ++q) {
            float o[16], ss = 0.f;
#pragma unroll
            for (int i = 0; i < 8; ++i) { o[2 * i] = (float)acc[q][i][0] * (1.0f / 256.0f); o[2 * i + 1] = (float)acc[q][i][1] * (1.0f / 256.0f); ss += o[2 * i] * o[2 * i] + o[2 * i + 1] * o[2 * i + 1]; }
            const float rstd = 1.0f / sqrtf(wave_sum(ss) * (1.0f / DM) + EPS);
            float* outr = F.out + ((size_t)F.b0 * SEQ + t0 + q) * DM;
#pragma unroll
            for (int j = 0; j < 4; ++j) { const int d0 = lane * 16 + 4 * j;
                const f32x4 x1 = *(const f32x4*)(outr + d0), g = *(const f32x4*)(F.g_post_ffn + d0), gt2 = *(const f32x4*)(mrow + d0);
                f32x4 ov;
#pragma unroll
                for (int i = 0; i < 4; ++i) ov[i] = x1[i] + gt2[i] * ((o[4 * j + i] * rstd) * g[i]);
                *(f32x4*)(outr + d0) = ov; }
        }
    }
}
#endif

__global__ void __launch_bounds__(512, 2) fwd_kernel(Args a) {
    extern __shared__ __attribute__((aligned(16))) unsigned char lds[];
    Frame F;
    F.lds = lds; F.tid = threadIdx.x; F.lane = F.tid & 63; F.wid = __builtin_amdgcn_readfirstlane(F.tid >> 6); F.G = gridDim.x; F.bid = blockIdx.x; F.b0 = a.b0;
    F.x = a.in[0]; F.c = a.in[1]; F.ctx = a.in[2]; F.c_ctx = a.in[3]; F.w_ada = a.in[4]; F.b_ada = a.in[5]; F.g_pre_mix = a.in[6]; F.g_post_mix = a.in[7];
    F.g_pre_ffn = a.in[8]; F.g_post_ffn = a.in[9]; F.w_in = a.in[10]; F.sink = a.in[11]; F.w_o_attn = a.in[12]; F.conv_dw = a.in[13]; F.conv_dw_b = a.in[14];
    F.conv_ln_g = a.in[15]; F.conv_ln_b = a.in[16]; F.w_o_conv = a.in[17]; F.w_out = a.in[18]; F.peer_wq = a.in[19]; F.peer_keys = a.in[20]; F.peer_u = a.in[21]; F.peer_v = a.in[22];
    F.out = a.out;
    unsigned char* ws = a.ws;
    F.mod = (float*)(ws + WS_MOD); F.rope = (float*)(ws + WS_ROPE);
    F.win_t = (act_t*)(ws + WS_WIN); F.woa_t = (act_t*)(ws + WS_WOA); F.woc_t = (act_t*)(ws + WS_WOC); F.wout_t = (act_t*)(ws + WS_WOUT); F.wq_t = (act_t*)(ws + WS_WQ); F.keys_t = (act_t*)(ws + WS_KEYS);
    F.q = (act_t*)(ws + O_Q); F.k = (act_t*)(ws + O_K); F.vT = (act_t*)(ws + O_VT); F.u = (act_t*)(ws + O_U); F.sg = (act_t*)(ws + O_SG); F.kc = (act_t*)(ws + O_KC); F.vTc = (act_t*)(ws + O_VTC);
    F.att = (act_t*)(ws + O_ATT); F.cact = (act_t*)(ws + O_CACT); F.hx = (act_t*)(ws + O_HX); F.hc = (act_t*)(ws + O_HC); F.m = (act_t*)(ws + O_M); F.h2 = (act_t*)(ws + O_H2); F.pq = (act_t*)(ws + O_PQ);
    F.mixed = (float*)(ws + O_MIXED); F.topv = (float*)(ws + O_TOPV); F.topi = (int*)(ws + O_TOPI); F.pei = (int*)(ws + O_PEI); F.peg = (float*)(ws + O_PEG);
    F.pu8 = ws + O_PU; F.pv8 = ws + O_PV;

    volatile LAS unsigned* misc = (volatile LAS unsigned*)(LAS unsigned char*)(lds + LDS_MISC);
    if (F.tid < 64) misc[F.tid] = 0u;
    __syncthreads();
    const int lo = a.ph_lo, hi = a.ph_hi;
    XcdBarrier bar; bar.bar = (unsigned*)(ws + WS_CTL); bar.x = 0; bar.st = misc;
    if (hi - lo > 1) bar = xcd_barrier_post((unsigned*)(ws + WS_CTL), misc);
#define IN(k) (lo <= (k) && (k) < hi)
#define SEAM(k) do { if (IN(k) && IN((k) + 1)) xcd_barrier(bar); } while (0)
#define REP(k) for (int rep_ = 0; rep_ < ((PROBE_PH == (k)) ? PROBE_N : 1); ++rep_)
    if (IN(0)) { REP(0) { p0_prep(F); __syncthreads(); } } SEAM(0);
    if (IN(1)) { REP(1) { p1_norm(F); } } SEAM(1);
    if (IN(2)) { REP(2) { p2_inproj(F); } } SEAM(2);
    if (IN(3)) { REP(3) { p3_attn(F); __syncthreads(); } REP(11) { p3_conv(F); __syncthreads(); } } SEAM(3);
    if (IN(4)) { REP(4) { p4_merge(F); } } SEAM(4);
    if (IN(5)) { REP(5) { p5_out(F); } } SEAM(5);
    if (IN(6)) { REP(6) { p6_rows(F); } } SEAM(6);
    if (IN(7)) { REP(7) { p7_wq(F); } } SEAM(7);
    if (IN(8)) { REP(8) { p8_topk(F); } } SEAM(8);
#if PROBE_PH == 30
    for (int i_ = 0; i_ < 10; ++i_) xcd_barrier(bar);
#endif
    if (IN(9)) { p10_experts(F); }
#undef REP
#undef IN
#undef SEAM
}

extern "C" void kernel_launch(void* const* d_in, const int* in_sizes, int n_in, void* d_out, int out_size, void* d_ws, size_t ws_size, hipStream_t stream) {
    static int grid = 0;
    if (grid == 0) {
        if (n_in != 23 || ws_size < WS_END) { fprintf(stderr, "kernel_launch: need 23 inputs and %zu B of workspace (got %d, %zu)\n", (size_t)WS_END, n_in, ws_size); grid = -1; return; }
        int dev = 0, cus = 0;
        if (hipGetDevice(&dev) != hipSuccess || hipDeviceGetAttribute(&cus, hipDeviceAttributeMultiprocessorCount, dev) != hipSuccess) { grid = -1; return; }
        if (hipFuncSetAttribute((const void*)fwd_kernel, hipFuncAttributeMaxDynamicSharedMemorySize, LDS_BYTES) != hipSuccess) { fprintf(stderr, "kernel_launch: hipFuncSetAttribute failed\n"); grid = -1; return; }
        grid = cus;
    }
    if (grid < 0) return;
    (void)hipMemsetAsync((char*)d_ws + WS_CTL, 0, CTL_BYTES, stream);
    Args a{};
    for (int i = 0; i < 23; ++i) a.in[i] = (const float*)d_in[i];
    a.out = (float*)d_out; a.ws = (unsigned char*)d_ws;
#if ONE_LAUNCH
    a.ph_lo = 0; a.ph_hi = NPHASE; a.b0 = 0;
    hipLaunchKernelGGL(fwd_kernel, dim3(grid), dim3(512), LDS_BYTES, stream, a);
#else
    a.ph_lo = 0; a.ph_hi = 1; a.b0 = 0;
    hipLaunchKernelGGL(fwd_kernel, dim3(grid), dim3(512), LDS_BYTES, stream, a);
    for (int b0 = 0; b0 < BATCH; b0 += CH_B)
        for (int ph = 1; ph < NPHASE; ++ph) { a.ph_lo = ph; a.ph_hi = ph + 1; a.b0 = b0; hipLaunchKernelGGL(fwd_kernel, dim3(grid), dim3(512), LDS_BYTES, stream, a); }
#endif
}
```
